# Optimizing an MI355X kernel written in HIP

```python
import math
import jax
import jax.numpy as jnp
from jax import lax
import numpy as np

D_MODEL = 1024
BATCH = 2
SEQ = 16384
DEPTH = 2

GRID_W = 64
CTX_LEN = 256
CHUNK = 128
Q_BLOCK = 128
ROPE_BASE = 10000.0
EPS = 1e-6

BRANCH_DIM = D_MODEL // 2
N_BRANCH = 4
CONV_DIM = BRANCH_DIM
CONV_WIDTH = 31
SSM_INNER = BRANCH_DIM
SSM_HEAD_DIM = 64
SSM_HEADS = SSM_INNER // SSM_HEAD_DIM
SSM_GROUPS = 2
SSM_STATE = 128
SSM_CONV = 5
SSM_XBC = SSM_INNER + 2 * SSM_GROUPS * SSM_STATE
RET_HEADS = 4
RET_QK_DIM = 64
RET_INNER = BRANCH_DIM
RET_V_DIM = RET_INNER // RET_HEADS
MLA_HEADS = 8
MLA_NOPE = 64
MLA_ROPE = 32
MLA_V = BRANCH_DIM // MLA_HEADS
MLA_Q_RANK = 384
MLA_KV_RANK = 256
MLA_INNER = MLA_HEADS * MLA_V
FFN_DIM = ((8 * D_MODEL // 3 + 255) // 256) * 256

IN_SPLITS = (
    2 * CONV_DIM,
    SSM_INNER, SSM_XBC, 2 * SSM_HEADS,
    RET_HEADS * RET_QK_DIM, RET_HEADS * RET_QK_DIM, RET_INNER, RET_INNER,
    MLA_Q_RANK, MLA_KV_RANK, MLA_ROPE,
    N_BRANCH * D_MODEL,
)
N_IN = sum(IN_SPLITS)

kernel_name = 'hybrid_gated_parallel_dit_block'


def split_cols(u, sizes):
    parts, off = [], 0
    for s in sizes:
        parts.append(u[..., off:off + s])
        off += s
    return parts


def flip(a):
    return jnp.flip(a, axis=1)


def rmsnorm(x, g):
    xf = x.astype(jnp.float32)
    y = xf * lax.rsqrt(jnp.mean(xf * xf, axis=-1, keepdims=True) + EPS)
    return y.astype(x.dtype) * g


def layernorm(x, g, b):
    xf = x.astype(jnp.float32)
    mu = jnp.mean(xf, axis=-1, keepdims=True)
    var = jnp.mean(jnp.square(xf - mu), axis=-1, keepdims=True)
    return ((xf - mu) * lax.rsqrt(var + EPS)).astype(x.dtype) * g + b


def modulate(h, shift, scale):
    return h * (1 + scale) + shift


def axial_rope(n, rot_dim, dtype):
    rows = n // GRID_W
    row = jnp.repeat(jnp.arange(rows, dtype=jnp.float32), GRID_W)
    col = jnp.tile(jnp.arange(GRID_W, dtype=jnp.float32), rows)
    nf = rot_dim // 4
    inv = ROPE_BASE ** (-jnp.arange(nf, dtype=jnp.float32) / nf)
    ang = jnp.concatenate([row[:, None] * inv, col[:, None] * inv], axis=-1)
    return jnp.cos(ang).astype(dtype), jnp.sin(ang).astype(dtype)


def apply_rope(x, rope):
    if rope is None:
        return x
    cos, sin = rope[0][:, None, :], rope[1][:, None, :]
    x1, x2 = jnp.split(x, 2, axis=-1)
    return jnp.concatenate([x1 * cos - x2 * sin, x1 * sin + x2 * cos], axis=-1)


def dwconv(x, w, b):
    pad = w.shape[0] // 2
    y = lax.conv_general_dilated(x, w[:, None, :].astype(x.dtype), window_strides=(1,),
                                 padding=((pad, pad),), dimension_numbers=('NWC', 'WIO', 'NWC'),
                                 feature_group_count=x.shape[-1])
    return y + b


def chunked_scan(q, k, v, log_a, h0, need_y):
    f32 = jnp.float32
    b, l, nh, n = k.shape
    p = v.shape[-1]
    nc = l // CHUNK
    k = k.astype(f32).reshape(b, nc, CHUNK, nh, n)
    v = v.astype(f32).reshape(b, nc, CHUNK, nh, p)
    cum = jnp.cumsum(log_a.astype(f32).reshape(b, nc, CHUNK, nh), axis=2)
    total = cum[:, :, -1]
    s_local = jnp.einsum('bclhn,bclhp->bchnp', k * jnp.exp(total[:, :, None] - cum)[..., None], v)

    def step(h, inp):
        s_c, t_c = inp
        return jnp.exp(t_c)[..., None, None] * h + s_c, h

    h_last, h_enter = lax.scan(step, h0.astype(f32), (jnp.moveaxis(s_local, 1, 0), jnp.moveaxis(total, 1, 0)))
    if not need_y:
        return None, h_last
    q = q.astype(f32).reshape(b, nc, CHUNK, nh, n)
    h_enter = jnp.moveaxis(h_enter, 0, 1)
    seg = cum[:, :, :, None, :] - cum[:, :, None, :, :]
    mask = jnp.tril(jnp.ones((CHUNK, CHUNK), dtype=bool))[None, None, :, :, None]
    decay = jnp.exp(jnp.where(mask, seg, -jnp.inf))
    scores = jnp.einsum('bclhn,bcshn->bclsh', q, k) * decay
    y = (jnp.einsum('bclsh,bcshp->bclhp', scores, v)
         + jnp.einsum('bclhn,bchnp->bclhp', q, h_enter) * jnp.exp(cum)[..., None])
    return y.reshape(b, l, nh, p), h_last


def conv_module(u, p):
    a, g = jnp.split(u, 2, axis=-1)
    h = dwconv(a * jax.nn.sigmoid(g), p['conv_w'], p['conv_b'])
    return jax.nn.silu(layernorm(h, p['conv_ln_g'], p['conv_ln_b']))


def ssm_mixer(z, xbc, dt_raw, p, h0, need_y):
    f32 = jnp.float32
    b, l, _ = xbc.shape
    xbc = jax.nn.silu(dwconv(xbc, p['ssm_conv_w'], p['ssm_conv_b']))
    xh, bm, cm = split_cols(xbc, (SSM_INNER, SSM_GROUPS * SSM_STATE, SSM_GROUPS * SSM_STATE))
    xf = xh.reshape(b, l, SSM_HEADS, SSM_HEAD_DIM).astype(f32)
    rep = SSM_HEADS // SSM_GROUPS
    bm = jnp.repeat(bm.reshape(b, l, SSM_GROUPS, SSM_STATE), rep, axis=2)
    cm = jnp.repeat(cm.reshape(b, l, SSM_GROUPS, SSM_STATE), rep, axis=2)
    dt = jax.nn.softplus(dt_raw.astype(f32).reshape(b, l, 2, SSM_HEADS) + p['ssm_dt_bias'].astype(f32))
    log_a = dt * -jnp.exp(p['ssm_a_log'].astype(f32))
    y_f, h_f = chunked_scan(cm, bm, xf * dt[:, :, 0, :, None], log_a[:, :, 0], h0[0], need_y)
    y_b, h_b = chunked_scan(flip(cm), flip(bm), flip(xf * dt[:, :, 1, :, None]), flip(log_a[:, :, 1]), h0[1], need_y)
    if not need_y:
        return None, (h_f, h_b)
    y = y_f + flip(y_b) + p['ssm_d'].astype(f32)[:, None] * xf
    y = y.reshape(b, l, SSM_INNER).astype(z.dtype) * jax.nn.silu(z)
    y = rmsnorm(y.reshape(b, l, SSM_GROUPS, SSM_INNER // SSM_GROUPS), p['ssm_norm_g'].reshape(SSM_GROUPS, -1))
    return y.reshape(b, l, SSM_INNER), (h_f, h_b)


def retention_mixer(q, k, v, g, p, h0, rope, need_y):
    b, l, _ = k.shape
    q = apply_rope(q.reshape(b, l, RET_HEADS, RET_QK_DIM), rope)
    k = apply_rope(k.reshape(b, l, RET_HEADS, RET_QK_DIM), rope) * (RET_QK_DIM ** -0.5)
    v = v.reshape(b, l, RET_HEADS, RET_V_DIM)
    log_gamma = -jnp.exp(p['ret_decay'].astype(jnp.float32))
    la_f = jnp.broadcast_to(log_gamma[0], (b, l, RET_HEADS))
    la_b = jnp.broadcast_to(log_gamma[1], (b, l, RET_HEADS))
    y_f, h_f = chunked_scan(q, k, v, la_f, h0[0], need_y)
    y_b, h_b = chunked_scan(flip(q), flip(k), flip(v), la_b, h0[1], need_y)
    if not need_y:
        return None, (h_f, h_b)
    y = (y_f + flip(y_b)).astype(g.dtype)
    yn = layernorm(y, p['ret_gn_g'].reshape(RET_HEADS, RET_V_DIM), p['ret_gn_b'].reshape(RET_HEADS, RET_V_DIM))
    return jax.nn.silu(g) * yn.reshape(b, l, RET_INNER), (h_f, h_b)


def mla_kv(c_kv, k_r, p, rope):
    b, l, _ = c_kv.shape
    kv = (rmsnorm(c_kv, p['mla_kv_norm_g']) @ p['mla_w_ukv']).reshape(b, l, MLA_HEADS, MLA_NOPE + MLA_V)
    k_rope = apply_rope(k_r[:, :, None, :], rope)
    k = jnp.concatenate([kv[..., :MLA_NOPE], jnp.broadcast_to(k_rope, (b, l, MLA_HEADS, MLA_ROPE))], axis=-1)
    return k, kv[..., MLA_NOPE:]


def mla_q(c_q, p, rope):
    b, l, _ = c_q.shape
    q = (rmsnorm(c_q, p['mla_q_norm_g']) @ p['mla_w_uq']).reshape(b, l, MLA_HEADS, MLA_NOPE + MLA_ROPE)
    return jnp.concatenate([q[..., :MLA_NOPE], apply_rope(q[..., MLA_NOPE:], rope)], axis=-1)


def block_attention(q, k, v):
    b, lq, h, d = q.shape
    nb = lq // Q_BLOCK
    scale = d ** -0.5
    qb = jnp.moveaxis(q.reshape(b, nb, Q_BLOCK, h, d), 1, 0)

    def one(qi):
        s = jnp.einsum('bqhd,bkhd->bhqk', qi, k).astype(jnp.float32) * scale
        w = jax.nn.softmax(s, axis=-1).astype(v.dtype)
        return jnp.einsum('bhqk,bkhd->bqhd', w, v)

    o = lax.map(one, qb)
    return jnp.moveaxis(o, 0, 1).reshape(b, lq, h * v.shape[-1])


def merge_branches(branches, gate_logits, p):
    merged = jax.nn.sigmoid(gate_logits[..., :D_MODEL]) * (branches[0] @ p['w_branch'][0])
    for i in range(1, N_BRANCH):
        gi = jax.nn.sigmoid(gate_logits[..., i * D_MODEL:(i + 1) * D_MODEL])
        merged = merged + gi * (branches[i] @ p['w_branch'][i])
    return merged @ p['w_out']


def token_mixers(hx, hc, p, rope_ret, rope_mla, need_ctx_out):
    f32 = jnp.float32
    b = hx.shape[0]
    (conv_x, z_x, xbc_x, dt_x, rq_x, rk_x, rv_x, rg_x, cq_x, ckv_x, kr_x, gl_x) = split_cols(hx @ p['w_in'], IN_SPLITS)
    (conv_c, z_c, xbc_c, dt_c, rq_c, rk_c, rv_c, rg_c, cq_c, ckv_c, kr_c, gl_c) = split_cols(hc @ p['w_in'], IN_SPLITS)
    zs = jnp.zeros((b, SSM_HEADS, SSM_STATE, SSM_HEAD_DIM), f32)
    zr = jnp.zeros((b, RET_HEADS, RET_QK_DIM, RET_V_DIM), f32)
    ssm_yc, ssm_hc = ssm_mixer(z_c, xbc_c, dt_c, p, (zs, zs), need_ctx_out)
    ret_yc, ret_hc = retention_mixer(rq_c, rk_c, rv_c, rg_c, p, (zr, zr), None, need_ctx_out)
    k_c, v_c = mla_kv(ckv_c, kr_c, p, None)
    ssm_yx, _ = ssm_mixer(z_x, xbc_x, dt_x, p, ssm_hc, True)
    ret_yx, _ = retention_mixer(rq_x, rk_x, rv_x, rg_x, p, ret_hc, rope_ret, True)
    k_x, v_x = mla_kv(ckv_x, kr_x, p, rope_mla)
    att_x = block_attention(mla_q(cq_x, p, rope_mla), jnp.concatenate([k_c, k_x], axis=1),
                            jnp.concatenate([v_c, v_x], axis=1))
    out_x = merge_branches((conv_module(conv_x, p), ssm_yx, ret_yx, att_x), gl_x, p)
    if not need_ctx_out:
        return out_x, None
    att_c = block_attention(mla_q(cq_c, p, None), k_c, v_c)
    out_c = merge_branches((conv_module(conv_c, p), ssm_yc, ret_yc, att_c), gl_c, p)
    return out_x, out_c


def swiglu(h, p):
    a, g = jnp.split(h @ p['w_ffn_in'], 2, axis=-1)
    return (jax.nn.silu(g) * a) @ p['w_ffn_out']


def trunk_layer(xs, cs, c, c_ctx, p, rope_ret, rope_mla, last):
    mod_x = jnp.split((jax.nn.silu(c) @ p['w_ada'] + p['b_ada'])[:, None, :], 6, axis=-1)
    mod_c = jnp.split((jax.nn.silu(c_ctx) @ p['w_ada'] + p['b_ada'])[None, None, :], 6, axis=-1)
    hx = modulate(rmsnorm(xs, p['norm1_g']), mod_x[0], mod_x[1])
    hc = modulate(rmsnorm(cs, p['norm1_g']), mod_c[0], mod_c[1])
    mx, mc = token_mixers(hx, hc, p, rope_ret, rope_mla, not last)
    xs = xs + mod_x[2] * mx
    xs = xs + mod_x[5] * swiglu(modulate(rmsnorm(xs, p['norm2_g']), mod_x[3], mod_x[4]), p)
    if last:
        return xs, cs
    cs = cs + mod_c[2] * mc
    cs = cs + mod_c[5] * swiglu(modulate(rmsnorm(cs, p['norm2_g']), mod_c[3], mod_c[4]), p)
    return xs, cs


def setup_inputs(seed: int = 0) -> dict:
    key = jax.random.key(seed)
    k = jax.random.split(key, 32)
    f32 = jnp.float32
    L, D = DEPTH, D_MODEL

    def nrm(i, shape, scale):
        return jax.random.normal(k[i], shape, f32) * scale

    def gain(i, shape):
        return 1.0 + nrm(i, shape, 0.02)

    dt0 = jnp.exp(jax.random.uniform(k[15], (L, 2, SSM_HEADS), f32, math.log(1e-3), math.log(1e-1)))
    gamma = 1.0 - 2.0 ** (-5.0 - jnp.arange(RET_HEADS, dtype=f32))
    return {
        'x': nrm(0, (BATCH, SEQ, D), 1.0),
        'c': nrm(1, (BATCH, D), 1.0),
        'ctx': nrm(2, (BATCH, CTX_LEN, D), 1.0),
        'c_ctx': nrm(3, (D,), 1.0),
        'w_ada': nrm(4, (L, D, 6 * D), 0.5 * D ** -0.5),
        'b_ada': nrm(5, (L, 6 * D), 0.02),
        'norm1_g': gain(6, (L, D)),
        'norm2_g': gain(7, (L, D)),
        'w_in': nrm(8, (L, D, N_IN), D ** -0.5),
        'conv_w': nrm(9, (L, CONV_WIDTH, CONV_DIM), CONV_WIDTH ** -0.5),
        'conv_b': nrm(10, (L, CONV_DIM), 0.02),
        'conv_ln_g': gain(11, (L, CONV_DIM)),
        'conv_ln_b': nrm(12, (L, CONV_DIM), 0.02),
        'ssm_conv_w': nrm(13, (L, SSM_CONV, SSM_XBC), SSM_CONV ** -0.5),
        'ssm_conv_b': nrm(14, (L, SSM_XBC), 0.02),
        'ssm_dt_bias': dt0 + jnp.log(-jnp.expm1(-dt0)),
        'ssm_a_log': jnp.log(jax.random.uniform(k[16], (L, 2, SSM_HEADS), f32, 1.0, 16.0)),
        'ssm_d': gain(17, (L, SSM_HEADS)),
        'ssm_norm_g': gain(18, (L, SSM_INNER)),
        'ret_decay': jnp.log(-jnp.log(gamma)) + nrm(19, (L, 2, RET_HEADS), 0.05),
        'ret_gn_g': gain(20, (L, RET_INNER)),
        'ret_gn_b': nrm(21, (L, RET_INNER), 0.02),
        'mla_q_norm_g': gain(22, (L, MLA_Q_RANK)),
        'mla_kv_norm_g': gain(23, (L, MLA_KV_RANK)),
        'mla_w_uq': nrm(24, (L, MLA_Q_RANK, MLA_HEADS * (MLA_NOPE + MLA_ROPE)), MLA_Q_RANK ** -0.5),
        'mla_w_ukv': nrm(25, (L, MLA_KV_RANK, MLA_HEADS * (MLA_NOPE + MLA_V)), MLA_KV_RANK ** -0.5),
        'w_branch': nrm(26, (L, N_BRANCH, BRANCH_DIM, D), BRANCH_DIM ** -0.5),
        'w_out': nrm(27, (L, D, D), D ** -0.5),
        'w_ffn_in': nrm(28, (L, D, 2 * FFN_DIM), D ** -0.5),
        'w_ffn_out': nrm(29, (L, FFN_DIM, D), FFN_DIM ** -0.5),
        'final_norm_g': gain(30, (D,)),
    }


def reference(x, c, ctx, c_ctx, w_ada, b_ada, norm1_g, norm2_g, w_in, conv_w, conv_b, conv_ln_g, conv_ln_b,
              ssm_conv_w, ssm_conv_b, ssm_dt_bias, ssm_a_log, ssm_d, ssm_norm_g, ret_decay, ret_gn_g, ret_gn_b,
              mla_q_norm_g, mla_kv_norm_g, mla_w_uq, mla_w_ukv, w_branch, w_out, w_ffn_in, w_ffn_out, final_norm_g):
    n_lat = x.shape[1]
    rope_ret = axial_rope(n_lat, RET_QK_DIM, x.dtype)
    rope_mla = axial_rope(n_lat, MLA_ROPE, x.dtype)
    xs, cs = x, ctx
    for i in range(DEPTH):
        p = {
            'w_ada': w_ada[i], 'b_ada': b_ada[i], 'norm1_g': norm1_g[i], 'norm2_g': norm2_g[i],
            'w_in': w_in[i], 'conv_w': conv_w[i], 'conv_b': conv_b[i], 'conv_ln_g': conv_ln_g[i],
            'conv_ln_b': conv_ln_b[i], 'ssm_conv_w': ssm_conv_w[i], 'ssm_conv_b': ssm_conv_b[i],
            'ssm_dt_bias': ssm_dt_bias[i], 'ssm_a_log': ssm_a_log[i], 'ssm_d': ssm_d[i],
            'ssm_norm_g': ssm_norm_g[i], 'ret_decay': ret_decay[i], 'ret_gn_g': ret_gn_g[i],
            'ret_gn_b': ret_gn_b[i], 'mla_q_norm_g': mla_q_norm_g[i], 'mla_kv_norm_g': mla_kv_norm_g[i],
            'mla_w_uq': mla_w_uq[i], 'mla_w_ukv': mla_w_ukv[i], 'w_branch': w_branch[i], 'w_out': w_out[i],
            'w_ffn_in': w_ffn_in[i], 'w_ffn_out': w_ffn_out[i],
        }
        xs, cs = trunk_layer(xs, cs, c, c_ctx, p, rope_ret, rope_mla, i == DEPTH - 1)
    return rmsnorm(xs, final_norm_g)
```

```cpp
#include <hip/hip_runtime.h>
#include <hip/hip_cooperative_groups.h>
#include <cstdio>
namespace cg = cooperative_groups;

#ifndef COOP
#define COOP 1
#endif
#define REP_N 4

typedef unsigned short bfr;
typedef __attribute__((ext_vector_type(8))) short bf16x8;
typedef __attribute__((ext_vector_type(4))) float f32x4;
#define DEV __device__ __forceinline__

constexpr int D = 1024, SEQ = 16384, CTX = 256, ROWS = SEQ + CTX, NCH = ROWS / 128;
constexpr int NIN = 8880, NU = 4784, FFN = 2816, NMOD = 6144;
constexpr int C_Z = 1024, C_XBC = 1536, C_DT = 2560, C_RQ = 2576, C_RK = 2832, C_RV = 3088, C_RG = 3600,
              C_CQ = 4112, C_CKV = 4496, C_KR = 4752;
constexpr float EPS = 1e-6f;

enum { I_X, I_C, I_CTX, I_CCTX, I_WADA, I_BADA, I_N1G, I_N2G, I_WIN, I_CONVW, I_CONVB, I_CLNG, I_CLNB, I_SCW, I_SCB,
       I_DTB, I_ALOG, I_SSMD, I_SNG, I_RDEC, I_RGNG, I_RGNB, I_QNG, I_KVNG, I_WUQ, I_WUKV, I_WBR, I_WOUT, I_WF1,
       I_WF2, I_FNG, N_INPUTS };

struct Prm { const float* in[N_INPUTS]; float* out; char* ws; };

constexpr size_t al256(size_t x) { return (x + 255) & ~(size_t)255; }
constexpr size_t O_MOD   = 0;
constexpr size_t O_MODP  = al256(O_MOD + (size_t)2 * 3 * NMOD * 4);
constexpr size_t O_RCS   = al256(O_MODP + (size_t)16 * 2 * 3 * NMOD * 4);
constexpr size_t O_MCS   = al256(O_RCS + 256 * 16 * 8);
constexpr size_t O_CS    = al256(O_MCS + 256 * 8 * 8);
constexpr size_t O_RSQ   = al256(O_CS + (size_t)2 * CTX * D * 4);
constexpr size_t O_RSKV  = al256(O_RSQ + ROWS * 4);
constexpr size_t O_TOT   = al256(O_RSKV + ROWS * 4);
constexpr size_t O_KROPE = al256(O_TOT + 2 * NCH * 8 * 4);
constexpr size_t O_WTIN  = al256(O_KROPE + (size_t)ROWS * 32 * 2);
constexpr size_t O_WTBR  = al256(O_WTIN + (size_t)NIN * D * 2);
constexpr size_t O_WTOUT = al256(O_WTBR + (size_t)4 * D * 512 * 2);
constexpr size_t O_WTF1  = al256(O_WTOUT + (size_t)D * D * 2);
constexpr size_t O_WTF2  = al256(O_WTF1 + (size_t)2 * FFN * D * 2);
constexpr size_t O_WTUQ  = al256(O_WTF2 + (size_t)D * FFN * 2);
constexpr size_t O_WTUKV = al256(O_WTUQ + (size_t)768 * 384 * 2);
constexpr size_t O_H     = al256(O_WTUKV + (size_t)1024 * 256 * 2);
constexpr size_t O_U     = al256(O_H + (size_t)ROWS * D * 2);
constexpr size_t O_BR    = al256(O_U + (size_t)ROWS * NU * 2);
constexpr size_t O_XBC   = al256(O_BR + (size_t)ROWS * 2048 * 2);
constexpr size_t O_SST   = al256(O_XBC + (size_t)ROWS * 1024 * 2);
constexpr size_t O_RST   = al256(O_SST + (size_t)2 * NCH * 8 * 8192 * 4);
constexpr size_t O_Q     = al256(O_RST + (size_t)2 * NCH * 4 * 8192 * 4);
constexpr size_t O_KN    = al256(O_Q + (size_t)ROWS * 768 * 2);
constexpr size_t O_VT    = al256(O_KN + (size_t)ROWS * 512 * 2);
constexpr size_t O_BAR   = al256(O_VT + (size_t)512 * ROWS * 2);
constexpr size_t O_END   = al256(O_BAR + 3456 * 4);
static_assert(O_END <= (size_t)512 * 1024 * 1024, "workspace too large");

#define WS_F(off) ((float*)(p.ws + (off)))
#define WS_B(off) ((bfr*)(p.ws + (off)))

DEV int rtid() { int t = __builtin_amdgcn_workitem_id_x(); asm volatile("" : "+v"(t)); return t; }
DEV int otid() { return rtid() & 255; }
#define VBX ((int)(blockIdx.x * 2 + (rtid() >> 8)))
#define VGX ((int)(gridDim.x * 2))
DEV bfr f2bf(float f) { unsigned u = __float_as_uint(f); u += 0x7fffu + ((u >> 16) & 1u); return (bfr)(u >> 16); }
DEV float bf2f(unsigned h) { return __uint_as_float(h << 16); }
DEV unsigned pack2(float a, float b) { unsigned r; asm("v_cvt_pk_bf16_f32 %0, %1, %2" : "=v"(r) : "v"(a), "v"(b)); return r; }
DEV uint2 pack4(float a, float b, float c, float d) { uint2 r; r.x = pack2(a, b); r.y = pack2(c, d); return r; }
DEV float lo16(unsigned w) { return __uint_as_float(w << 16); }
DEV float hi16(unsigned w) { return __uint_as_float(w & 0xffff0000u); }
DEV void unpack8(const uint4& v, float (&f)[8]) {
  f[0] = lo16(v.x); f[1] = hi16(v.x); f[2] = lo16(v.y); f[3] = hi16(v.y);
  f[4] = lo16(v.z); f[5] = hi16(v.z); f[6] = lo16(v.w); f[7] = hi16(v.w);
}
DEV void unpack4(const uint2& v, float (&f)[4]) { f[0] = lo16(v.x); f[1] = hi16(v.x); f[2] = lo16(v.y); f[3] = hi16(v.y); }
DEV uint4 pack8(const float (&f)[8]) {
  uint4 r; r.x = pack2(f[0], f[1]); r.y = pack2(f[2], f[3]); r.z = pack2(f[4], f[5]); r.w = pack2(f[6], f[7]); return r;
}
DEV unsigned elem16(const uint4& v, int e) {
  unsigned w = (e >> 1) == 0 ? v.x : (e >> 1) == 1 ? v.y : (e >> 1) == 2 ? v.z : v.w;
  return (e & 1) ? (w >> 16) : (w & 0xffffu);
}
DEV float silu_f(float x) { return x / (1.f + __expf(-x)); }
DEV float sigm_f(float x) { return 1.f / (1.f + __expf(-x)); }
DEV float softplus_f(float x) { return x > 20.f ? x : log1pf(__expf(x)); }
DEV float wave_sum(float v) {
#pragma unroll
  for (int o = 32; o >= 1; o >>= 1) v += __shfl_xor(v, o);
  return v;
}

template <int MI, int NI, int KS>
DEV void lds_gemm(const bfr* sX, int ldx, const bfr* sW, int ldw, f32x4 (&acc)[MI][NI]) {
  const int lane = otid() & 63, l15 = lane & 15, quad = lane >> 4;
#pragma unroll
  for (int ks = 0; ks < KS; ks++) {
    bf16x8 xa[MI], wb[NI];
#pragma unroll
    for (int mi = 0; mi < MI; mi++) xa[mi] = *(const bf16x8*)(sX + (mi * 16 + l15) * ldx + ks * 32 + quad * 8);
#pragma unroll
    for (int ni = 0; ni < NI; ni++) wb[ni] = *(const bf16x8*)(sW + (ni * 16 + l15) * ldw + ks * 32 + quad * 8);
#pragma unroll
    for (int mi = 0; mi < MI; mi++)
#pragma unroll
      for (int ni = 0; ni < NI; ni++)
        acc[mi][ni] = __builtin_amdgcn_mfma_f32_16x16x32_bf16(wb[ni], xa[mi], acc[mi][ni], 0, 0, 0);
  }
}

DEV void gemm_mainloop(const bfr* __restrict__ A, int lda, const bfr* __restrict__ Bt, int ldb, int K,
                       f32x4 (&acc)[4][4], char* smem) {
  bfr* sA = (bfr*)smem;
  bfr* sB = sA + 128 * 72;
  const int tid = otid(), wid = tid >> 6, wm = wid >> 1, wn = wid & 1;
  const int lrow = tid >> 3, lkc = (tid & 7) * 8;
  const bfr* pa = A + (size_t)lrow * lda + lkc;
  const bfr* pb = Bt + (size_t)lrow * ldb + lkc;
  const size_t sa = (size_t)32 * lda, sb = (size_t)32 * ldb;
  uint4 ra0 = *(const uint4*)(pa), ra1 = *(const uint4*)(pa + sa), ra2 = *(const uint4*)(pa + 2 * sa), ra3 = *(const uint4*)(pa + 3 * sa);
  uint4 rb0 = *(const uint4*)(pb), rb1 = *(const uint4*)(pb + sb), rb2 = *(const uint4*)(pb + 2 * sb), rb3 = *(const uint4*)(pb + 3 * sb);
  bfr* wa = sA + lrow * 72 + lkc;
  bfr* wb = sB + lrow * 72 + lkc;
  const int nk = K >> 6;
#pragma unroll 1
  for (int kt = 0; kt < nk; kt++) {
    __syncthreads();
    *(uint4*)(wa) = ra0; *(uint4*)(wa + 32 * 72) = ra1; *(uint4*)(wa + 64 * 72) = ra2; *(uint4*)(wa + 96 * 72) = ra3;
    *(uint4*)(wb) = rb0; *(uint4*)(wb + 32 * 72) = rb1; *(uint4*)(wb + 64 * 72) = rb2; *(uint4*)(wb + 96 * 72) = rb3;
    __syncthreads();
    if (kt + 1 < nk) {
      pa += 64; pb += 64;
      ra0 = *(const uint4*)(pa); ra1 = *(const uint4*)(pa + sa); ra2 = *(const uint4*)(pa + 2 * sa); ra3 = *(const uint4*)(pa + 3 * sa);
      rb0 = *(const uint4*)(pb); rb1 = *(const uint4*)(pb + sb); rb2 = *(const uint4*)(pb + 2 * sb); rb3 = *(const uint4*)(pb + 3 * sb);
    }
    lds_gemm<4, 4, 2>(sA + (wm * 64) * 72, 72, sB + (wn * 64) * 72, 72, acc);
  }
}

DEV void gemm2_mainloop(const bfr* __restrict__ A, int lda, const bfr* __restrict__ Bt, int ldb, int K,
                        f32x4 (&acc)[8][4], char* smem) {
  constexpr int LDT = 32;
  bfr* sA0 = (bfr*)smem;
  bfr* sB0 = sA0 + 2 * 256 * LDT;
  const int tid = otid(), lane = tid & 63, wid = tid >> 6, wm = wid >> 1, wn = wid & 1, l15 = lane & 15, quad = lane >> 4;
  const int lrow = tid >> 2, lkc = (tid & 3) * 8;
  const bfr* pa = A + (size_t)lrow * lda + lkc;
  const bfr* pb = Bt + (size_t)lrow * ldb + lkc;
  const size_t sa = (size_t)64 * lda, sb = (size_t)64 * ldb;
  const int wo = lrow * LDT + (((tid & 3) ^ ((0x1320 >> (4 * ((lrow >> 2) & 3))) & 3)) * 8);
  const int rsw = ((quad ^ ((0x1320 >> (4 * ((l15 >> 2) & 3))) & 3)) * 8);
  uint4 ra0, ra1, ra2, ra3, rb0, rb1;
#define SBAR() __builtin_amdgcn_sched_barrier(0)
#define G2_LOADA() do { ra0 = *(const uint4*)(pa); ra1 = *(const uint4*)(pa + sa); ra2 = *(const uint4*)(pa + 2 * sa); ra3 = *(const uint4*)(pa + 3 * sa); pa += 32; } while (0)
#define G2_LOADB() do { rb0 = *(const uint4*)(pb); rb1 = *(const uint4*)(pb + sb); pb += 32; } while (0)
#define G2_STOREA(buf_) do { bfr* a_ = sA0 + (buf_) * 256 * LDT + wo; \
                       *(uint4*)(a_) = ra0; *(uint4*)(a_ + 64 * LDT) = ra1; *(uint4*)(a_ + 128 * LDT) = ra2; *(uint4*)(a_ + 192 * LDT) = ra3; } while (0)
#define G2_STOREB(buf_) do { bfr* b_ = sB0 + (buf_) * 128 * LDT + wo; *(uint4*)(b_) = rb0; *(uint4*)(b_ + 64 * LDT) = rb1; } while (0)
#ifdef PROBE_DMFMA
  f32x4 dacc[4] = {f32x4{0,0,0,0}, f32x4{0,0,0,0}, f32x4{0,0,0,0}, f32x4{0,0,0,0}};
#define MF4(xa_, mi_) do { _Pragma("unroll") for (int ni = 0; ni < 4; ni++) { acc[mi_][ni] = __builtin_amdgcn_mfma_f32_16x16x32_bf16(wb[ni], xa_, acc[mi_][ni], 0, 0, 0); dacc[ni] = __builtin_amdgcn_mfma_f32_16x16x32_bf16(wb[ni], xa_, dacc[ni], 0, 0, 0); } } while (0)
#else
#define MF4(xa_, mi_) do { _Pragma("unroll") for (int ni = 0; ni < 4; ni++) acc[mi_][ni] = __builtin_amdgcn_mfma_f32_16x16x32_bf16(wb[ni], xa_, acc[mi_][ni], 0, 0, 0); } while (0)
#endif
  const int nk = K >> 5;
  __syncthreads();
  G2_LOADA(); G2_LOADB(); G2_STOREA(0); G2_STOREB(0);
  if (nk > 1) { G2_LOADA(); G2_LOADB(); }
  __syncthreads();
#pragma unroll 1
  for (int kt = 0; kt < nk; kt++) {
    const int cur = kt & 1, nxt = cur ^ 1;
    const bool st = kt + 1 < nk, ld = kt + 2 < nk;
    const bfr* sA = sA0 + cur * 256 * LDT + (wm * 128 + l15) * LDT + rsw;
    const bfr* sB = sB0 + cur * 128 * LDT + (wn * 64 + l15) * LDT + rsw;
    bf16x8 wb[4];
#pragma unroll
    for (int ni = 0; ni < 4; ni++) wb[ni] = *(const bf16x8*)(sB + ni * 16 * LDT);
    bf16x8 f0 = *(const bf16x8*)(sA), f1 = *(const bf16x8*)(sA + 16 * LDT), f2;
    SBAR();
    f2 = *(const bf16x8*)(sA + 32 * LDT); MF4(f0, 0); SBAR();
    f0 = *(const bf16x8*)(sA + 48 * LDT); MF4(f1, 1); if (st) G2_STOREA(nxt); SBAR();
    f1 = *(const bf16x8*)(sA + 64 * LDT); MF4(f2, 2); if (st) G2_STOREB(nxt); SBAR();
    f2 = *(const bf16x8*)(sA + 80 * LDT); MF4(f0, 3); if (ld) G2_LOADA(); SBAR();
    f0 = *(const bf16x8*)(sA + 96 * LDT); MF4(f1, 4); if (ld) G2_LOADB(); SBAR();
    f1 = *(const bf16x8*)(sA + 112 * LDT); MF4(f2, 5); SBAR();
    MF4(f0, 6); SBAR();
    MF4(f1, 7);
    __syncthreads();
  }
#undef G2_LOADA
#undef G2_LOADB
#undef G2_STOREA
#undef G2_STOREB
#undef MF4
#ifdef PROBE_DMFMA
  if (dacc[0][0] + dacc[1][1] + dacc[2][2] + dacc[3][3] == 12345.678f) smem[otid()] = 1;
#endif
}
DEV void gemm4_mainloop(const bfr* __restrict__ A, int lda, const bfr* __restrict__ Bt, int ldb, int K,
                        f32x4 (&acc)[4][4], char* smem, const bfr* nA, const bfr* nBt, bool first,
                        const bfr*& g_pa, const bfr*& g_pb, uint4& g_pa0, uint4& g_pa1, uint4& g_pb0, uint4& g_pb1, uint4& g_qa0, uint4& g_qa1, uint4& g_qb0, uint4& g_qb1) {
  constexpr int LDT = 32;
  bfr* sA0 = (bfr*)smem;
  bfr* sB0 = sA0 + 2 * 128 * LDT;
  const int tid = otid(), lane = tid & 63, wid = tid >> 6, wm = wid >> 1, wn = wid & 1, l15 = lane & 15, quad = lane >> 4;
  const int lrow = tid >> 2, lkc = (tid & 3) * 8;
  const size_t offA = (size_t)lrow * lda + lkc, offB = (size_t)lrow * ldb + lkc;
  const size_t sa = (size_t)64 * lda, sb = (size_t)64 * ldb;
  const int wo = lrow * LDT + (((tid & 3) ^ ((0x1320 >> (4 * ((lrow >> 2) & 3))) & 3)) * 8);
  const int rsw = ((quad ^ ((0x1320 >> (4 * ((l15 >> 2) & 3))) & 3)) * 8);
  const bfr* npa = nA + offA; const bfr* npb = nBt + offB;
  int g_rem;
#define G4_LOAD(S) do { g_##S##a0 = *(const uint4*)(g_pa); g_##S##a1 = *(const uint4*)(g_pa + sa); g_##S##b0 = *(const uint4*)(g_pb); g_##S##b1 = *(const uint4*)(g_pb + sb); \
      g_rem -= 1; const bool sw_ = g_rem == 0; g_pa = sw_ ? npa : g_pa + 32; g_pb = sw_ ? npb : g_pb + 32; } while (0)
#define G4_STORE(S, buf_) do { bfr* a_ = sA0 + (buf_) * 128 * LDT + wo; bfr* b_ = sB0 + (buf_) * 128 * LDT + wo; \
      *(uint4*)(a_) = g_##S##a0; *(uint4*)(a_ + 64 * LDT) = g_##S##a1; *(uint4*)(b_) = g_##S##b0; *(uint4*)(b_ + 64 * LDT) = g_##S##b1; } while (0)
#define MF4(xa_, mi_) do { _Pragma("unroll") for (int ni = 0; ni < 4; ni++) acc[mi_][ni] = __builtin_amdgcn_mfma_f32_16x16x32_bf16(wb[ni], xa_, acc[mi_][ni], 0, 0, 0); } while (0)
#define G4_ITER(S, cur_) do { \
    const bfr* sA = sA0 + (cur_) * 128 * LDT + (wm * 64 + l15) * LDT + rsw; \
    const bfr* sB = sB0 + (cur_) * 128 * LDT + (wn * 64 + l15) * LDT + rsw; \
    bf16x8 wb[4]; \
    _Pragma("unroll") for (int ni = 0; ni < 4; ni++) wb[ni] = *(const bf16x8*)(sB + ni * 16 * LDT); \
    bf16x8 f0 = *(const bf16x8*)(sA), f1 = *(const bf16x8*)(sA + 16 * LDT), f2, f3; \
    SBAR(); \
    f2 = *(const bf16x8*)(sA + 32 * LDT); MF4(f0, 0); G4_STORE(S, (cur_) ^ 1); SBAR(); \
    f3 = *(const bf16x8*)(sA + 48 * LDT); MF4(f1, 1); G4_LOAD(S); SBAR(); \
    MF4(f2, 2); SBAR(); \
    MF4(f3, 3); \
    __syncthreads(); } while (0)
  const int nk = K >> 5;
  if (first) {
    g_pa = A + offA; g_pb = Bt + offB; g_rem = nk;
    __syncthreads();
    G4_LOAD(p); G4_LOAD(q);
    G4_STORE(p, 0);
    G4_LOAD(p);
    __syncthreads();
  } else {
    g_rem = nk - 3;
  }
#pragma unroll 1
  for (int kt = 0; kt < nk; kt += 2) {
    G4_ITER(q, 0);
    G4_ITER(p, 1);
  }
#undef G4_LOAD
#undef G4_STORE
#undef G4_ITER
#undef MF4
}
DEV void gemm4_single(const bfr* __restrict__ A, int lda, const bfr* __restrict__ Bt, int ldb, int K, f32x4 (&acc)[4][4], char* smem) {
  const bfr* g_pa = nullptr; const bfr* g_pb = nullptr; uint4 a0{}, a1{}, b0{}, b1{}, c0{}, c1{}, d0{}, d1{};
  gemm4_mainloop(A, lda, Bt, ldb, K, acc, smem, A, Bt, true, g_pa, g_pb, a0, a1, b0, b1, c0, c1, d0, d1);
}

DEV void gemm3_mainloop(const bfr* __restrict__ A, int lda, const bfr* __restrict__ Bt, int ldb, int K,
                        f32x4 (&acc)[8][4], char* smem, const bfr* nA, const bfr* nBt, bool first,
                        const bfr*& g_pa, const bfr*& g_pb, uint4& g_pa0, uint4& g_pa1, uint4& g_pb0, uint4& g_pb1, uint4& g_qa0, uint4& g_qa1, uint4& g_qb0, uint4& g_qb1) {
  int g_rem;
  constexpr int LDT = 32;
  bfr* sA0 = (bfr*)smem;
  bfr* sB0 = sA0 + 2 * 256 * LDT;
  const int tid = rtid(), lane = tid & 63, wid = tid >> 6, wm = wid >> 2, wn = wid & 3, l15 = lane & 15, quad = lane >> 4;
  const int lrow = tid >> 2, lkc = (tid & 3) * 8;
  const size_t offA = (size_t)lrow * lda + lkc, offB = (size_t)lrow * ldb + lkc;
  const size_t sa = (size_t)128 * lda, sb = (size_t)128 * ldb;
  const int wo = lrow * LDT + (((tid & 3) ^ ((0x1320 >> (4 * ((lrow >> 2) & 3))) & 3)) * 8);
  const int rsw = ((quad ^ ((0x1320 >> (4 * ((l15 >> 2) & 3))) & 3)) * 8);
  const bfr* npa = nA + offA; const bfr* npb = nBt + offB;
#define G3_LOAD(S) do { g_##S##a0 = *(const uint4*)(g_pa); g_##S##a1 = *(const uint4*)(g_pa + sa); g_##S##b0 = *(const uint4*)(g_pb); g_##S##b1 = *(const uint4*)(g_pb + sb); \
      g_rem -= 1; const bool sw_ = g_rem == 0;                   \
      g_pa = sw_ ? npa : g_pa + 32; g_pb = sw_ ? npb : g_pb + 32; } while (0)
#define G3_STORE(S, buf_) do { bfr* a_ = sA0 + (buf_) * 256 * LDT + wo; bfr* b_ = sB0 + (buf_) * 256 * LDT + wo; \
      *(uint4*)(a_) = g_##S##a0; *(uint4*)(a_ + 128 * LDT) = g_##S##a1; *(uint4*)(b_) = g_##S##b0; *(uint4*)(b_ + 128 * LDT) = g_##S##b1; } while (0)
#define MF4(xa_, mi_) do { _Pragma("unroll") for (int ni = 0; ni < 4; ni++) acc[mi_][ni] = __builtin_amdgcn_mfma_f32_16x16x32_bf16(wb[ni], xa_, acc[mi_][ni], 0, 0, 0); } while (0)
#define G3_ITER(S, cur_) do { \
    const bfr* sA = sA0 + (cur_) * 256 * LDT + (wm * 128 + l15) * LDT + rsw; \
    const bfr* sB = sB0 + (cur_) * 256 * LDT + (wn * 64 + l15) * LDT + rsw; \
    bf16x8 wb[4]; \
    _Pragma("unroll") for (int ni = 0; ni < 4; ni++) wb[ni] = *(const bf16x8*)(sB + ni * 16 * LDT); \
    bf16x8 f0 = *(const bf16x8*)(sA), f1 = *(const bf16x8*)(sA + 16 * LDT), f2; \
    SBAR(); \
    f2 = *(const bf16x8*)(sA + 32 * LDT); MF4(f0, 0); SBAR(); \
    f0 = *(const bf16x8*)(sA + 48 * LDT); MF4(f1, 1); G3_STORE(S, (cur_) ^ 1); SBAR(); \
    f1 = *(const bf16x8*)(sA + 64 * LDT); MF4(f2, 2); G3_LOAD(S); SBAR(); \
    f2 = *(const bf16x8*)(sA + 80 * LDT); MF4(f0, 3); SBAR(); \
    f0 = *(const bf16x8*)(sA + 96 * LDT); MF4(f1, 4); SBAR(); \
    f1 = *(const bf16x8*)(sA + 112 * LDT); MF4(f2, 5); SBAR(); \
    MF4(f0, 6); SBAR(); \
    MF4(f1, 7); \
    __syncthreads(); } while (0)
  const int nk = K >> 5;
  if (first) {
    g_pa = A + offA; g_pb = Bt + offB; g_rem = nk;
    __syncthreads();
    G3_LOAD(p); G3_LOAD(q);
    G3_STORE(p, 0);
    G3_LOAD(p);
    __syncthreads();
  } else {
    g_rem = nk - 3;
  }
#pragma unroll 1
  for (int kt = 0; kt < nk; kt += 2) {
    G3_ITER(q, 0);
    G3_ITER(p, 1);
  }
#undef G3_LOAD
#undef G3_STORE
#undef G3_ITER
#undef MF4
}
DEV void zero_acc84(f32x4 (&acc)[8][4]) {
#pragma unroll
  for (int i = 0; i < 8; i++)
#pragma unroll
    for (int j = 0; j < 4; j++) acc[i][j] = f32x4{0.f, 0.f, 0.f, 0.f};
}


DEV bool tile_remap(int r, int MT, int NT, int& mt, int& nt, int b, int G, bool clamp) {
  const int per = G >> 3;
  int lin = clamp ? r * G + ((b >> 1) & 7) * per + (((b >> 4) << 1) | (b & 1)) : r * G + (b & 7) * per + (b >> 3);
  if (lin >= MT * NT) { if (!clamp) return false; lin = MT * NT - 1; }
  const int g = lin / (8 * NT), rem = lin - g * 8 * NT;
  const int gsz = min(8, MT - 8 * g);
  nt = rem / gsz; mt = 8 * g + rem - nt * gsz;
  return true;
}
DEV void zero_acc44(f32x4 (&acc)[4][4]) {
#pragma unroll
  for (int i = 0; i < 4; i++)
#pragma unroll
    for (int j = 0; j < 4; j++) acc[i][j] = f32x4{0.f, 0.f, 0.f, 0.f};
}

DEV const float* res_src(const Prm& p, int L, int b, int r) {
  if (r < CTX) return (L == 0 ? p.in[I_CTX] : (const float*)WS_F(O_CS)) + ((size_t)(b * CTX + r)) * D;
  return (L == 0 ? p.in[I_X] : (const float*)p.out) + ((size_t)b * SEQ + (r - CTX)) * D;
}
DEV float* res_dst(const Prm& p, int b, int r) {
  if (r < CTX) return WS_F(O_CS) + ((size_t)(b * CTX + r)) * D;
  return p.out + ((size_t)b * SEQ + (r - CTX)) * D;
}

DEV void ph_ada(const Prm& p) {
  const int tid = otid();
  for (int it = VBX; it < 193; it += VGX) {
    if (it < 192) {
      int L = it / 96, rem = it % 96, ks = rem / 6, cb = rem % 6;
      int j = (cb * 256 + tid) * 4;
      float4 a0 = {0, 0, 0, 0}, a1 = a0, a2 = a0;
      const float* W = p.in[I_WADA] + (size_t)L * D * NMOD;
      for (int k = ks * 64; k < ks * 64 + 64; k++) {
        float4 w = *(const float4*)(W + (size_t)k * NMOD + j);
        float s0 = silu_f(p.in[I_C][k]), s1 = silu_f(p.in[I_C][D + k]), s2 = silu_f(p.in[I_CCTX][k]);
        a0.x += s0 * w.x; a0.y += s0 * w.y; a0.z += s0 * w.z; a0.w += s0 * w.w;
        a1.x += s1 * w.x; a1.y += s1 * w.y; a1.z += s1 * w.z; a1.w += s1 * w.w;
        a2.x += s2 * w.x; a2.y += s2 * w.y; a2.z += s2 * w.z; a2.w += s2 * w.w;
      }
      float* MP = WS_F(O_MODP) + ((size_t)(ks * 2 + L) * 3) * NMOD;
      *(float4*)(MP + j) = a0; *(float4*)(MP + NMOD + j) = a1; *(float4*)(MP + 2 * NMOD + j) = a2;
    } else {
      float2* rcs = (float2*)(p.ws + O_RCS);
      float2* mcs = (float2*)(p.ws + O_MCS);
      for (int idx = tid; idx < 256 * 16; idx += 256) {
        int pos = idx >> 4, i = idx & 15;
        float inv = powf(10000.f, -(float)i / 16.f);
        float ang = (float)pos * inv;
        double t = (double)ang * 0.15915494309189535; t -= floor(t);
        float rr = (float)(t * 6.283185307179586);
        rcs[idx] = make_float2(__cosf(rr), __sinf(rr));
      }
      for (int idx = tid; idx < 256 * 8; idx += 256) {
        int pos = idx >> 3, i = idx & 7;
        float inv = powf(10000.f, -(float)i / 8.f);
        float ang = (float)pos * inv;
        double t = (double)ang * 0.15915494309189535; t -= floor(t);
        float rr = (float)(t * 6.283185307179586);
        mcs[idx] = make_float2(__cosf(rr), __sinf(rr));
      }
    }
  }
}
DEV void ph_ada_reduce(const Prm& p) {
  for (int idx = VBX * 256 + otid(); idx < 2 * 3 * NMOD; idx += VGX * 256) {
    int L = idx / (3 * NMOD), j = idx % NMOD;
    float s = p.in[I_BADA][L * NMOD + j];
    for (int ks = 0; ks < 16; ks++) {
      int r = (idx / NMOD) % 3;
      s += WS_F(O_MODP)[((size_t)(ks * 2 + L) * 3 + r) * NMOD + j];
    }
    WS_F(O_MOD)[idx] = s;
  }
}

DEV void transpose_tile(const float* __restrict__ src, int lds, int N, int k0, int n0, bfr* __restrict__ dst,
                        int ldd, int mode, const float* gain, float* sT) {
  const int tx = otid() & 63, ty = otid() >> 6;
  __syncthreads();
#pragma unroll
  for (int i = 0; i < 16; i++) {
    int k = k0 + ty + 4 * i, n = n0 + tx;
    float v = 0.f;
    if (n < N) { v = src[(size_t)k * lds + n]; if (gain) v *= gain[k]; }
    sT[(ty + 4 * i) * 65 + tx] = v;
  }
  __syncthreads();
#pragma unroll
  for (int i = 0; i < 16; i++) {
    int n = n0 + ty + 4 * i;
    if (n < N) {
      int dr = n;
      if (mode == 1) { int j = n < FFN ? n : n - FFN; dr = (j >> 5) * 64 + (n < FFN ? 0 : 32) + (j & 31); }
      if (mode == 2) { int hd = n >> 7, j = n & 127; dr = j < 64 ? hd * 64 + j : 512 + hd * 64 + (j - 64); }
      dst[(size_t)dr * ldd + k0 + tx] = f2bf(sT[tx * 65 + ty + 4 * i]);
    }
  }
}
DEV void ph_convert(const Prm& p, int L, char* smem) {
  float* sT = (float*)smem;
  constexpr int T0 = 16 * 139, T1 = T0 + 512, T2 = T1 + 256, T3 = T2 + 16 * 88, T4 = T3 + 44 * 16, T5 = T4 + 72,
                T6 = T5 + 64;
  for (int it = VBX; it < T6; it += VGX) {
    if (it < T0) {
      int kt = it % 16, nt = it / 16;
      transpose_tile(p.in[I_WIN] + (size_t)L * D * NIN, NIN, NIN, kt * 64, nt * 64, WS_B(O_WTIN), D, 0, nullptr, sT);
    } else if (it < T1) {
      int q = it - T0, i = q / 128, r = q % 128, kt = r % 8, nt = r / 8;
      transpose_tile(p.in[I_WBR] + ((size_t)L * 4 + i) * 512 * D, D, D, kt * 64, nt * 64,
                     WS_B(O_WTBR) + (size_t)i * D * 512, 512, 0, nullptr, sT);
    } else if (it < T2) {
      int q = it - T1, kt = q % 16, nt = q / 16;
      transpose_tile(p.in[I_WOUT] + (size_t)L * D * D, D, D, kt * 64, nt * 64, WS_B(O_WTOUT), D, 0, nullptr, sT);
    } else if (it < T3) {
      int q = it - T2, kt = q % 16, nt = q / 16;
      transpose_tile(p.in[I_WF1] + (size_t)L * D * 2 * FFN, 2 * FFN, 2 * FFN, kt * 64, nt * 64, WS_B(O_WTF1), D, 1,
                     nullptr, sT);
    } else if (it < T4) {
      int q = it - T3, kt = q % 44, nt = q / 44;
      transpose_tile(p.in[I_WF2] + (size_t)L * FFN * D, D, D, kt * 64, nt * 64, WS_B(O_WTF2), FFN, 0, nullptr, sT);
    } else if (it < T5) {
      int q = it - T4, kt = q % 6, nt = q / 6;
      transpose_tile(p.in[I_WUQ] + (size_t)L * 384 * 768, 768, 768, kt * 64, nt * 64, WS_B(O_WTUQ), 384, 0,
                     p.in[I_QNG] + L * 384, sT);
    } else {
      int q = it - T5, kt = q % 4, nt = q / 4;
      transpose_tile(p.in[I_WUKV] + (size_t)L * 256 * 1024, 1024, 1024, kt * 64, nt * 64, WS_B(O_WTUKV), 256, 2,
                     p.in[I_KVNG] + L * 256, sT);
    }
  }
}

DEV void ph_norm(const Prm& p, int L, int b, int which) {
  const int lane = otid() & 63, wid = otid() >> 6;
  const float* g = p.in[which ? I_N2G : I_N1G] + L * D;
  const int shift = which ? 3 : 0, scale = which ? 4 : 1;
  const int it0 = (which && L == 1) ? CTX / 4 : 0;
  for (int it = VBX + it0; it < ROWS / 4; it += 2 * VGX) {
    const bool hasB = it + VGX < ROWS / 4;
    const int rA = it * 4 + wid, rB = hasB ? (it + VGX) * 4 + wid : rA;
    const float* xA = which ? (const float*)res_dst(p, b, rA) : res_src(p, L, b, rA);
    const float* xB = which ? (const float*)res_dst(p, b, rB) : res_src(p, L, b, rB);
    float4 vA[4], vB[4]; float sA = 0.f, sB = 0.f;
#pragma unroll
    for (int i = 0; i < 4; i++) { vA[i] = *(const float4*)(xA + lane * 4 + 256 * i); vB[i] = *(const float4*)(xB + lane * 4 + 256 * i); }
#pragma unroll
    for (int i = 0; i < 4; i++) {
      sA += vA[i].x * vA[i].x + vA[i].y * vA[i].y + vA[i].z * vA[i].z + vA[i].w * vA[i].w;
      sB += vB[i].x * vB[i].x + vB[i].y * vB[i].y + vB[i].z * vB[i].z + vB[i].w * vB[i].w;
    }
    sA = wave_sum(sA); sB = wave_sum(sB);
    const float rsA = rsqrtf(sA * (1.f / D) + EPS), rsB = rsqrtf(sB * (1.f / D) + EPS);
    const float* mdA = WS_F(O_MOD) + (size_t)(L * 3 + (rA < CTX ? 2 : b)) * NMOD;
    const float* mdB = WS_F(O_MOD) + (size_t)(L * 3 + (rB < CTX ? 2 : b)) * NMOD;
    bfr* hA = WS_B(O_H) + (size_t)rA * D;
    bfr* hB = WS_B(O_H) + (size_t)rB * D;
#pragma unroll
    for (int i = 0; i < 4; i++) {
      int c = lane * 4 + 256 * i;
      float4 gg = *(const float4*)(g + c);
      float4 scA = *(const float4*)(mdA + scale * D + c), shA = *(const float4*)(mdA + shift * D + c);
      float4 scB = *(const float4*)(mdB + scale * D + c), shB = *(const float4*)(mdB + shift * D + c);
      *(uint2*)(hA + c) = pack4(vA[i].x * rsA * gg.x * (1.f + scA.x) + shA.x, vA[i].y * rsA * gg.y * (1.f + scA.y) + shA.y,
                                vA[i].z * rsA * gg.z * (1.f + scA.z) + shA.z, vA[i].w * rsA * gg.w * (1.f + scA.w) + shA.w);
      if (hasB)
        *(uint2*)(hB + c) = pack4(vB[i].x * rsB * gg.x * (1.f + scB.x) + shB.x, vB[i].y * rsB * gg.y * (1.f + scB.y) + shB.y,
                                  vB[i].z * rsB * gg.z * (1.f + scB.z) + shB.z, vB[i].w * rsB * gg.w * (1.f + scB.w) + shB.w);
    }
  }
}
DEV void ph_final_norm(const Prm& p, int b) {
  const int lane = otid() & 63, wid = otid() >> 6;
  const float* g = p.in[I_FNG];
  for (int it = VBX; it < SEQ / 4; it += VGX) {
    float* xr = p.out + ((size_t)b * SEQ + it * 4 + wid) * D;
    float4 v[4]; float ss = 0.f;
#pragma unroll
    for (int i = 0; i < 4; i++) {
      v[i] = *(const float4*)(xr + lane * 4 + 256 * i);
      ss += v[i].x * v[i].x + v[i].y * v[i].y + v[i].z * v[i].z + v[i].w * v[i].w;
    }
    ss = wave_sum(ss);
    float rstd = rsqrtf(ss * (1.f / D) + EPS);
#pragma unroll
    for (int i = 0; i < 4; i++) {
      int c = lane * 4 + 256 * i;
      float4 gg = *(const float4*)(g + c);
      float4 o = {v[i].x * rstd * gg.x, v[i].y * rstd * gg.y, v[i].z * rstd * gg.z, v[i].w * rstd * gg.w};
      *(float4*)(xr + c) = o;
    }
  }
}

#define TILE_IDS                                                                   \
  int tid_ = otid();                           \
  const int tid = tid_, lane = tid & 63, wid = tid >> 6, l15 = lane & 15, quad = lane >> 4, \
            wm = wid >> 1, wn = wid & 1;                                           \
  (void)wm; (void)wn; (void)l15; (void)quad;

#define TILE_IDS3                                                                  \
  const int tid = rtid(), lane = tid & 63, wid = tid >> 6, l15 = lane & 15, quad = lane >> 4, \
            wm = wid >> 2, wn = wid & 3;                                           \
  (void)wm; (void)wn; (void)l15; (void)quad;
DEV void ph_inproj(const Prm& p, char* smem) {
  TILE_IDS3
  constexpr int NT = 19, MT = ROWS / 256;
  const bfr* g_pa = nullptr; const bfr* g_pb = nullptr; uint4 g_pa0{}, g_pa1{}, g_pb0{}, g_pb1{}, g_qa0{}, g_qa1{}, g_qb0{}, g_qb1{}; bool first = true;
  for (int rd = 0; rd * (int)gridDim.x < MT * NT; rd++) {
    int mt, nt; if (!tile_remap(rd, MT, NT, mt, nt, blockIdx.x, gridDim.x, false)) continue;
    int m0 = mt * 256, n0 = nt * 256;
    int mt2, nt2; const bool hasn = tile_remap(rd + 1, MT, NT, mt2, nt2, blockIdx.x, gridDim.x, false);
    if (!hasn) { mt2 = mt; nt2 = nt; }
    f32x4 acc[8][4]; zero_acc84(acc);
    gemm3_mainloop(WS_B(O_H) + (size_t)m0 * D, D, WS_B(O_WTIN) + (size_t)n0 * D, D, D, acc, smem,
                   WS_B(O_H) + (size_t)(mt2 * 256) * D, WS_B(O_WTIN) + (size_t)(nt2 * 256) * D, first, g_pa, g_pb, g_pa0, g_pa1, g_pb0, g_pb1, g_qa0, g_qa1, g_qb0, g_qb1);
    first = !hasn;
#pragma unroll
    for (int mi = 0; mi < 8; mi++)
#pragma unroll
      for (int ni = 0; ni < 4; ni++) {
        int row = m0 + wm * 128 + mi * 16 + l15, col = n0 + wn * 64 + ni * 16 + quad * 4;
        if (col < NU) *(uint2*)(WS_B(O_U) + (size_t)row * NU + col) = pack4(acc[mi][ni][0], acc[mi][ni][1], acc[mi][ni][2], acc[mi][ni][3]);
      }
  }
}
DEV void ph_gates(const Prm& p, int L, char* smem) {
  TILE_IDS3
  constexpr int NT = 16;
  const int mt0 = L == 1 ? 1 : 0, MT = ROWS / 256 - mt0;
  const bfr* g_pa = nullptr; const bfr* g_pb = nullptr; uint4 g_pa0{}, g_pa1{}, g_pb0{}, g_pb1{}, g_qa0{}, g_qa1{}, g_qb0{}, g_qb1{}; bool first = true;
  for (int rd = 0; rd * (int)gridDim.x < MT * NT; rd++) {
    int mt, nt; if (!tile_remap(rd, MT, NT, mt, nt, blockIdx.x, gridDim.x, false)) continue;
    mt += mt0; int m0 = mt * 256, n0 = nt * 256;
    int mt2, nt2; const bool hasn = tile_remap(rd + 1, MT, NT, mt2, nt2, blockIdx.x, gridDim.x, false);
    if (hasn) mt2 += mt0; else { mt2 = mt; nt2 = nt; }
    f32x4 acc[8][4]; zero_acc84(acc);
    gemm3_mainloop(WS_B(O_H) + (size_t)m0 * D, D, WS_B(O_WTIN) + (size_t)(NU + n0) * D, D, D, acc, smem,
                   WS_B(O_H) + (size_t)(mt2 * 256) * D, WS_B(O_WTIN) + (size_t)(NU + nt2 * 256) * D, first, g_pa, g_pb, g_pa0, g_pa1, g_pb0, g_pb1, g_qa0, g_qa1, g_qb0, g_qb1);
    first = !hasn;
#pragma unroll
    for (int mi = 0; mi < 8; mi++)
#pragma unroll
      for (int ni = 0; ni < 4; ni++) {
        int row = m0 + wm * 128 + mi * 16 + l15, col = n0 + wn * 64 + ni * 16 + quad * 4;
        *(uint2*)(WS_B(O_U) + (size_t)row * 4096 + col) =
            pack4(sigm_f(acc[mi][ni][0]), sigm_f(acc[mi][ni][1]), sigm_f(acc[mi][ni][2]), sigm_f(acc[mi][ni][3]));
      }
  }
}
DEV void ph_merge(const Prm& p, int L, char* smem) {
  TILE_IDS
  const int mt0 = L == 1 ? 2 : 0;
  const bfr* g_pa = nullptr; const bfr* g_pb = nullptr; uint4 g_a0{}, g_a1{}, g_b0{}, g_b1{}, g_c0{}, g_c1{}, g_d0{}, g_d1{}; bool first = true;
  const int NT_ = (NCH - mt0) * 8;
  for (int rd = 0; rd * (int)VGX < NT_; rd++) {
    int mt, nt; tile_remap(rd, NCH - mt0, 8, mt, nt, VBX, VGX, true);
    mt += mt0; int m0 = mt * 128, n0 = nt * 128;
    const bool hasn = (rd + 1) * (int)VGX < NT_;
    int mt2 = mt, nt2 = nt; if (hasn) { tile_remap(rd + 1, NCH - mt0, 8, mt2, nt2, VBX, VGX, true); mt2 += mt0; }
    f32x4 macc[4][4]; zero_acc44(macc);
#pragma unroll 1
    for (int i = 0; i < 4; i++) {
      f32x4 acc[4][4]; zero_acc44(acc);
      const bool lastb = i == 3;
      const bfr* nA_ = lastb ? WS_B(O_BR) + (size_t)(mt2 * 128) * 2048 : WS_B(O_BR) + (size_t)m0 * 2048 + (i + 1) * 512;
      const bfr* nB_ = lastb ? WS_B(O_WTBR) + (size_t)(nt2 * 128) * 512 : WS_B(O_WTBR) + ((size_t)(i + 1) * D + n0) * 512;
      gemm4_mainloop(WS_B(O_BR) + (size_t)m0 * 2048 + i * 512, 2048, WS_B(O_WTBR) + ((size_t)i * D + n0) * 512, 512, 512, acc, smem,
                     nA_, nB_, first, g_pa, g_pb, g_a0, g_a1, g_b0, g_b1, g_c0, g_c1, g_d0, g_d1);
      first = lastb && !hasn;
#pragma unroll
      for (int mi = 0; mi < 4; mi++)
#pragma unroll
        for (int ni = 0; ni < 4; ni++) {
          int row = m0 + wm * 64 + mi * 16 + l15, col = n0 + wn * 64 + ni * 16 + quad * 4;
          uint2 gv = *(const uint2*)(WS_B(O_U) + (size_t)row * 4096 + i * D + col);
          float gf[4]; unpack4(gv, gf);
#pragma unroll
          for (int r = 0; r < 4; r++) macc[mi][ni][r] += gf[r] * acc[mi][ni][r];
        }
    }
#pragma unroll
    for (int mi = 0; mi < 4; mi++)
#pragma unroll
      for (int ni = 0; ni < 4; ni++) {
        int row = m0 + wm * 64 + mi * 16 + l15, col = n0 + wn * 64 + ni * 16 + quad * 4;
        *(uint2*)(WS_B(O_H) + (size_t)row * D + col) = pack4(macc[mi][ni][0], macc[mi][ni][1], macc[mi][ni][2], macc[mi][ni][3]);
      }
  }
}
DEV void ph_resgemm(const Prm& p, int L, int b, const bfr* A, int lda, const bfr* Wt, int K, int gate_idx,
                    bool from_src, char* smem) {
  TILE_IDS3
  const int mt0 = L == 1 ? 1 : 0, MT = ROWS / 256 - mt0;
  const bfr* g_pa = nullptr; const bfr* g_pb = nullptr; uint4 g_pa0{}, g_pa1{}, g_pb0{}, g_pb1{}, g_qa0{}, g_qa1{}, g_qb0{}, g_qb1{}; bool first = true;
  for (int rd = 0; rd * (int)gridDim.x < MT * 4; rd++) {
    int mt, nt; if (!tile_remap(rd, MT, 4, mt, nt, blockIdx.x, gridDim.x, false)) continue;
    mt += mt0; int m0 = mt * 256, n0 = nt * 256;
    int mt2, nt2; const bool hasn = tile_remap(rd + 1, MT, 4, mt2, nt2, blockIdx.x, gridDim.x, false);
    if (hasn) mt2 += mt0; else { mt2 = mt; nt2 = nt; }
    f32x4 acc[8][4]; zero_acc84(acc);
    gemm3_mainloop(A + (size_t)m0 * lda, lda, Wt + (size_t)n0 * K, K, K, acc, smem,
                   A + (size_t)(mt2 * 256) * lda, Wt + (size_t)(nt2 * 256) * K, first, g_pa, g_pb, g_pa0, g_pa1, g_pb0, g_pb1, g_qa0, g_qa1, g_qb0, g_qb1);
    first = !hasn;
#pragma unroll
    for (int mi = 0; mi < 8; mi++) {
      int row = m0 + wm * 128 + mi * 16 + l15;
      const float* rs = from_src ? res_src(p, L, b, row) : (const float*)res_dst(p, b, row);
      float* rd = res_dst(p, b, row);
      const float* md = WS_F(O_MOD) + (size_t)(L * 3 + (row < CTX ? 2 : b)) * NMOD + gate_idx * D;
#pragma unroll
      for (int ni = 0; ni < 4; ni++) {
        int col = n0 + wn * 64 + ni * 16 + quad * 4;
        float4 x = *(const float4*)(rs + col), g = *(const float4*)(md + col);
        float4 o = {x.x + g.x * acc[mi][ni][0], x.y + g.y * acc[mi][ni][1], x.z + g.z * acc[mi][ni][2], x.w + g.w * acc[mi][ni][3]};
        *(float4*)(rd + col) = o;
      }
    }
  }
}
DEV void ph_ffn1(const Prm& p, int L, char* smem) {
  TILE_IDS3
  constexpr int NT = 22;
  const int mt0 = L == 1 ? 1 : 0, MT = ROWS / 256 - mt0;
  const bfr* g_pa = nullptr; const bfr* g_pb = nullptr; uint4 g_pa0{}, g_pa1{}, g_pb0{}, g_pb1{}, g_qa0{}, g_qa1{}, g_qb0{}, g_qb1{}; bool first = true;
  for (int rd = 0; rd * (int)gridDim.x < MT * NT; rd++) {
    int mt, nt; if (!tile_remap(rd, MT, NT, mt, nt, blockIdx.x, gridDim.x, false)) continue;
    mt += mt0; int m0 = mt * 256, n0 = nt * 256;
    int mt2, nt2; const bool hasn = tile_remap(rd + 1, MT, NT, mt2, nt2, blockIdx.x, gridDim.x, false);
    if (hasn) mt2 += mt0; else { mt2 = mt; nt2 = nt; }
    f32x4 acc[8][4]; zero_acc84(acc);
    gemm3_mainloop(WS_B(O_H) + (size_t)m0 * D, D, WS_B(O_WTF1) + (size_t)n0 * D, D, D, acc, smem,
                   WS_B(O_H) + (size_t)(mt2 * 256) * D, WS_B(O_WTF1) + (size_t)(nt2 * 256) * D, first, g_pa, g_pb, g_pa0, g_pa1, g_pb0, g_pb1, g_qa0, g_qa1, g_qb0, g_qb1);
    first = !hasn;
    int j0 = ((n0 + wn * 64) >> 6) * 32;
#pragma unroll
    for (int mi = 0; mi < 8; mi++)
#pragma unroll
      for (int ni = 0; ni < 2; ni++) {
        int row = m0 + wm * 128 + mi * 16 + l15, col = j0 + ni * 16 + quad * 4;
        float f[4];
#pragma unroll
        for (int r = 0; r < 4; r++) f[r] = silu_f(acc[mi][ni + 2][r]) * acc[mi][ni][r];
        *(uint2*)(WS_B(O_U) + (size_t)row * FFN + col) = pack4(f[0], f[1], f[2], f[3]);
      }
  }
}

DEV void conv_module_item(const Prm& p, int L, int grp, char* smem) {
  const int tid = otid(), lane = tid & 63, wid = tid >> 6;
  unsigned* sG = (unsigned*)smem;
  float* sR = (float*)(smem + 47104);
  const int t0 = grp * 16, seg0 = t0 < CTX ? 0 : CTX, seg1 = t0 < CTX ? CTX : ROWS;
  const int c = tid * 2;
  const bfr* U_ = WS_B(O_U);
  __syncthreads();
#pragma unroll 8
  for (int rr = 0; rr < 46; rr++) {
    const int r = t0 - 15 + rr, rc = min(max(r, seg0), seg1 - 1);
    const unsigned aa = *(const unsigned*)(U_ + (size_t)rc * NU + c), gg = *(const unsigned*)(U_ + (size_t)rc * NU + 512 + c);
    const unsigned v = pack2(lo16(aa) * sigm_f(lo16(gg)), hi16(aa) * sigm_f(hi16(gg)));
    sG[rr * 256 + tid] = (r == rc) ? v : 0u;
  }
  __syncthreads();
  const float* cw = p.in[I_CONVW] + (size_t)L * 31 * 512 + c;
  float2 cb = *(const float2*)(p.in[I_CONVB] + L * 512 + c);
  float a0[16], a1[16];
#pragma unroll
  for (int o = 0; o < 16; o++) { a0[o] = cb.x; a1[o] = cb.y; }
  float2 wj[31];
#pragma unroll
  for (int j = 0; j < 31; j++) wj[j] = *(const float2*)(cw + j * 512);
#pragma unroll
  for (int j = 0; j < 31; j++) {
    const float2 w = wj[j];
#pragma unroll
    for (int o = 0; o < 16; o++) {
      unsigned vv = sG[(o + j) * 256 + tid];
      a0[o] += w.x * lo16(vv); a1[o] += w.y * hi16(vv);
    }
  }
  float mu[16], rs[16];
#pragma unroll
  for (int o = 0; o < 16; o++) { float s = wave_sum(a0[o] + a1[o]); if (lane == 0) sR[wid * 16 + o] = s; }
  __syncthreads();
#pragma unroll
  for (int o = 0; o < 16; o++) mu[o] = (sR[o] + sR[16 + o] + sR[32 + o] + sR[48 + o]) * (1.f / 512.f);
  __syncthreads();
#pragma unroll
  for (int o = 0; o < 16; o++) {
    float d0 = a0[o] - mu[o], d1 = a1[o] - mu[o];
    float s = wave_sum(d0 * d0 + d1 * d1);
    if (lane == 0) sR[wid * 16 + o] = s;
  }
  __syncthreads();
#pragma unroll
  for (int o = 0; o < 16; o++) rs[o] = rsqrtf((sR[o] + sR[16 + o] + sR[32 + o] + sR[48 + o]) * (1.f / 512.f) + EPS);
  float2 lg = *(const float2*)(p.in[I_CLNG] + L * 512 + c), lb = *(const float2*)(p.in[I_CLNB] + L * 512 + c);
#pragma unroll
  for (int o = 0; o < 16; o++) {
    float y0 = (a0[o] - mu[o]) * rs[o] * lg.x + lb.x, y1 = (a1[o] - mu[o]) * rs[o] * lg.y + lb.y;
    *(unsigned*)(WS_B(O_BR) + (size_t)(t0 + o) * 2048 + c) = pack2(silu_f(y0), silu_f(y1));
  }
}
DEV void xbc_conv_item(const Prm& p, int L, int grp) {
  const int tid = otid();
  const int t0 = grp * 16, seg0 = t0 < CTX ? 0 : CTX, seg1 = t0 < CTX ? CTX : ROWS;
  const int c = tid * 4;
  float4 w[5];
#pragma unroll
  for (int j = 0; j < 5; j++) w[j] = *(const float4*)(p.in[I_SCW] + ((size_t)L * 5 + j) * 1024 + c);
  float4 bb = *(const float4*)(p.in[I_SCB] + L * 1024 + c);
  float4 a[16];
#pragma unroll
  for (int o = 0; o < 16; o++) a[o] = bb;
  const bfr* U_ = WS_B(O_U);
#pragma unroll
  for (int ii = 0; ii < 20; ii++) {
    const int r = t0 - 2 + ii, rc = min(max(r, seg0), seg1 - 1);
    float v[4];
    { uint2 t = *(const uint2*)(U_ + (size_t)rc * NU + C_XBC + c); if (r != rc) { t.x = 0u; t.y = 0u; } unpack4(t, v); }
#pragma unroll
    for (int o = 0; o < 16; o++) {
      if (ii - o >= 0 && ii - o <= 4) {
        a[o].x += w[ii - o].x * v[0]; a[o].y += w[ii - o].y * v[1]; a[o].z += w[ii - o].z * v[2]; a[o].w += w[ii - o].w * v[3];
      }
    }
  }
#pragma unroll
  for (int o = 0; o < 16; o++)
    *(uint2*)(WS_B(O_XBC) + (size_t)(t0 + o) * 1024 + c) = pack4(silu_f(a[o].x), silu_f(a[o].y), silu_f(a[o].z), silu_f(a[o].w));
}
DEV void mla_pre_item(const Prm& p, int it) {
  const int lane = otid() & 63, wid = otid() >> 6;
  const bfr* U_ = WS_B(O_U);
  const float2* mcs = (const float2*)(p.ws + O_MCS);
#pragma unroll 4
  for (int rr = 0; rr < 16; rr++) {
    int r = it * 64 + wid * 16 + rr;
    const bfr* ur = U_ + (size_t)r * NU;
    float sq = 0.f, sk = 0.f;
#pragma unroll
    for (int i = 0; i < 3; i++) { unsigned t = *(const unsigned*)(ur + C_CQ + lane * 2 + 128 * i); float x = lo16(t), y = hi16(t); sq += x * x + y * y; }
    { uint2 t = *(const uint2*)(ur + C_CKV + lane * 4); float f[4]; unpack4(t, f); sk = f[0] * f[0] + f[1] * f[1] + f[2] * f[2] + f[3] * f[3]; }
    sq = wave_sum(sq); sk = wave_sum(sk);
    if (lane == 0) { WS_F(O_RSQ)[r] = rsqrtf(sq * (1.f / 384.f) + EPS); WS_F(O_RSKV)[r] = rsqrtf(sk * (1.f / 256.f) + EPS); }
    if (lane < 16) {
      float x1 = bf2f(ur[C_KR + lane]), x2 = bf2f(ur[C_KR + 16 + lane]);
      float o1 = x1, o2 = x2;
      if (r >= CTX) {
        int t = r - CTX, pos = lane < 8 ? (t >> 6) : (t & 63);
        float2 cs = mcs[pos * 8 + (lane & 7)];
        o1 = x1 * cs.x - x2 * cs.y; o2 = x1 * cs.y + x2 * cs.x;
      }
      WS_B(O_KROPE)[(size_t)r * 32 + lane] = f2bf(o1);
      WS_B(O_KROPE)[(size_t)r * 32 + 16 + lane] = f2bf(o2);
    }
  }
}
DEV void ph_local(const Prm& p, int L, char* smem) {
  constexpr int NG = ROWS / 16;
  for (int it = VBX; it < 2 * NG + 260; it += VGX) {
#ifdef ONLY2
    it = ONLY2 == 0 ? 0 : ONLY2 == 1 ? NG : 2 * NG;
#endif
    if (it < NG) conv_module_item(p, L, it, smem);
    else if (it < 2 * NG) xbc_conv_item(p, L, it - NG);
    else mla_pre_item(p, it - 2 * NG);
  }
}

DEV void uq_tile(const Prm& p, int it, char* smem) {
  TILE_IDS
  int mt = it / 6, nt = it % 6, m0 = mt * 128, n0 = nt * 128;
  f32x4 acc[4][4]; zero_acc44(acc);
  gemm4_single(WS_B(O_U) + (size_t)m0 * NU + C_CQ, NU, WS_B(O_WTUQ) + (size_t)n0 * 384, 384, 384, acc, smem);
#pragma unroll
  for (int mi = 0; mi < 4; mi++) {
    int row = m0 + wm * 64 + mi * 16 + l15;
    float rs = WS_F(O_RSQ)[row];
#pragma unroll
    for (int ni = 0; ni < 4; ni++) {
      int col = n0 + wn * 64 + ni * 16 + quad * 4;
      *(uint2*)(WS_B(O_Q) + (size_t)row * 768 + col) = pack4(rs * acc[mi][ni][0], rs * acc[mi][ni][1], rs * acc[mi][ni][2], rs * acc[mi][ni][3]);
    }
  }
}
DEV void ukn_tile(const Prm& p, int it, char* smem) {
  TILE_IDS
  int mt = it / 4, nt = it % 4, m0 = mt * 128, n0 = nt * 128;
  f32x4 acc[4][4]; zero_acc44(acc);
  gemm4_single(WS_B(O_U) + (size_t)m0 * NU + C_CKV, NU, WS_B(O_WTUKV) + (size_t)n0 * 256, 256, 256, acc, smem);
#pragma unroll
  for (int mi = 0; mi < 4; mi++) {
    int row = m0 + wm * 64 + mi * 16 + l15;
    float rs = WS_F(O_RSKV)[row];
#pragma unroll
    for (int ni = 0; ni < 4; ni++) {
      int col = n0 + wn * 64 + ni * 16 + quad * 4;
      *(uint2*)(WS_B(O_KN) + (size_t)row * 512 + col) = pack4(rs * acc[mi][ni][0], rs * acc[mi][ni][1], rs * acc[mi][ni][2], rs * acc[mi][ni][3]);
    }
  }
}
DEV void uvt_tile(const Prm& p, int it, char* smem) {
  TILE_IDS
  int vt = it / NCH, tt = it % NCH, m0 = vt * 128, n0 = tt * 128;
  f32x4 acc[4][4]; zero_acc44(acc);
  gemm4_single(WS_B(O_WTUKV) + (size_t)(512 + m0) * 256, 256, WS_B(O_U) + (size_t)n0 * NU + C_CKV, NU, 256, acc, smem);
#pragma unroll
  for (int ni = 0; ni < 4; ni++) {
    int tok = n0 + wn * 64 + ni * 16 + quad * 4;
    float4 rs = *(const float4*)(WS_F(O_RSKV) + tok);
#pragma unroll
    for (int mi = 0; mi < 4; mi++) {
      int vrow = m0 + wm * 64 + mi * 16 + l15;
      *(uint2*)(WS_B(O_VT) + (size_t)vrow * ROWS + tok) = pack4(rs.x * acc[mi][ni][0], rs.y * acc[mi][ni][1], rs.z * acc[mi][ni][2], rs.w * acc[mi][ni][3]);
    }
  }
}

DEV void chunk_decay(const Prm& p, int L, float raw, int h, float* sCum, float* sDt, float* sTmp) {
  const int tid = otid(), dir = tid >> 7, i = tid & 127, l = dir ? 127 - i : i;
  float dt = softplus_f(raw + p.in[I_DTB][L * 16 + dir * 8 + h]);
  float v = -dt * expf(p.in[I_ALOG][L * 16 + dir * 8 + h]);
#pragma unroll
  for (int o = 1; o < 64; o <<= 1) { float t = __shfl_up(v, o); if ((tid & 63) >= o) v += t; }
  if ((tid & 63) == 63) sTmp[tid >> 6] = v;
  __syncthreads();
  if (tid & 64) v += sTmp[(tid >> 6) - 1];
  sCum[dir * 128 + l] = v; sDt[dir * 128 + l] = dt;
  __syncthreads();
}

DEV void ssm_state_item(const Prm& p, int L, int it, char* smem) {
  TILE_IDS
  bfr* sBT = (bfr*)smem;
  bfr* sXT = sBT + 128 * 136;
  float* sCum = (float*)(smem + 52224); float* sDt = sCum + 256; float* sTmp = sDt + 256;
  const int c = it >> 2, g = (it >> 1) & 1, hp = it & 1, r0 = c * 128;
  const bfr* X_ = WS_B(O_XBC);
  unsigned rawp;
  { const int dir_ = tid >> 7, i_ = tid & 127, l_ = dir_ ? 127 - i_ : i_;
    rawp = *(const unsigned*)(WS_B(O_U) + (size_t)(r0 + l_) * NU + C_DT + dir_ * 8 + g * 4 + hp * 2); }
  __syncthreads();
#pragma unroll 4
  for (int u = tid; u < 1024; u += 256) {
    int lp = u & 63, nc = u >> 6;
    const bfr* src = X_ + (size_t)(r0 + 2 * lp) * 1024 + 512 + g * 128 + nc * 8;
    uint4 a = *(const uint4*)src, b2 = *(const uint4*)(src + 1024);
#pragma unroll
    for (int e = 0; e < 8; e++) *(unsigned*)(sBT + (nc * 8 + e) * 136 + 2 * lp) = elem16(a, e) | (elem16(b2, e) << 16);
  }
  for (int hh = 0; hh < 2; hh++) {
    const int h = g * 4 + hp * 2 + hh;
    uint4 xs0, xs1, xs2, xs3;
    { const bfr* s0_ = X_ + (size_t)(r0 + 2 * (tid & 63)) * 1024 + h * 64 + (tid >> 6) * 8;
      xs0 = *(const uint4*)s0_; xs1 = *(const uint4*)(s0_ + 1024); xs2 = *(const uint4*)(s0_ + 32); xs3 = *(const uint4*)(s0_ + 1024 + 32); }
    chunk_decay(p, L, hh ? hi16(rawp) : lo16(rawp), h, sCum, sDt, sTmp);
    const float totf = sCum[127], totb = sCum[128];
    if (tid == 0) { WS_F(O_TOT)[(0 * NCH + c) * 8 + h] = __expf(totf); WS_F(O_TOT)[(1 * NCH + c) * 8 + h] = __expf(totb); }
    for (int dir = 0; dir < 2; dir++) {
      const float tot = dir ? totb : totf;
      {
        const int lp = tid & 63, pc = tid >> 6, l0 = 2 * lp;
        float w0 = __expf(tot - sCum[dir * 128 + l0]) * sDt[dir * 128 + l0];
        float w1 = __expf(tot - sCum[dir * 128 + l0 + 1]) * sDt[dir * 128 + l0 + 1];
        float fa[8], fb[8], fc[8], fd[8]; unpack8(xs0, fa); unpack8(xs1, fb); unpack8(xs2, fc); unpack8(xs3, fd);
#pragma unroll
        for (int e = 0; e < 8; e++) {
          *(unsigned*)(sXT + (pc * 8 + e) * 136 + l0) = pack2(fa[e] * w0, fb[e] * w1);
          *(unsigned*)(sXT + ((pc + 4) * 8 + e) * 136 + l0) = pack2(fc[e] * w0, fd[e] * w1);
        }
      }
      __syncthreads();
      f32x4 acc[4][2];
#pragma unroll
      for (int i = 0; i < 4; i++) { acc[i][0] = f32x4{0, 0, 0, 0}; acc[i][1] = f32x4{0, 0, 0, 0}; }
      lds_gemm<4, 2, 4>(sXT, 136, sBT + (wid * 32) * 136, 136, acc);
      float* dst = WS_F(O_SST) + ((size_t)((dir * NCH + c) * 8 + h)) * 8192;
#pragma unroll
      for (int mi = 0; mi < 4; mi++)
#pragma unroll
        for (int ni = 0; ni < 2; ni++) *(f32x4*)(dst + (mi * 16 + l15) * 128 + wid * 32 + ni * 16 + quad * 4) = acc[mi][ni];
      __syncthreads();
    }
  }
}

DEV void ret_rope8(const Prm& p, int r, int nc, const uint4& c1, const uint4& c2, float scale, float (&o1)[8], float (&o2)[8]) {
  float x1[8], x2[8]; unpack8(c1, x1); unpack8(c2, x2);
  if (r >= CTX) {
    const float2* rcs = (const float2*)(p.ws + O_RCS);
    int t = r - CTX, pos = nc < 2 ? (t >> 6) : (t & 63);
    const float2* cs = rcs + pos * 16 + (nc & 1) * 8;
#pragma unroll
    for (int e = 0; e < 8; e++) { float2 v = cs[e]; o1[e] = (x1[e] * v.x - x2[e] * v.y) * scale; o2[e] = (x1[e] * v.y + x2[e] * v.x) * scale; }
  } else {
#pragma unroll
    for (int e = 0; e < 8; e++) { o1[e] = x1[e] * scale; o2[e] = x2[e] * scale; }
  }
}

DEV void ret_state_item(const Prm& p, int L, int it, char* smem) {
  TILE_IDS
  bfr* sVT = (bfr*)smem;
  bfr* sKT = sVT + 128 * 136;
  const int c = it >> 2, h = it & 3, r0 = c * 128;
  const bfr* U_ = WS_B(O_U);
  const float lgf = -expf(p.in[I_RDEC][L * 8 + h]), lgb = -expf(p.in[I_RDEC][L * 8 + 4 + h]);
  __syncthreads();
#pragma unroll 4
  for (int u = tid; u < 1024; u += 256) {
    int lp = u & 63, pc = u >> 6;
    const bfr* src = U_ + (size_t)(r0 + 2 * lp) * NU + C_RV + h * 128 + pc * 8;
    uint4 a = *(const uint4*)src, b2 = *(const uint4*)(src + NU);
#pragma unroll
    for (int e = 0; e < 8; e++) *(unsigned*)(sVT + (pc * 8 + e) * 136 + 2 * lp) = elem16(a, e) | (elem16(b2, e) << 16);
  }
  uint4 a1, a2, b1, b2;
  { const bfr* src = U_ + (size_t)(r0 + 2 * (tid & 63)) * NU + C_RK + h * 64 + (tid >> 6) * 8;
    a1 = *(const uint4*)src; a2 = *(const uint4*)(src + 32); b1 = *(const uint4*)(src + NU); b2 = *(const uint4*)(src + NU + 32); }
  for (int dir = 0; dir < 2; dir++) {
    {
      int lp = tid & 63, nc = tid >> 6, l0 = 2 * lp;
      float w0 = dir ? __expf((float)l0 * lgb) : __expf((float)(127 - l0) * lgf);
      float w1 = dir ? __expf((float)(l0 + 1) * lgb) : __expf((float)(126 - l0) * lgf);
      float p1[8], p2[8], q1[8], q2[8];
      ret_rope8(p, r0 + l0, nc, a1, a2, 0.125f * w0, p1, p2);
      ret_rope8(p, r0 + l0 + 1, nc, b1, b2, 0.125f * w1, q1, q2);
#pragma unroll
      for (int e = 0; e < 8; e++) {
        *(unsigned*)(sKT + (nc * 8 + e) * 136 + l0) = pack2(p1[e], q1[e]);
        *(unsigned*)(sKT + (32 + nc * 8 + e) * 136 + l0) = pack2(p2[e], q2[e]);
      }
    }
    __syncthreads();
    f32x4 acc[2][4];
#pragma unroll
    for (int i = 0; i < 2; i++)
#pragma unroll
      for (int j = 0; j < 4; j++) acc[i][j] = f32x4{0, 0, 0, 0};
    lds_gemm<2, 4, 4>(sVT + (wid * 32) * 136, 136, sKT, 136, acc);
    float* dst = WS_F(O_RST) + ((size_t)((dir * NCH + c) * 4 + h)) * 8192;
#pragma unroll
    for (int mi = 0; mi < 2; mi++)
#pragma unroll
      for (int ni = 0; ni < 4; ni++) *(f32x4*)(dst + (wid * 32 + mi * 16 + l15) * 64 + ni * 16 + quad * 4) = acc[mi][ni];
    __syncthreads();
  }
}
DEV void ph_states(const Prm& p, int L, char* smem) {
  constexpr int N0 = NCH * 6, N1 = N0 + NCH * 8, N2 = N1 + NCH * 4, N3 = N2 + NCH * 4;
  for (int it = VBX; it < N3; it += VGX) {
#ifdef ONLY3
    it = ONLY3 == 0 ? 0 : ONLY3 == 1 ? N0 : ONLY3 == 2 ? N1 : N2;
#endif
    if (it < N0) uq_tile(p, it, smem);
    else if (it < N1) { if (it - N0 < NCH * 4) ukn_tile(p, it - N0, smem); else uvt_tile(p, it - N0 - NCH * 4, smem); }
    else if (it < N2) ssm_state_item(p, L, it - N1, smem);
    else ret_state_item(p, L, it - N2, smem);
  }
}

DEV int chunk_order(int dir, int i) { return dir == 0 ? i : (i < 2 ? 1 - i : 131 - i); }
DEV void ph_scan(const Prm& p, int L) {
  for (int it = VBX; it < 192; it += VGX) {
    if (it < 128) {
      int gid = it * 256 + otid(), dir = gid >> 14, h = (gid >> 11) & 7, e4 = gid & 2047;
      float4 hr = {0, 0, 0, 0};
      for (int i0 = 0; i0 < NCH; i0 += 13) {
        float4 s[13]; float g[13];
#pragma unroll
        for (int j = 0; j < 13; j++) {
          int c = chunk_order(dir, i0 + j);
          s[j] = *(const float4*)(WS_F(O_SST) + ((size_t)((dir * NCH + c) * 8 + h)) * 8192 + e4 * 4);
          g[j] = WS_F(O_TOT)[(dir * NCH + c) * 8 + h];
        }
#pragma unroll
        for (int j = 0; j < 13; j++) {
          int c = chunk_order(dir, i0 + j);
          *(float4*)(WS_F(O_SST) + ((size_t)((dir * NCH + c) * 8 + h)) * 8192 + e4 * 4) = hr;
          hr.x = g[j] * hr.x + s[j].x; hr.y = g[j] * hr.y + s[j].y; hr.z = g[j] * hr.z + s[j].z; hr.w = g[j] * hr.w + s[j].w;
        }
      }
    } else {
      int gid = (it - 128) * 256 + otid(), dir = gid >> 13, h = (gid >> 11) & 3, e4 = gid & 2047;
      const float G = expf(-128.f * expf(p.in[I_RDEC][L * 8 + dir * 4 + h]));
      float4 hr = {0, 0, 0, 0};
      for (int i0 = 0; i0 < NCH; i0 += 13) {
        float4 s[13];
#pragma unroll
        for (int j = 0; j < 13; j++) {
          int c = chunk_order(dir, i0 + j);
          s[j] = *(const float4*)(WS_F(O_RST) + ((size_t)((dir * NCH + c) * 4 + h)) * 8192 + e4 * 4);
        }
#pragma unroll
        for (int j = 0; j < 13; j++) {
          int c = chunk_order(dir, i0 + j);
          *(float4*)(WS_F(O_RST) + ((size_t)((dir * NCH + c) * 4 + h)) * 8192 + e4 * 4) = hr;
          hr.x = G * hr.x + s[j].x; hr.y = G * hr.y + s[j].y; hr.z = G * hr.z + s[j].z; hr.w = G * hr.w + s[j].w;
        }
      }
    }
  }
}

DEV void ssm_out_item(const Prm& p, int L, int it, char* smem) {
  TILE_IDS
  bfr* sC = (bfr*)smem;
  bfr* sB = sC + 64 * 136;
  bfr* sP = sB; bfr* sX = sB + 64 * 136;
  float* sCum = (float*)(smem + 52224); float* sDt = sCum + 256; float* sSS = sDt + 256; float* sTmp = sSS + 64;
  const int c = it >> 2, g = (it >> 1) & 1, lh = it & 1, r0 = c * 128, rq0 = r0 + lh * 64;
  const bfr* X_ = WS_B(O_XBC);
  const bfr* U_ = WS_B(O_U);
  uint2 rawq;
  { const int dir_ = tid >> 7, i_ = tid & 127, l_ = dir_ ? 127 - i_ : i_;
    rawq = *(const uint2*)(U_ + (size_t)(r0 + l_) * NU + C_DT + dir_ * 8 + g * 4); }
  uint4 xr0, xr1, xr2, xr3;
#define SSM_XLOAD(h_) do { \
    const bfr* s0_ = X_ + (size_t)(r0 + 2 * (tid & 63)) * 1024 + (h_) * 64 + (tid >> 6) * 8; \
    xr0 = *(const uint4*)s0_; xr1 = *(const uint4*)(s0_ + 1024); xr2 = *(const uint4*)(s0_ + 32); xr3 = *(const uint4*)(s0_ + 1024 + 32); } while (0)
  SSM_XLOAD(g * 4);
  __syncthreads();
#pragma unroll 4
  for (int u = tid; u < 1024; u += 256) {
    int row = u >> 4, ch = u & 15;
    *(uint4*)(sC + row * 136 + ch * 8) = *(const uint4*)(X_ + (size_t)(rq0 + row) * 1024 + 768 + g * 128 + ch * 8);
  }
#pragma unroll 4
  for (int u = tid; u < 2048; u += 256) {
    int row = u >> 4, ch = u & 15;
    *(uint4*)(sB + row * 136 + ch * 8) = *(const uint4*)(X_ + (size_t)(r0 + row) * 1024 + 512 + g * 128 + ch * 8);
  }
  if (tid < 64) sSS[tid] = 0.f;
  __syncthreads();
  f32x4 cb[2][4];
#pragma unroll
  for (int i = 0; i < 2; i++)
#pragma unroll
    for (int j = 0; j < 4; j++) cb[i][j] = f32x4{0, 0, 0, 0};
  lds_gemm<2, 4, 4>(sC + (wm * 32) * 136, 136, sB + (wn * 64) * 136, 136, cb);
#pragma unroll 1
  for (int hh = 0; hh < 4; hh++) {
    f32x4 y[2][2];
    const int h = g * 4 + hh;
    __syncthreads();
    chunk_decay(p, L, hh == 0 ? lo16(rawq.x) : hh == 1 ? hi16(rawq.x) : hh == 2 ? lo16(rawq.y) : hi16(rawq.y), h, sCum, sDt, sTmp);
#pragma unroll
    for (int mi = 0; mi < 2; mi++) {
      const int rl = wm * 32 + mi * 16 + l15, ll = lh * 64 + rl;
      const float cfl = sCum[ll], cbl = sCum[128 + ll];
#pragma unroll
      for (int ni = 0; ni < 4; ni++) {
        const int s0 = wn * 64 + ni * 16 + quad * 4;
        float pv[4];
#pragma unroll
        for (int r = 0; r < 4; r++) {
          int s = s0 + r;
          float ef = (s <= ll) ? __expf(cfl - sCum[s]) * sDt[s] : 0.f;
          float eb = (s >= ll) ? __expf(cbl - sCum[128 + s]) * sDt[128 + s] : 0.f;
          pv[r] = cb[mi][ni][r] * (ef + eb);
        }
        *(uint2*)(sP + rl * 136 + s0) = pack4(pv[0], pv[1], pv[2], pv[3]);
      }
    }
    {
      const int lp = tid & 63, pc = tid >> 6;
#pragma unroll
      for (int e = 0; e < 8; e++) {
        *(unsigned*)(sX + (pc * 8 + e) * 136 + 2 * lp) = elem16(xr0, e) | (elem16(xr1, e) << 16);
        *(unsigned*)(sX + ((pc + 4) * 8 + e) * 136 + 2 * lp) = elem16(xr2, e) | (elem16(xr3, e) << 16);
      }
      if (hh < 3) SSM_XLOAD(h + 1);
    }
    __syncthreads();
#pragma unroll
    for (int i = 0; i < 2; i++) { y[i][0] = f32x4{0, 0, 0, 0}; y[i][1] = f32x4{0, 0, 0, 0}; }
    float4 hreg[8];
    {
      const float* hsrc = WS_F(O_SST) + ((size_t)((0 * NCH + c) * 8 + h)) * 8192;
#pragma unroll
      for (int k = 0; k < 8; k++) { int u = tid + 256 * k; hreg[k] = *(const float4*)(hsrc + (u >> 5) * 128 + (u & 31) * 4); }
    }
    lds_gemm<2, 2, 4>(sP + (wm * 32) * 136, 136, sX + (wn * 32) * 136, 136, y);
#pragma unroll
    for (int dir = 0; dir < 2; dir++) {
      __syncthreads();
#pragma unroll
      for (int k = 0; k < 8; k++) { int u = tid + 256 * k; *(uint2*)(sX + (u >> 5) * 136 + (u & 31) * 4) = pack4(hreg[k].x, hreg[k].y, hreg[k].z, hreg[k].w); }
      if (dir == 0) {
        const float* hsrc = WS_F(O_SST) + ((size_t)((1 * NCH + c) * 8 + h)) * 8192;
#pragma unroll
        for (int k = 0; k < 8; k++) { int u = tid + 256 * k; hreg[k] = *(const float4*)(hsrc + (u >> 5) * 128 + (u & 31) * 4); }
      }
      __syncthreads();
      f32x4 t[2][2];
#pragma unroll
      for (int i = 0; i < 2; i++) { t[i][0] = f32x4{0, 0, 0, 0}; t[i][1] = f32x4{0, 0, 0, 0}; }
      lds_gemm<2, 2, 4>(sC + (wm * 32) * 136, 136, sX + (wn * 32) * 136, 136, t);
#pragma unroll
      for (int mi = 0; mi < 2; mi++) {
        float e = __expf(sCum[dir * 128 + lh * 64 + wm * 32 + mi * 16 + l15]);
#pragma unroll
        for (int ni = 0; ni < 2; ni++)
#pragma unroll
          for (int r = 0; r < 4; r++) y[mi][ni][r] += e * t[mi][ni][r];
      }
    }
    const float Dh = p.in[I_SSMD][L * 8 + h];
#pragma unroll
    for (int mi = 0; mi < 2; mi++) {
      const int rl = wm * 32 + mi * 16 + l15, row = rq0 + rl;
      float part = 0.f;
#pragma unroll
      for (int ni = 0; ni < 2; ni++) {
        int p0 = wn * 32 + ni * 16 + quad * 4;
        float xf[4], zf[4];
        unpack4(*(const uint2*)(X_ + (size_t)row * 1024 + h * 64 + p0), xf);
        unpack4(*(const uint2*)(U_ + (size_t)row * NU + C_Z + h * 64 + p0), zf);
#pragma unroll
        for (int r = 0; r < 4; r++) {
          float v = (y[mi][ni][r] + Dh * xf[r]) * silu_f(zf[r]);
          y[mi][ni][r] = v; part += v * v;
        }
      }
      part += __shfl_xor(part, 16); part += __shfl_xor(part, 32);
      if (quad == 0) atomicAdd(&sSS[rl], part);
#pragma unroll
      for (int ni = 0; ni < 2; ni++) {
        int ch = hh * 64 + wn * 32 + ni * 16 + quad * 4;
        *(uint2*)(WS_B(O_BR) + (size_t)row * 2048 + 512 + g * 256 + ch) = pack4(y[mi][ni][0], y[mi][ni][1], y[mi][ni][2], y[mi][ni][3]);
      }
    }
  }
  __syncthreads();
  const float* ng = p.in[I_SNG] + L * 512 + g * 256;
#pragma unroll
  for (int mi = 0; mi < 2; mi++) {
    const int rl = wm * 32 + mi * 16 + l15, row = rq0 + rl;
    const float rstd = rsqrtf(sSS[rl] * (1.f / 256.f) + EPS);
#pragma unroll
    for (int hh = 0; hh < 4; hh++)
#pragma unroll
      for (int ni = 0; ni < 2; ni++) {
        int ch = hh * 64 + wn * 32 + ni * 16 + quad * 4;
        float4 gg = *(const float4*)(ng + ch);
        bfr* dst = WS_B(O_BR) + (size_t)row * 2048 + 512 + g * 256 + ch;
        float v[4]; unpack4(*(const uint2*)dst, v);
        *(uint2*)dst = pack4(v[0] * rstd * gg.x, v[1] * rstd * gg.y, v[2] * rstd * gg.z, v[3] * rstd * gg.w);
      }
  }
}

#undef SSM_XLOAD
DEV void ret_out_item(const Prm& p, int L, int it, char* smem) {
  TILE_IDS
  bfr* sQ = (bfr*)smem;
  bfr* sK = sQ + 64 * 72;
  bfr* sP = sK;
  bfr* sV = (bfr*)(smem + 27648);
  bfr* sH = sV;
  float* sSum = (float*)(smem + 62464); float* sSq = sSum + 64;
  const int c = it >> 3, h = (it >> 1) & 3, lh = it & 1, r0 = c * 128, rq0 = r0 + lh * 64;
  const bfr* U_ = WS_B(O_U);
  const float lgf = -expf(p.in[I_RDEC][L * 8 + h]), lgb = -expf(p.in[I_RDEC][L * 8 + 4 + h]);
  __syncthreads();
  {
    int row = tid >> 2, nc = tid & 3, r = rq0 + row;
    const bfr* src = U_ + (size_t)r * NU + C_RQ + h * 64 + nc * 8;
    float o1[8], o2[8];
    ret_rope8(p, r, nc, *(const uint4*)src, *(const uint4*)(src + 32), 1.f, o1, o2);
    *(uint4*)(sQ + row * 72 + nc * 8) = pack8(o1); *(uint4*)(sQ + row * 72 + 32 + nc * 8) = pack8(o2);
  }
  for (int u = tid; u < 512; u += 256) {
    int row = u >> 2, nc = u & 3, r = r0 + row;
    const bfr* src = U_ + (size_t)r * NU + C_RK + h * 64 + nc * 8;
    float o1[8], o2[8];
    ret_rope8(p, r, nc, *(const uint4*)src, *(const uint4*)(src + 32), 0.125f, o1, o2);
    *(uint4*)(sK + row * 72 + nc * 8) = pack8(o1); *(uint4*)(sK + row * 72 + 32 + nc * 8) = pack8(o2);
  }
#pragma unroll 4
  for (int u = tid; u < 1024; u += 256) {
    int lp = u & 63, pc = u >> 6;
    const bfr* src = U_ + (size_t)(r0 + 2 * lp) * NU + C_RV + h * 128 + pc * 8;
    uint4 a = *(const uint4*)src, b2 = *(const uint4*)(src + NU);
#pragma unroll
    for (int e = 0; e < 8; e++) *(unsigned*)(sV + (pc * 8 + e) * 136 + 2 * lp) = elem16(a, e) | (elem16(b2, e) << 16);
  }
  if (tid < 128) sSum[tid] = 0.f;
  __syncthreads();
  f32x4 qk[2][4];
#pragma unroll
  for (int i = 0; i < 2; i++)
#pragma unroll
    for (int j = 0; j < 4; j++) qk[i][j] = f32x4{0, 0, 0, 0};
  lds_gemm<2, 4, 2>(sQ + (wm * 32) * 72, 72, sK + (wn * 64) * 72, 72, qk);
  __syncthreads();
#pragma unroll
  for (int mi = 0; mi < 2; mi++) {
    const int rl = wm * 32 + mi * 16 + l15, ll = lh * 64 + rl;
#pragma unroll
    for (int ni = 0; ni < 4; ni++) {
      const int s0 = wn * 64 + ni * 16 + quad * 4;
      float pv[4];
#pragma unroll
      for (int r = 0; r < 4; r++) {
        int d = ll - (s0 + r);
        float wgt = (d >= 0 ? __expf((float)d * lgf) : 0.f) + (d <= 0 ? __expf((float)(-d) * lgb) : 0.f);
        pv[r] = qk[mi][ni][r] * wgt;
      }
      *(uint2*)(sP + rl * 136 + s0) = pack4(pv[0], pv[1], pv[2], pv[3]);
    }
  }
  __syncthreads();
  f32x4 y[2][4];
#pragma unroll
  for (int i = 0; i < 2; i++)
#pragma unroll
    for (int j = 0; j < 4; j++) y[i][j] = f32x4{0, 0, 0, 0};
  float4 hreg[8];
  {
    const float* hsrc = WS_F(O_RST) + ((size_t)((0 * NCH + c) * 4 + h)) * 8192;
#pragma unroll
    for (int k = 0; k < 8; k++) { int u = tid + 256 * k; hreg[k] = *(const float4*)(hsrc + (u >> 4) * 64 + (u & 15) * 4); }
  }
  lds_gemm<2, 4, 4>(sP + (wm * 32) * 136, 136, sV + (wn * 64) * 136, 136, y);
#pragma unroll
  for (int dir = 0; dir < 2; dir++) {
    __syncthreads();
#pragma unroll
    for (int k = 0; k < 8; k++) { int u = tid + 256 * k; *(uint2*)(sH + (u >> 4) * 72 + (u & 15) * 4) = pack4(hreg[k].x, hreg[k].y, hreg[k].z, hreg[k].w); }
    if (dir == 0) {
      const float* hsrc = WS_F(O_RST) + ((size_t)((1 * NCH + c) * 4 + h)) * 8192;
#pragma unroll
      for (int k = 0; k < 8; k++) { int u = tid + 256 * k; hreg[k] = *(const float4*)(hsrc + (u >> 4) * 64 + (u & 15) * 4); }
    }
    __syncthreads();
    f32x4 t[2][4];
#pragma unroll
    for (int i = 0; i < 2; i++)
#pragma unroll
      for (int j = 0; j < 4; j++) t[i][j] = f32x4{0, 0, 0, 0};
    lds_gemm<2, 4, 2>(sQ + (wm * 32) * 72, 72, sH + (wn * 64) * 72, 72, t);
#pragma unroll
    for (int mi = 0; mi < 2; mi++) {
      const int ll = lh * 64 + wm * 32 + mi * 16 + l15;
      float e = dir == 0 ? __expf((float)(ll + 1) * lgf) : __expf((float)(128 - ll) * lgb);
#pragma unroll
      for (int ni = 0; ni < 4; ni++)
#pragma unroll
        for (int r = 0; r < 4; r++) y[mi][ni][r] += e * t[mi][ni][r];
    }
  }
#pragma unroll
  for (int mi = 0; mi < 2; mi++) {
    const int rl = wm * 32 + mi * 16 + l15;
    float s1 = 0.f, s2 = 0.f;
#pragma unroll
    for (int ni = 0; ni < 4; ni++)
#pragma unroll
      for (int r = 0; r < 4; r++) { float v = y[mi][ni][r]; s1 += v; s2 += v * v; }
    s1 += __shfl_xor(s1, 16); s1 += __shfl_xor(s1, 32);
    s2 += __shfl_xor(s2, 16); s2 += __shfl_xor(s2, 32);
    if (quad == 0) { atomicAdd(&sSum[rl], s1); atomicAdd(&sSq[rl], s2); }
  }
  __syncthreads();
  const float* gg = p.in[I_RGNG] + L * 512 + h * 128;
  const float* gb = p.in[I_RGNB] + L * 512 + h * 128;
#pragma unroll
  for (int mi = 0; mi < 2; mi++) {
    const int rl = wm * 32 + mi * 16 + l15, row = rq0 + rl;
    const float mu = sSum[rl] * (1.f / 128.f);
    const float var = fmaxf(sSq[rl] * (1.f / 128.f) - mu * mu, 0.f);
    const float rstd = rsqrtf(var + EPS);
#pragma unroll
    for (int ni = 0; ni < 4; ni++) {
      int p0 = wn * 64 + ni * 16 + quad * 4;
      float gf[4]; unpack4(*(const uint2*)(U_ + (size_t)row * NU + C_RG + h * 128 + p0), gf);
      float4 g4 = *(const float4*)(gg + p0), b4 = *(const float4*)(gb + p0);
      float o0 = silu_f(gf[0]) * ((y[mi][ni][0] - mu) * rstd * g4.x + b4.x);
      float o1 = silu_f(gf[1]) * ((y[mi][ni][1] - mu) * rstd * g4.y + b4.y);
      float o2 = silu_f(gf[2]) * ((y[mi][ni][2] - mu) * rstd * g4.z + b4.z);
      float o3 = silu_f(gf[3]) * ((y[mi][ni][3] - mu) * rstd * g4.w + b4.w);
      *(uint2*)(WS_B(O_BR) + (size_t)row * 2048 + 1024 + h * 128 + p0) = pack4(o0, o1, o2, o3);
    }
  }
}

typedef __attribute__((ext_vector_type(16))) float f32x16;
DEV unsigned cvtpk(float lo, float hi) { unsigned r; asm("v_cvt_pk_bf16_f32 %0, %1, %2" : "=v"(r) : "v"(lo), "v"(hi)); return r; }
DEV void attn_item(const Prm& p, int q0, int head, int nkeys, char* smem) {
  const int tid = rtid(), lane = tid & 63, wid = tid >> 6, l31 = lane & 31, hi = lane >> 5;
  constexpr int LDK = 104, LDV = 72;
  bfr* sK0 = (bfr*)smem;
  bfr* sV0 = sK0 + 2 * 64 * LDK;
  const bfr* KN = WS_B(O_KN);
  const bfr* KR = WS_B(O_KROPE);
  const bfr* VT = WS_B(O_VT);
  const float qs = 0.10206207261596577f * 1.4426950408889634f;
  const float THR2 = 11.5f;
  bf16x8 qf[6];
  const int row = q0 + wid * 32 + l31;
  {
    const bfr* qp = WS_B(O_Q) + (size_t)row * 768 + head * 96;
#pragma unroll
    for (int ks = 0; ks < 4; ks++) {
      float f[8]; unpack8(*(const uint4*)(qp + ks * 16 + hi * 8), f);
      uint4 t = {cvtpk(f[0] * qs, f[1] * qs), cvtpk(f[2] * qs, f[3] * qs), cvtpk(f[4] * qs, f[5] * qs), cvtpk(f[6] * qs, f[7] * qs)};
      qf[ks] = *(bf16x8*)&t;
    }
    float x1[8], x2[8], o1[8], o2[8];
    unpack8(*(const uint4*)(qp + 64 + hi * 8), x1);
    unpack8(*(const uint4*)(qp + 80 + hi * 8), x2);
    if (row >= CTX) {
      const float2* mcs = (const float2*)(p.ws + O_MCS);
      int t = row - CTX, pos = hi ? (t & 63) : (t >> 6);
#pragma unroll
      for (int e = 0; e < 8; e++) {
        float2 cs = mcs[pos * 8 + e];
        o1[e] = (x1[e] * cs.x - x2[e] * cs.y) * qs; o2[e] = (x1[e] * cs.y + x2[e] * cs.x) * qs;
      }
    } else {
#pragma unroll
      for (int e = 0; e < 8; e++) { o1[e] = x1[e] * qs; o2[e] = x2[e] * qs; }
    }
    uint4 t1 = {cvtpk(o1[0], o1[1]), cvtpk(o1[2], o1[3]), cvtpk(o1[4], o1[5]), cvtpk(o1[6], o1[7])};
    uint4 t2 = {cvtpk(o2[0], o2[1]), cvtpk(o2[2], o2[3]), cvtpk(o2[4], o2[5]), cvtpk(o2[6], o2[7])};
    qf[4] = *(bf16x8*)&t1; qf[5] = *(bf16x8*)&t2;
  }
  f32x16 O0, O1;
#pragma unroll
  for (int r = 0; r < 16; r++) { O0[r] = 0.f; O1[r] = 0.f; }
  float mrun = -1e30f, lrun = 0.f;
  uint4 ek0, ek1, ev0, ok0, ok1, ov0;
  const int nt = nkeys >> 6;
  const bool k2 = tid < 256;
  const int ku0 = tid, ku1 = tid + 512;
  const int kk0 = ku0 / 12, kc0 = ku0 - kk0 * 12, kk1 = ku1 / 12, kc1 = ku1 - kk1 * 12;
  const bfr* ks0 = kc0 < 8 ? KN + (size_t)kk0 * 512 + head * 64 + kc0 * 8 : KR + (size_t)kk0 * 32 + (kc0 - 8) * 8;
  const bfr* ks1 = kc1 < 8 ? KN + (size_t)kk1 * 512 + head * 64 + kc1 * 8 : KR + (size_t)kk1 * 32 + (kc1 - 8) * 8;
  const int kst0 = kc0 < 8 ? 512 * 64 : 32 * 64, kst1 = kc1 < 8 ? 512 * 64 : 32 * 64;
  const int vd0 = tid >> 3, vc0 = tid & 7;
  const bfr* vs0 = VT + (size_t)(head * 64 + vd0) * ROWS + vc0 * 8;
  const int kw0 = kk0 * LDK + kc0 * 8, kw1 = kk1 * LDK + kc1 * 8;
  const int vw0 = vd0 * LDV + (vc0 >> 1) * 16 + (vc0 & 1) * 4;
#define ATT_KLOAD(S, t_) do { const int tc_ = min((int)(t_), nt - 1); S##k0 = *(const uint4*)(ks0 + (size_t)tc_ * kst0); if (k2) S##k1 = *(const uint4*)(ks1 + (size_t)tc_ * kst1); } while (0)
#define ATT_VLOAD(S, t_) do { const int tc_ = min((int)(t_), nt - 1); S##v0 = *(const uint4*)(vs0 + tc_ * 64); } while (0)
#define ATT_KSTORE(S, buf_) do { bfr* sK_ = sK0 + (buf_) * 64 * LDK; *(uint4*)(sK_ + kw0) = S##k0; if (k2) *(uint4*)(sK_ + kw1) = S##k1; } while (0)
#define ATT_VSTORE(S, buf_) do { bfr* sV_ = sV0 + (buf_) * 64 * LDV; \
       *(uint2*)(sV_ + vw0) = make_uint2(S##v0.x, S##v0.y); *(uint2*)(sV_ + vw0 + 8) = make_uint2(S##v0.z, S##v0.w); } while (0)
#define ATT_QK(SA_, SB_, buf_) do { const bfr* sK = sK0 + (buf_) * 64 * LDK; \
    _Pragma("unroll") for (int r = 0; r < 16; r++) { SA_[r] = 0.f; SB_[r] = 0.f; } \
    _Pragma("unroll") for (int ks = 0; ks < 6; ks++) { \
      bf16x8 k0 = *(const bf16x8*)(sK + l31 * LDK + ks * 16 + hi * 8); \
      bf16x8 k1 = *(const bf16x8*)(sK + (32 + l31) * LDK + ks * 16 + hi * 8); \
      SA_ = __builtin_amdgcn_mfma_f32_32x32x16_bf16(k0, qf[ks], SA_, 0, 0, 0); \
      SB_ = __builtin_amdgcn_mfma_f32_32x32x16_bf16(k1, qf[ks], SB_, 0, 0, 0); } } while (0)
#define ATT_SMPV(S0, S1, buf_) do { const bfr* sV = sV0 + (buf_) * 64 * LDV; \
    float pmax; asm("v_max_f32 %0, %1, %2" : "=v"(pmax) : "v"(S0[0]), "v"(S1[0])); \
    _Pragma("unroll") for (int r = 1; r < 16; r++) asm("v_max3_f32 %0, %1, %2, %3" : "=v"(pmax) : "v"(pmax), "v"(S0[r]), "v"(S1[r])); \
    { auto rr_ = __builtin_amdgcn_permlane32_swap(__float_as_uint(pmax), __float_as_uint(pmax), false, false); \
      pmax = fmaxf(__uint_as_float(rr_[0]), __uint_as_float(rr_[1])); } \
    if (!__all(pmax - mrun <= THR2)) { \
      const float mn = fmaxf(mrun, pmax); const float alpha = __builtin_amdgcn_exp2f(mrun - mn); \
      mrun = mn; lrun *= alpha; \
      _Pragma("unroll") for (int r = 0; r < 16; r++) { O0[r] *= alpha; O1[r] *= alpha; } } \
    float rs = 0.f; \
    _Pragma("unroll") for (int r = 0; r < 16; r++) { \
      S0[r] = __builtin_amdgcn_exp2f(S0[r] - mrun); S1[r] = __builtin_amdgcn_exp2f(S1[r] - mrun); rs += S0[r] + S1[r]; } \
    lrun += rs; \
    _Pragma("unroll") for (int kt = 0; kt < 2; kt++) \
    _Pragma("unroll") for (int sx = 0; sx < 2; sx++) { \
        uint4 pw; \
        if (kt == 0) pw = uint4{cvtpk(S0[8 * sx + 0], S0[8 * sx + 1]), cvtpk(S0[8 * sx + 2], S0[8 * sx + 3]), cvtpk(S0[8 * sx + 4], S0[8 * sx + 5]), cvtpk(S0[8 * sx + 6], S0[8 * sx + 7])}; \
        else         pw = uint4{cvtpk(S1[8 * sx + 0], S1[8 * sx + 1]), cvtpk(S1[8 * sx + 2], S1[8 * sx + 3]), cvtpk(S1[8 * sx + 4], S1[8 * sx + 5]), cvtpk(S1[8 * sx + 6], S1[8 * sx + 7])}; \
        bf16x8 pf = *(bf16x8*)&pw; \
        const int ko = kt * 32 + sx * 16 + hi * 8; \
        uint4 va = *(const uint4*)(sV + l31 * LDV + ko), vb = *(const uint4*)(sV + (32 + l31) * LDV + ko); \
        O0 = __builtin_amdgcn_mfma_f32_32x32x16_bf16(*(bf16x8*)&va, pf, O0, 0, 0, 0); \
        O1 = __builtin_amdgcn_mfma_f32_32x32x16_bf16(*(bf16x8*)&vb, pf, O1, 0, 0, 0); } } while (0)
#define ATT_STEP(S, SC0, SC1, SN0, SN1, t_) do { \
    ATT_KSTORE(S, (t_) & 1); \
    ATT_VSTORE(S, ((t_) + 1) & 1); \
    ATT_KLOAD(S, (t_) + 4); \
    ATT_VLOAD(S, (t_) + 3); \
    ATT_QK(SN0, SN1, ((t_) + 1) & 1); \
    ATT_SMPV(SC0, SC1, (t_) & 1); \
    __syncthreads(); } while (0)
  f32x16 SA0, SA1, SB0, SB1;
  __syncthreads();
  ATT_KLOAD(e, 0); ATT_VLOAD(e, 0); ATT_KLOAD(o, 1);
  ATT_KSTORE(e, 0); ATT_VSTORE(e, 0); ATT_KSTORE(o, 1);
  ATT_KLOAD(e, 2); ATT_VLOAD(e, 1); ATT_KLOAD(o, 3); ATT_VLOAD(o, 2);
  __syncthreads();
  ATT_QK(SA0, SA1, 0);
  __syncthreads();
#pragma unroll 1
  for (int t = 0; t < nt; t += 2) {
    ATT_STEP(e, SA0, SA1, SB0, SB1, t);
    ATT_STEP(o, SB0, SB1, SA0, SA1, t + 1);
  }
#undef ATT_KLOAD
#undef ATT_VLOAD
#undef ATT_KSTORE
#undef ATT_VSTORE
#undef ATT_QK
#undef ATT_SMPV
#undef ATT_STEP
  {
    float l = lrun + __shfl_xor(lrun, 32);
    const float inv = 1.f / l;
    bfr* orow = WS_B(O_BR) + (size_t)row * 2048 + 1536 + head * 64 + 4 * hi;
#pragma unroll
    for (int g4 = 0; g4 < 4; g4++) {
      *(uint2*)(orow + 8 * g4) = make_uint2(cvtpk(O0[4 * g4] * inv, O0[4 * g4 + 1] * inv), cvtpk(O0[4 * g4 + 2] * inv, O0[4 * g4 + 3] * inv));
      *(uint2*)(orow + 32 + 8 * g4) = make_uint2(cvtpk(O1[4 * g4] * inv, O1[4 * g4 + 1] * inv), cvtpk(O1[4 * g4 + 2] * inv, O1[4 * g4 + 3] * inv));
    }
  }
}

DEV void ph_mix(const Prm& p, int L, char* smem_base, char* smem) {
  constexpr int NQB = SEQ / 256;
  const int NA = NQB * 8 + (L == 0 ? 8 : 0);
#ifdef ATT_REP
  for (int rp_ = 0; rp_ < ATT_REP; rp_++)
#endif
  for (int it = blockIdx.x; it < NA; it += gridDim.x) {
    if (it < NQB * 8) {
      int head = it / NQB, qb = it % NQB;
      if (gridDim.x == 256) { const int b = blockIdx.x, xcd = b & 7, j = b >> 3, k = it >> 8; head = (xcd >> 1) + 4 * k; qb = (xcd & 1) * 32 + j; }
      attn_item(p, CTX + qb * 256, head, ROWS, smem_base);
    } else attn_item(p, 0, it - NQB * 8, CTX, smem_base);
  }
  constexpr int N2 = NCH * 4, N3 = N2 + NCH * 8;
  for (int it = VBX; it < N3; it += VGX) {
    if (it < N2) ssm_out_item(p, L, it, smem);
    else ret_out_item(p, L, it - N2, smem);
  }
}

#define XB_TMO      128
#define XB_XCNT(j)  (256  + 64 * (j))
#define XB_XSUB(j)  (1280 + 64 * (j))
#define XB_XGEN(j)  (2304 + 64 * (j))
#define XB_TOP      3328
#define XB_TOPGEN   3392
#define XCD_BAR_WORDS 3456
#define XB_SPIN_CAP (1u << 18)
#define LAS __attribute__((address_space(3)))
DEV unsigned xb_ld(unsigned* p)              { return __hip_atomic_load(p, __ATOMIC_RELAXED, __HIP_MEMORY_SCOPE_AGENT); }
DEV unsigned xb_add(unsigned* p, unsigned v) { return __hip_atomic_fetch_add(p, v, __ATOMIC_RELAXED, __HIP_MEMORY_SCOPE_AGENT); }
DEV unsigned xb_xcc_id() { return (unsigned)__builtin_amdgcn_s_getreg((3 << 11) | 20) & 0xFu; }
#define XB_SPIN(cond, bar) do { unsigned _sp = 0; while (cond) { __builtin_amdgcn_s_sleep(1); \
    if ((++_sp & 255u) == 0u) { if (xb_ld(&(bar)[XB_TMO])) break; if (_sp > XB_SPIN_CAP) { atomicAdd(&(bar)[XB_TMO], 1u); break; } } } } while (0)
struct XcdBarrier { unsigned* bar; unsigned x; volatile LAS unsigned* st; };
DEV XcdBarrier xcd_barrier_post(unsigned* bar, volatile LAS unsigned* st) {
  XcdBarrier b; b.bar = bar; b.x = xb_xcc_id(); b.st = st;
  if (__builtin_amdgcn_workitem_id_x() == 0) (void)xb_add(&bar[XB_XCNT(b.x)], 1u);
  return b;
}
DEV void xcd_barrier_complete(unsigned* bar, unsigned x, unsigned& nloc, unsigned& nx) {
  const unsigned G = gridDim.x * gridDim.y * gridDim.z;
  unsigned sum, cnt, mine, sp = 0u;
  for (;;) {
    sum = 0u; cnt = 0u; mine = 0u;
#pragma unroll
    for (unsigned j = 0; j < 16; ++j) { const unsigned c = xb_ld(&bar[XB_XCNT(j)]); sum += c; cnt += (c > 0u) ? 1u : 0u; mine = (j == x) ? c : mine; }
    if (sum == G) break;
    __builtin_amdgcn_s_sleep(1);
    if ((++sp & 255u) == 0u) { if (xb_ld(&bar[XB_TMO])) break; if (sp > XB_SPIN_CAP) { atomicAdd(&bar[XB_TMO], 1u); break; } }
  }
  nloc = mine > 0u ? mine : 1u; nx = cnt > 0u ? cnt : 1u;
}
DEV void xcd_barrier(const XcdBarrier& b) {
  asm volatile("s_waitcnt vmcnt(0)" ::: "memory");
  __syncthreads();
  if (__builtin_amdgcn_workitem_id_x() == 0) {
    unsigned* bar = b.bar;
    __builtin_amdgcn_s_waitcnt(0);
    unsigned nloc = b.st[0], nx = b.st[1];
    if (nloc == 0u) { xcd_barrier_complete(bar, b.x, nloc, nx); b.st[0] = nloc; b.st[1] = nx; }
    const unsigned old = xb_add(&bar[XB_XSUB(b.x)], 1u);
    const unsigned gen = old / nloc;
    if (old + 1u == (gen + 1u) * nloc) {
      __builtin_amdgcn_fence(__ATOMIC_RELEASE, "agent");
      asm volatile("s_waitcnt vmcnt(0)" ::: "memory");
      const unsigned og = xb_add(&bar[XB_TOP], 1u);
      const unsigned tg = og / nx;
      if (og + 1u == (tg + 1u) * nx) xb_add(&bar[XB_TOPGEN], 1u);
      else XB_SPIN(xb_ld(&bar[XB_TOPGEN]) == tg, bar);
      __builtin_amdgcn_fence(__ATOMIC_ACQUIRE, "agent");
      xb_add(&bar[XB_XGEN(b.x)], 1u);
      asm volatile("s_waitcnt vmcnt(0)" ::: "memory");
    } else {
      XB_SPIN(xb_ld(&bar[XB_XGEN(b.x)]) == gen, bar);
      __builtin_amdgcn_fence(__ATOMIC_ACQUIRE, "agent");
      asm volatile("s_waitcnt vmcnt(0)" ::: "memory");
    }
  }
  __syncthreads();
}

constexpr int NST = 13, NPH = 2 + 2 * (1 + 2 * NST);
DEV void run_phase(const Prm& p, int ph, char* smem_base) {
  char* smem = smem_base + (rtid() >> 8) * 63488;
  if (ph == 0) { ph_ada(p); return; }
  if (ph == 1) { ph_ada_reduce(p); return; }
  int q = ph - 2, L = q / (1 + 2 * NST), s = q % (1 + 2 * NST);
#ifdef CONV_REP
  if (s == 0) { for (int r_ = 0; r_ < CONV_REP; r_++) ph_convert(p, L, smem); return; }
#endif
  if (s == 0) { ph_convert(p, L, smem); return; }
  s -= 1;
  int b = s / NST, st = s % NST;
#ifdef ONLY
  st = ONLY;
#endif
#ifdef REP_MASK
  for (int rep_ = 0; rep_ < (((REP_MASK >> st) & 1) ? REP_N : 1); rep_++)
#endif
  switch (st) {
    case 0: ph_norm(p, L, b, 0); break;
    case 1: ph_inproj(p, smem_base); break;
    case 2: ph_local(p, L, smem); break;
    case 3: ph_states(p, L, smem); break;
    case 4: ph_scan(p, L); break;
    case 5: ph_mix(p, L, smem_base, smem); break;
    case 6: ph_gates(p, L, smem_base); break;
    case 7: ph_merge(p, L, smem); break;
    case 8: ph_resgemm(p, L, b, WS_B(O_H), D, WS_B(O_WTOUT), D, 2, true, smem_base); break;
    case 9: ph_norm(p, L, b, 1); break;
    case 10: ph_ffn1(p, L, smem_base); break;
    case 11: ph_resgemm(p, L, b, WS_B(O_U), FFN, WS_B(O_WTF2), FFN, 5, false, smem_base); break;
    case 12: if (L == 1) ph_final_norm(p, b); break;
  }
}

constexpr int DYN_LDS = 2 * 63488;
__global__ void __launch_bounds__(512) mega(Prm p, int ph0, int ph1) {
  extern __shared__ __attribute__((aligned(16))) char smem[];
  __shared__ uint4 xb_words;
#if COOP
  if (__builtin_amdgcn_workitem_id_x() == 0) xb_words = make_uint4(0u, 0u, 0u, 0u);
  __syncthreads();
  (void)xcd_barrier_post((unsigned*)(p.ws + O_BAR), (volatile LAS unsigned*)&xb_words);
#define GRID_BARRIER() do { if (ph1 > 100000) cg::this_grid().sync(); else { XcdBarrier xb_; xb_.bar = (unsigned*)(p.ws + O_BAR); xb_.x = xb_xcc_id(); xb_.st = (volatile LAS unsigned*)&xb_words; xcd_barrier(xb_); } } while (0)
#else
#define GRID_BARRIER() do {} while (0)
#endif
  for (int ph = ph0; ph < ph1; ph++) {
    if (ph >= 2 && ph < 2 + (1 + 2 * NST) && ((ph - 2) % (1 + 2 * NST)) >= 1 && (((ph - 2) % (1 + 2 * NST)) - 1) % NST == 12) continue;
    run_phase(p, ph, smem);
    if (ph + 1 < ph1) GRID_BARRIER();
  }
}

extern "C" void kernel_launch(void* const* d_in, const int* in_sizes, int n_in, void* d_out, int out_size, void* d_ws,
                              size_t ws_size, hipStream_t stream) {
  static int grid_blocks = 0;
  if (!grid_blocks) {
    int dev = 0, cus = 0, per_cu = 0;
    (void)hipGetDevice(&dev);
    (void)hipDeviceGetAttribute(&cus, hipDeviceAttributeMultiprocessorCount, dev);
    (void)hipFuncSetAttribute((const void*)mega, hipFuncAttributeMaxDynamicSharedMemorySize, DYN_LDS);
    (void)hipOccupancyMaxActiveBlocksPerMultiprocessor(&per_cu, mega, 512, DYN_LDS);
    if (per_cu > 1) per_cu = 1;
    if (per_cu < 1) per_cu = 1;
    grid_blocks = cus * per_cu;
  }
  Prm p{};
  for (int i = 0; i < N_INPUTS; i++) p.in[i] = (const float*)d_in[i];
  p.out = (float*)d_out;
  p.ws = (char*)d_ws;
#if COOP
  hipMemsetAsync((char*)d_ws + O_BAR, 0, 3456 * 4, stream);
  int ph0 = 0, ph1 = NPH;
  void* args[] = {&p, &ph0, &ph1};
  hipError_t e = hipLaunchCooperativeKernel((void*)mega, dim3(grid_blocks), dim3(512), args, DYN_LDS, stream);
  if (e != hipSuccess) fprintf(stderr, "cooperative launch failed: %s (grid %d)\n", hipGetErrorString(e), grid_blocks);
#else
  for (int ph = 0; ph < NPH; ph++) mega<<<grid_blocks, 512, DYN_LDS, stream>>>(p, ph, ph + 1);
#endif
}
```

```cpp
#include <hip/hip_runtime.h>
#include <hip/hip_cooperative_groups.h>
#include <cstdio>
namespace cg = cooperative_groups;

#ifndef COOP
#define COOP 1
#endif
#define REP_N 4

typedef unsigned short bfr;
typedef __attribute__((ext_vector_type(8))) short bf16x8;
typedef __attribute__((ext_vector_type(4))) float f32x4;
#define DEV __device__ __forceinline__

constexpr int D = 1024, SEQ = 16384, CTX = 256, ROWS = SEQ + CTX, NCH = ROWS / 128;
constexpr int NIN = 8880, NU = 4784, FFN = 2816, NMOD = 6144;
constexpr int C_Z = 1024, C_XBC = 1536, C_DT = 2560, C_RQ = 2576, C_RK = 2832, C_RV = 3088, C_RG = 3600,
              C_CQ = 4112, C_CKV = 4496, C_KR = 4752;
constexpr float EPS = 1e-6f;

enum { I_X, I_C, I_CTX, I_CCTX, I_WADA, I_BADA, I_N1G, I_N2G, I_WIN, I_CONVW, I_CONVB, I_CLNG, I_CLNB, I_SCW, I_SCB,
       I_DTB, I_ALOG, I_SSMD, I_SNG, I_RDEC, I_RGNG, I_RGNB, I_QNG, I_KVNG, I_WUQ, I_WUKV, I_WBR, I_WOUT, I_WF1,
       I_WF2, I_FNG, N_INPUTS };

struct Prm { const float* in[N_INPUTS]; float* out; char* ws; };

constexpr size_t al256(size_t x) { return (x + 255) & ~(size_t)255; }
constexpr size_t O_MOD   = 0;
constexpr size_t O_MODP  = al256(O_MOD + (size_t)2 * 3 * NMOD * 4);
constexpr size_t O_RCS   = al256(O_MODP + (size_t)16 * 2 * 3 * NMOD * 4);
constexpr size_t O_MCS   = al256(O_RCS + 256 * 16 * 8);
constexpr size_t O_CS    = al256(O_MCS + 256 * 8 * 8);
constexpr size_t O_RSQ   = al256(O_CS + (size_t)2 * CTX * D * 4);
constexpr size_t O_RSKV  = al256(O_RSQ + ROWS * 4);
constexpr size_t O_TOT   = al256(O_RSKV + ROWS * 4);
constexpr size_t O_KROPE = al256(O_TOT + 2 * NCH * 8 * 4);
constexpr size_t O_WTIN  = al256(O_KROPE + (size_t)ROWS * 32 * 2);
constexpr size_t O_WTBR  = al256(O_WTIN + (size_t)NIN * D * 2);
constexpr size_t O_WTOUT = al256(O_WTBR + (size_t)4 * D * 512 * 2);
constexpr size_t O_WTF1  = al256(O_WTOUT + (size_t)D * D * 2);
constexpr size_t O_WTF2  = al256(O_WTF1 + (size_t)2 * FFN * D * 2);
constexpr size_t O_WTUQ  = al256(O_WTF2 + (size_t)D * FFN * 2);
constexpr size_t O_WTUKV = al256(O_WTUQ + (size_t)768 * 384 * 2);
constexpr size_t O_H     = al256(O_WTUKV + (size_t)1024 * 256 * 2);
constexpr size_t O_U     = al256(O_H + (size_t)ROWS * D * 2);
constexpr size_t O_BR    = al256(O_U + (size_t)ROWS * NU * 2);
constexpr size_t O_XBC   = al256(O_BR + (size_t)ROWS * 2048 * 2);
constexpr size_t O_SST   = al256(O_XBC + (size_t)ROWS * 1024 * 2);
constexpr size_t O_RST   = al256(O_SST + (size_t)2 * NCH * 8 * 8192 * 4);
constexpr size_t O_Q     = al256(O_RST + (size_t)2 * NCH * 4 * 8192 * 4);
constexpr size_t O_KN    = al256(O_Q + (size_t)ROWS * 768 * 2);
constexpr size_t O_VT    = al256(O_KN + (size_t)ROWS * 512 * 2);
constexpr size_t O_BAR   = al256(O_VT + (size_t)512 * ROWS * 2);
constexpr size_t O_END   = al256(O_BAR + 3456 * 4);
static_assert(O_END <= (size_t)512 * 1024 * 1024, "workspace too large");

#define WS_F(off) ((float*)(p.ws + (off)))
#define WS_B(off) ((bfr*)(p.ws + (off)))

DEV int rtid() { int t = __builtin_amdgcn_workitem_id_x(); asm volatile("" : "+v"(t)); return t; }
DEV int otid() { return rtid() & 255; }
#define VBX ((int)(blockIdx.x * 2 + (rtid() >> 8)))
#define VGX ((int)(gridDim.x * 2))
DEV bfr f2bf(float f) { unsigned u = __float_as_uint(f); u += 0x7fffu + ((u >> 16) & 1u); return (bfr)(u >> 16); }
DEV float bf2f(unsigned h) { return __uint_as_float(h << 16); }
DEV unsigned pack2(float a, float b) { unsigned r; asm("v_cvt_pk_bf16_f32 %0, %1, %2" : "=v"(r) : "v"(a), "v"(b)); return r; }
DEV uint2 pack4(float a, float b, float c, float d) { uint2 r; r.x = pack2(a, b); r.y = pack2(c, d); return r; }
DEV float lo16(unsigned w) { return __uint_as_float(w << 16); }
DEV float hi16(unsigned w) { return __uint_as_float(w & 0xffff0000u); }
DEV void unpack8(const uint4& v, float (&f)[8]) {
  f[0] = lo16(v.x); f[1] = hi16(v.x); f[2] = lo16(v.y); f[3] = hi16(v.y);
  f[4] = lo16(v.z); f[5] = hi16(v.z); f[6] = lo16(v.w); f[7] = hi16(v.w);
}
DEV void unpack4(const uint2& v, float (&f)[4]) { f[0] = lo16(v.x); f[1] = hi16(v.x); f[2] = lo16(v.y); f[3] = hi16(v.y); }
DEV uint4 pack8(const float (&f)[8]) {
  uint4 r; r.x = pack2(f[0], f[1]); r.y = pack2(f[2], f[3]); r.z = pack2(f[4], f[5]); r.w = pack2(f[6], f[7]); return r;
}
DEV unsigned elem16(const uint4& v, int e) {
  unsigned w = (e >> 1) == 0 ? v.x : (e >> 1) == 1 ? v.y : (e >> 1) == 2 ? v.z : v.w;
  return (e & 1) ? (w >> 16) : (w & 0xffffu);
}
DEV float silu_f(float x) { return x / (1.f + __expf(-x)); }
DEV float sigm_f(float x) { return 1.f / (1.f + __expf(-x)); }
DEV float softplus_f(float x) { return x > 20.f ? x : log1pf(__expf(x)); }
DEV float wave_sum(float v) {
#pragma unroll
  for (int o = 32; o >= 1; o >>= 1) v += __shfl_xor(v, o);
  return v;
}

template <int MI, int NI, int KS>
DEV void lds_gemm(const bfr* sX, int ldx, const bfr* sW, int ldw, f32x4 (&acc)[MI][NI]) {
  const int lane = otid() & 63, l15 = lane & 15, quad = lane >> 4;
#pragma unroll
  for (int ks = 0; ks < KS; ks++) {
    bf16x8 xa[MI], wb[NI];
#pragma unroll
    for (int mi = 0; mi < MI; mi++) xa[mi] = *(const bf16x8*)(sX + (mi * 16 + l15) * ldx + ks * 32 + quad * 8);
#pragma unroll
    for (int ni = 0; ni < NI; ni++) wb[ni] = *(const bf16x8*)(sW + (ni * 16 + l15) * ldw + ks * 32 + quad * 8);
#pragma unroll
    for (int mi = 0; mi < MI; mi++)
#pragma unroll
      for (int ni = 0; ni < NI; ni++)
        acc[mi][ni] = __builtin_amdgcn_mfma_f32_16x16x32_bf16(wb[ni], xa[mi], acc[mi][ni], 0, 0, 0);
  }
}

DEV void gemm_mainloop(const bfr* __restrict__ A, int lda, const bfr* __restrict__ Bt, int ldb, int K,
                       f32x4 (&acc)[4][4], char* smem) {
  bfr* sA = (bfr*)smem;
  bfr* sB = sA + 128 * 72;
  const int tid = otid(), wid = tid >> 6, wm = wid >> 1, wn = wid & 1;
  const int lrow = tid >> 3, lkc = (tid & 7) * 8;
  const bfr* pa = A + (size_t)lrow * lda + lkc;
  const bfr* pb = Bt + (size_t)lrow * ldb + lkc;
  const size_t sa = (size_t)32 * lda, sb = (size_t)32 * ldb;
  uint4 ra0 = *(const uint4*)(pa), ra1 = *(const uint4*)(pa + sa), ra2 = *(const uint4*)(pa + 2 * sa), ra3 = *(const uint4*)(pa + 3 * sa);
  uint4 rb0 = *(const uint4*)(pb), rb1 = *(const uint4*)(pb + sb), rb2 = *(const uint4*)(pb + 2 * sb), rb3 = *(const uint4*)(pb + 3 * sb);
  bfr* wa = sA + lrow * 72 + lkc;
  bfr* wb = sB + lrow * 72 + lkc;
  const int nk = K >> 6;
#pragma unroll 1
  for (int kt = 0; kt < nk; kt++) {
    __syncthreads();
    *(uint4*)(wa) = ra0; *(uint4*)(wa + 32 * 72) = ra1; *(uint4*)(wa + 64 * 72) = ra2; *(uint4*)(wa + 96 * 72) = ra3;
    *(uint4*)(wb) = rb0; *(uint4*)(wb + 32 * 72) = rb1; *(uint4*)(wb + 64 * 72) = rb2; *(uint4*)(wb + 96 * 72) = rb3;
    __syncthreads();
    if (kt + 1 < nk) {
      pa += 64; pb += 64;
      ra0 = *(const uint4*)(pa); ra1 = *(const uint4*)(pa + sa); ra2 = *(const uint4*)(pa + 2 * sa); ra3 = *(const uint4*)(pa + 3 * sa);
      rb0 = *(const uint4*)(pb); rb1 = *(const uint4*)(pb + sb); rb2 = *(const uint4*)(pb + 2 * sb); rb3 = *(const uint4*)(pb + 3 * sb);
    }
    lds_gemm<4, 4, 2>(sA + (wm * 64) * 72, 72, sB + (wn * 64) * 72, 72, acc);
  }
}

DEV void gemm2_mainloop(const bfr* __restrict__ A, int lda, const bfr* __restrict__ Bt, int ldb, int K,
                        f32x4 (&acc)[8][4], char* smem) {
  constexpr int LDT = 32;
  bfr* sA0 = (bfr*)smem;
  bfr* sB0 = sA0 + 2 * 256 * LDT;
  const int tid = otid(), lane = tid & 63, wid = tid >> 6, wm = wid >> 1, wn = wid & 1, l15 = lane & 15, quad = lane >> 4;
  const int lrow = tid >> 2, lkc = (tid & 3) * 8;
  const bfr* pa = A + (size_t)lrow * lda + lkc;
  const bfr* pb = Bt + (size_t)lrow * ldb + lkc;
  const size_t sa = (size_t)64 * lda, sb = (size_t)64 * ldb;
  const int wo = lrow * LDT + (((tid & 3) ^ ((0x1320 >> (4 * ((lrow >> 2) & 3))) & 3)) * 8);
  const int rsw = ((quad ^ ((0x1320 >> (4 * ((l15 >> 2) & 3))) & 3)) * 8);
  uint4 ra0, ra1, ra2, ra3, rb0, rb1;
#define SBAR() __builtin_amdgcn_sched_barrier(0)
#define G2_LOADA() do { ra0 = *(const uint4*)(pa); ra1 = *(const uint4*)(pa + sa); ra2 = *(const uint4*)(pa + 2 * sa); ra3 = *(const uint4*)(pa + 3 * sa); pa += 32; } while (0)
#define G2_LOADB() do { rb0 = *(const uint4*)(pb); rb1 = *(const uint4*)(pb + sb); pb += 32; } while (0)
#define G2_STOREA(buf_) do { bfr* a_ = sA0 + (buf_) * 256 * LDT + wo; \
                       *(uint4*)(a_) = ra0; *(uint4*)(a_ + 64 * LDT) = ra1; *(uint4*)(a_ + 128 * LDT) = ra2; *(uint4*)(a_ + 192 * LDT) = ra3; } while (0)
#define G2_STOREB(buf_) do { bfr* b_ = sB0 + (buf_) * 128 * LDT + wo; *(uint4*)(b_) = rb0; *(uint4*)(b_ + 64 * LDT) = rb1; } while (0)
#ifdef PROBE_DMFMA
  f32x4 dacc[4] = {f32x4{0,0,0,0}, f32x4{0,0,0,0}, f32x4{0,0,0,0}, f32x4{0,0,0,0}};
#define MF4(xa_, mi_) do { _Pragma("unroll") for (int ni = 0; ni < 4; ni++) { acc[mi_][ni] = __builtin_amdgcn_mfma_f32_16x16x32_bf16(wb[ni], xa_, acc[mi_][ni], 0, 0, 0); dacc[ni] = __builtin_amdgcn_mfma_f32_16x16x32_bf16(wb[ni], xa_, dacc[ni], 0, 0, 0); } } while (0)
#else
#define MF4(xa_, mi_) do { _Pragma("unroll") for (int ni = 0; ni < 4; ni++) acc[mi_][ni] = __builtin_amdgcn_mfma_f32_16x16x32_bf16(wb[ni], xa_, acc[mi_][ni], 0, 0, 0); } while (0)
#endif
  const int nk = K >> 5;
  __syncthreads();
  G2_LOADA(); G2_LOADB(); G2_STOREA(0); G2_STOREB(0);
  if (nk > 1) { G2_LOADA(); G2_LOADB(); }
  __syncthreads();
#pragma unroll 1
  for (int kt = 0; kt < nk; kt++) {
    const int cur = kt & 1, nxt = cur ^ 1;
    const bool st = kt + 1 < nk, ld = kt + 2 < nk;
    const bfr* sA = sA0 + cur * 256 * LDT + (wm * 128 + l15) * LDT + rsw;
    const bfr* sB = sB0 + cur * 128 * LDT + (wn * 64 + l15) * LDT + rsw;
    bf16x8 wb[4];
#pragma unroll
    for (int ni = 0; ni < 4; ni++) wb[ni] = *(const bf16x8*)(sB + ni * 16 * LDT);
    bf16x8 f0 = *(const bf16x8*)(sA), f1 = *(const bf16x8*)(sA + 16 * LDT), f2;
    SBAR();
    f2 = *(const bf16x8*)(sA + 32 * LDT); MF4(f0, 0); SBAR();
    f0 = *(const bf16x8*)(sA + 48 * LDT); MF4(f1, 1); if (st) G2_STOREA(nxt); SBAR();
    f1 = *(const bf16x8*)(sA + 64 * LDT); MF4(f2, 2); if (st) G2_STOREB(nxt); SBAR();
    f2 = *(const bf16x8*)(sA + 80 * LDT); MF4(f0, 3); if (ld) G2_LOADA(); SBAR();
    f0 = *(const bf16x8*)(sA + 96 * LDT); MF4(f1, 4); if (ld) G2_LOADB(); SBAR();
    f1 = *(const bf16x8*)(sA + 112 * LDT); MF4(f2, 5); SBAR();
    MF4(f0, 6); SBAR();
    MF4(f1, 7);
    __syncthreads();
  }
#undef G2_LOADA
#undef G2_LOADB
#undef G2_STOREA
#undef G2_STOREB
#undef MF4
#ifdef PROBE_DMFMA
  if (dacc[0][0] + dacc[1][1] + dacc[2][2] + dacc[3][3] == 12345.678f) smem[otid()] = 1;
#endif
}
DEV void gemm4_mainloop(const bfr* __restrict__ A, int lda, const bfr* __restrict__ Bt, int ldb, int K,
                        f32x4 (&acc)[4][4], char* smem, const bfr* nA, const bfr* nBt, bool first,
                        const bfr*& g_pa, const bfr*& g_pb, uint4& g_pa0, uint4& g_pa1, uint4& g_pb0, uint4& g_pb1, uint4& g_qa0, uint4& g_qa1, uint4& g_qb0, uint4& g_qb1) {
  constexpr int LDT = 32;
  bfr* sA0 = (bfr*)smem;
  bfr* sB0 = sA0 + 2 * 128 * LDT;
  const int tid = otid(), lane = tid & 63, wid = tid >> 6, wm = wid >> 1, wn = wid & 1, l15 = lane & 15, quad = lane >> 4;
  const int lrow = tid >> 2, lkc = (tid & 3) * 8;
  const size_t offA = (size_t)lrow * lda + lkc, offB = (size_t)lrow * ldb + lkc;
  const size_t sa = (size_t)64 * lda, sb = (size_t)64 * ldb;
  const int wo = lrow * LDT + (((tid & 3) ^ ((0x1320 >> (4 * ((lrow >> 2) & 3))) & 3)) * 8);
  const int rsw = ((quad ^ ((0x1320 >> (4 * ((l15 >> 2) & 3))) & 3)) * 8);
  const bfr* npa = nA + offA; const bfr* npb = nBt + offB;
  int g_rem;
#define G4_LOAD(S) do { g_##S##a0 = *(const uint4*)(g_pa); g_##S##a1 = *(const uint4*)(g_pa + sa); g_##S##b0 = *(const uint4*)(g_pb); g_##S##b1 = *(const uint4*)(g_pb + sb); \
      g_rem -= 1; const bool sw_ = g_rem == 0; g_pa = sw_ ? npa : g_pa + 32; g_pb = sw_ ? npb : g_pb + 32; } while (0)
#define G4_STORE(S, buf_) do { bfr* a_ = sA0 + (buf_) * 128 * LDT + wo; bfr* b_ = sB0 + (buf_) * 128 * LDT + wo; \
      *(uint4*)(a_) = g_##S##a0; *(uint4*)(a_ + 64 * LDT) = g_##S##a1; *(uint4*)(b_) = g_##S##b0; *(uint4*)(b_ + 64 * LDT) = g_##S##b1; } while (0)
#define MF4(xa_, mi_) do { _Pragma("unroll") for (int ni = 0; ni < 4; ni++) acc[mi_][ni] = __builtin_amdgcn_mfma_f32_16x16x32_bf16(wb[ni], xa_, acc[mi_][ni], 0, 0, 0); } while (0)
#define G4_ITER(S, cur_) do { \
    const bfr* sA = sA0 + (cur_) * 128 * LDT + (wm * 64 + l15) * LDT + rsw; \
    const bfr* sB = sB0 + (cur_) * 128 * LDT + (wn * 64 + l15) * LDT + rsw; \
    bf16x8 wb[4]; \
    _Pragma("unroll") for (int ni = 0; ni < 4; ni++) wb[ni] = *(const bf16x8*)(sB + ni * 16 * LDT); \
    bf16x8 f0 = *(const bf16x8*)(sA), f1 = *(const bf16x8*)(sA + 16 * LDT), f2, f3; \
    SBAR(); \
    f2 = *(const bf16x8*)(sA + 32 * LDT); MF4(f0, 0); G4_STORE(S, (cur_) ^ 1); SBAR(); \
    f3 = *(const bf16x8*)(sA + 48 * LDT); MF4(f1, 1); G4_LOAD(S); SBAR(); \
    MF4(f2, 2); SBAR(); \
    MF4(f3, 3); \
    __syncthreads(); } while (0)
  const int nk = K >> 5;
  if (first) {
    g_pa = A + offA; g_pb = Bt + offB; g_rem = nk;
    __syncthreads();
    G4_LOAD(p); G4_LOAD(q);
    G4_STORE(p, 0);
    G4_LOAD(p);
    __syncthreads();
  } else {
    g_rem = nk - 3;
  }
#pragma unroll 1
  for (int kt = 0; kt < nk; kt += 2) {
    G4_ITER(q, 0);
    G4_ITER(p, 1);
  }
#undef G4_LOAD
#undef G4_STORE
#undef G4_ITER
#undef MF4
}
DEV void gemm4_single(const bfr* __restrict__ A, int lda, const bfr* __restrict__ Bt, int ldb, int K, f32x4 (&acc)[4][4], char* smem) {
  const bfr* g_pa = nullptr; const bfr* g_pb = nullptr; uint4 a0{}, a1{}, b0{}, b1{}, c0{}, c1{}, d0{}, d1{};
  gemm4_mainloop(A, lda, Bt, ldb, K, acc, smem, A, Bt, true, g_pa, g_pb, a0, a1, b0, b1, c0, c1, d0, d1);
}

DEV void gemm3_mainloop(const bfr* __restrict__ A, int lda, const bfr* __restrict__ Bt, int ldb, int K,
                        f32x4 (&acc)[8][4], char* smem, const bfr* nA, const bfr* nBt, bool first,
                        const bfr*& g_pa, const bfr*& g_pb, uint4& g_pa0, uint4& g_pa1, uint4& g_pb0, uint4& g_pb1, uint4& g_qa0, uint4& g_qa1, uint4& g_qb0, uint4& g_qb1) {
  int g_rem;
  constexpr int LDT = 32;
  bfr* sA0 = (bfr*)smem;
  bfr* sB0 = sA0 + 2 * 256 * LDT;
  const int tid = rtid(), lane = tid & 63, wid = tid >> 6, wm = wid >> 2, wn = wid & 3, l15 = lane & 15, quad = lane >> 4;
  const int lrow = tid >> 2, lkc = (tid & 3) * 8;
  const size_t offA = (size_t)lrow * lda + lkc, offB = (size_t)lrow * ldb + lkc;
  const size_t sa = (size_t)128 * lda, sb = (size_t)128 * ldb;
  const int wo = lrow * LDT + (((tid & 3) ^ ((0x1320 >> (4 * ((lrow >> 2) & 3))) & 3)) * 8);
  const int rsw = ((quad ^ ((0x1320 >> (4 * ((l15 >> 2) & 3))) & 3)) * 8);
  const bfr* npa = nA + offA; const bfr* npb = nBt + offB;
#define G3_LOAD(S) do { g_##S##a0 = *(const uint4*)(g_pa); g_##S##a1 = *(const uint4*)(g_pa + sa); g_##S##b0 = *(const uint4*)(g_pb); g_##S##b1 = *(const uint4*)(g_pb + sb); \
      g_rem -= 1; const bool sw_ = g_rem == 0;                   \
      g_pa = sw_ ? npa : g_pa + 32; g_pb = sw_ ? npb : g_pb + 32; } while (0)
#define G3_STORE(S, buf_) do { bfr* a_ = sA0 + (buf_) * 256 * LDT + wo; bfr* b_ = sB0 + (buf_) * 256 * LDT + wo; \
      *(uint4*)(a_) = g_##S##a0; *(uint4*)(a_ + 128 * LDT) = g_##S##a1; *(uint4*)(b_) = g_##S##b0; *(uint4*)(b_ + 128 * LDT) = g_##S##b1; } while (0)
#define MF4(xa_, mi_) do { _Pragma("unroll") for (int ni = 0; ni < 4; ni++) acc[mi_][ni] = __builtin_amdgcn_mfma_f32_16x16x32_bf16(wb[ni], xa_, acc[mi_][ni], 0, 0, 0); } while (0)
#define G3_ITER(S, cur_) do { \
    const bfr* sA = sA0 + (cur_) * 256 * LDT + (wm * 128 + l15) * LDT + rsw; \
    const bfr* sB = sB0 + (cur_) * 256 * LDT + (wn * 64 + l15) * LDT + rsw; \
    bf16x8 wb[4]; \
    _Pragma("unroll") for (int ni = 0; ni < 4; ni++) wb[ni] = *(const bf16x8*)(sB + ni * 16 * LDT); \
    bf16x8 f0 = *(const bf16x8*)(sA), f1 = *(const bf16x8*)(sA + 16 * LDT), f2; \
    SBAR(); \
    f2 = *(const bf16x8*)(sA + 32 * LDT); MF4(f0, 0); SBAR(); \
    f0 = *(const bf16x8*)(sA + 48 * LDT); MF4(f1, 1); G3_STORE(S, (cur_) ^ 1); SBAR(); \
    f1 = *(const bf16x8*)(sA + 64 * LDT); MF4(f2, 2); G3_LOAD(S); SBAR(); \
    f2 = *(const bf16x8*)(sA + 80 * LDT); MF4(f0, 3); SBAR(); \
    f0 = *(const bf16x8*)(sA + 96 * LDT); MF4(f1, 4); SBAR(); \
    f1 = *(const bf16x8*)(sA + 112 * LDT); MF4(f2, 5); SBAR(); \
    MF4(f0, 6); SBAR(); \
    MF4(f1, 7); \
    __syncthreads(); } while (0)
  const int nk = K >> 5;
  if (first) {
    g_pa = A + offA; g_pb = Bt + offB; g_rem = nk;
    __syncthreads();
    G3_LOAD(p); G3_LOAD(q);
    G3_STORE(p, 0);
    G3_LOAD(p);
    __syncthreads();
  } else {
    g_rem = nk - 3;
  }
#pragma unroll 1
  for (int kt = 0; kt < nk; kt += 2) {
    G3_ITER(q, 0);
    G3_ITER(p, 1);
  }
#undef G3_LOAD
#undef G3_STORE
#undef G3_ITER
#undef MF4
}
DEV void zero_acc84(f32x4 (&acc)[8][4]) {
#pragma unroll
  for (int i = 0; i < 8; i++)
#pragma unroll
    for (int j = 0; j < 4; j++) acc[i][j] = f32x4{0.f, 0.f, 0.f, 0.f};
}


DEV bool tile_remap(int r, int MT, int NT, int& mt, int& nt, int b, int G, bool clamp) {
  const int per = G >> 3;
  int lin = r * G + (b & 7) * per + (b >> 3);
  if (lin >= MT * NT) { if (!clamp) return false; lin = MT * NT - 1; }
  const int g = lin / (8 * NT), rem = lin - g * 8 * NT;
  const int gsz = min(8, MT - 8 * g);
  nt = rem / gsz; mt = 8 * g + rem - nt * gsz;
  return true;
}
DEV void zero_acc44(f32x4 (&acc)[4][4]) {
#pragma unroll
  for (int i = 0; i < 4; i++)
#pragma unroll
    for (int j = 0; j < 4; j++) acc[i][j] = f32x4{0.f, 0.f, 0.f, 0.f};
}

DEV const float* res_src(const Prm& p, int L, int b, int r) {
  if (r < CTX) return (L == 0 ? p.in[I_CTX] : (const float*)WS_F(O_CS)) + ((size_t)(b * CTX + r)) * D;
  return (L == 0 ? p.in[I_X] : (const float*)p.out) + ((size_t)b * SEQ + (r - CTX)) * D;
}
DEV float* res_dst(const Prm& p, int b, int r) {
  if (r < CTX) return WS_F(O_CS) + ((size_t)(b * CTX + r)) * D;
  return p.out + ((size_t)b * SEQ + (r - CTX)) * D;
}

DEV void ph_ada(const Prm& p) {
  const int tid = otid();
  for (int it = VBX; it < 193; it += VGX) {
    if (it < 192) {
      int L = it / 96, rem = it % 96, ks = rem / 6, cb = rem % 6;
      int j = (cb * 256 + tid) * 4;
      float4 a0 = {0, 0, 0, 0}, a1 = a0, a2 = a0;
      const float* W = p.in[I_WADA] + (size_t)L * D * NMOD;
      for (int k = ks * 64; k < ks * 64 + 64; k++) {
        float4 w = *(const float4*)(W + (size_t)k * NMOD + j);
        float s0 = silu_f(p.in[I_C][k]), s1 = silu_f(p.in[I_C][D + k]), s2 = silu_f(p.in[I_CCTX][k]);
        a0.x += s0 * w.x; a0.y += s0 * w.y; a0.z += s0 * w.z; a0.w += s0 * w.w;
        a1.x += s1 * w.x; a1.y += s1 * w.y; a1.z += s1 * w.z; a1.w += s1 * w.w;
        a2.x += s2 * w.x; a2.y += s2 * w.y; a2.z += s2 * w.z; a2.w += s2 * w.w;
      }
      float* MP = WS_F(O_MODP) + ((size_t)(ks * 2 + L) * 3) * NMOD;
      *(float4*)(MP + j) = a0; *(float4*)(MP + NMOD + j) = a1; *(float4*)(MP + 2 * NMOD + j) = a2;
    } else {
      float2* rcs = (float2*)(p.ws + O_RCS);
      float2* mcs = (float2*)(p.ws + O_MCS);
      for (int idx = tid; idx < 256 * 16; idx += 256) {
        int pos = idx >> 4, i = idx & 15;
        float inv = powf(10000.f, -(float)i / 16.f);
        float ang = (float)pos * inv;
        double t = (double)ang * 0.15915494309189535; t -= floor(t);
        float rr = (float)(t * 6.283185307179586);
        rcs[idx] = make_float2(__cosf(rr), __sinf(rr));
      }
      for (int idx = tid; idx < 256 * 8; idx += 256) {
        int pos = idx >> 3, i = idx & 7;
        float inv = powf(10000.f, -(float)i / 8.f);
        float ang = (float)pos * inv;
        double t = (double)ang * 0.15915494309189535; t -= floor(t);
        float rr = (float)(t * 6.283185307179586);
        mcs[idx] = make_float2(__cosf(rr), __sinf(rr));
      }
    }
  }
}
DEV void ph_ada_reduce(const Prm& p) {
  for (int idx = VBX * 256 + otid(); idx < 2 * 3 * NMOD; idx += VGX * 256) {
    int L = idx / (3 * NMOD), j = idx % NMOD;
    float s = p.in[I_BADA][L * NMOD + j];
    for (int ks = 0; ks < 16; ks++) {
      int r = (idx / NMOD) % 3;
      s += WS_F(O_MODP)[((size_t)(ks * 2 + L) * 3 + r) * NMOD + j];
    }
    WS_F(O_MOD)[idx] = s;
  }
}

DEV void transpose_tile(const float* __restrict__ src, int lds, int N, int k0, int n0, bfr* __restrict__ dst,
                        int ldd, int mode, const float* gain, float* sT) {
  const int tx = otid() & 63, ty = otid() >> 6;
  __syncthreads();
#pragma unroll
  for (int i = 0; i < 16; i++) {
    int k = k0 + ty + 4 * i, n = n0 + tx;
    float v = 0.f;
    if (n < N) { v = src[(size_t)k * lds + n]; if (gain) v *= gain[k]; }
    sT[(ty + 4 * i) * 65 + tx] = v;
  }
  __syncthreads();
#pragma unroll
  for (int i = 0; i < 16; i++) {
    int n = n0 + ty + 4 * i;
    if (n < N) {
      int dr = n;
      if (mode == 1) { int j = n < FFN ? n : n - FFN; dr = (j >> 5) * 64 + (n < FFN ? 0 : 32) + (j & 31); }
      if (mode == 2) { int hd = n >> 7, j = n & 127; dr = j < 64 ? hd * 64 + j : 512 + hd * 64 + (j - 64); }
      dst[(size_t)dr * ldd + k0 + tx] = f2bf(sT[tx * 65 + ty + 4 * i]);
    }
  }
}
DEV void ph_convert(const Prm& p, int L, char* smem) {
  float* sT = (float*)smem;
  constexpr int T0 = 16 * 139, T1 = T0 + 512, T2 = T1 + 256, T3 = T2 + 16 * 88, T4 = T3 + 44 * 16, T5 = T4 + 72,
                T6 = T5 + 64;
  for (int it = VBX; it < T6; it += VGX) {
    if (it < T0) {
      int kt = it % 16, nt = it / 16;
      transpose_tile(p.in[I_WIN] + (size_t)L * D * NIN, NIN, NIN, kt * 64, nt * 64, WS_B(O_WTIN), D, 0, nullptr, sT);
    } else if (it < T1) {
      int q = it - T0, i = q / 128, r = q % 128, kt = r % 8, nt = r / 8;
      transpose_tile(p.in[I_WBR] + ((size_t)L * 4 + i) * 512 * D, D, D, kt * 64, nt * 64,
                     WS_B(O_WTBR) + (size_t)i * D * 512, 512, 0, nullptr, sT);
    } else if (it < T2) {
      int q = it - T1, kt = q % 16, nt = q / 16;
      transpose_tile(p.in[I_WOUT] + (size_t)L * D * D, D, D, kt * 64, nt * 64, WS_B(O_WTOUT), D, 0, nullptr, sT);
    } else if (it < T3) {
      int q = it - T2, kt = q % 16, nt = q / 16;
      transpose_tile(p.in[I_WF1] + (size_t)L * D * 2 * FFN, 2 * FFN, 2 * FFN, kt * 64, nt * 64, WS_B(O_WTF1), D, 1,
                     nullptr, sT);
    } else if (it < T4) {
      int q = it - T3, kt = q % 44, nt = q / 44;
      transpose_tile(p.in[I_WF2] + (size_t)L * FFN * D, D, D, kt * 64, nt * 64, WS_B(O_WTF2), FFN, 0, nullptr, sT);
    } else if (it < T5) {
      int q = it - T4, kt = q % 6, nt = q / 6;
      transpose_tile(p.in[I_WUQ] + (size_t)L * 384 * 768, 768, 768, kt * 64, nt * 64, WS_B(O_WTUQ), 384, 0,
                     p.in[I_QNG] + L * 384, sT);
    } else {
      int q = it - T5, kt = q % 4, nt = q / 4;
      transpose_tile(p.in[I_WUKV] + (size_t)L * 256 * 1024, 1024, 1024, kt * 64, nt * 64, WS_B(O_WTUKV), 256, 2,
                     p.in[I_KVNG] + L * 256, sT);
    }
  }
}

DEV void ph_norm(const Prm& p, int L, int b, int which) {
  const int lane = otid() & 63, wid = otid() >> 6;
  const float* g = p.in[which ? I_N2G : I_N1G] + L * D;
  const int shift = which ? 3 : 0, scale = which ? 4 : 1;
  const int it0 = (which && L == 1) ? CTX / 4 : 0;
  for (int it = VBX + it0; it < ROWS / 4; it += 2 * VGX) {
    const bool hasB = it + VGX < ROWS / 4;
    const int rA = it * 4 + wid, rB = hasB ? (it + VGX) * 4 + wid : rA;
    const float* xA = which ? (const float*)res_dst(p, b, rA) : res_src(p, L, b, rA);
    const float* xB = which ? (const float*)res_dst(p, b, rB) : res_src(p, L, b, rB);
    float4 vA[4], vB[4]; float sA = 0.f, sB = 0.f;
#pragma unroll
    for (int i = 0; i < 4; i++) { vA[i] = *(const float4*)(xA + lane * 4 + 256 * i); vB[i] = *(const float4*)(xB + lane * 4 + 256 * i); }
#pragma unroll
    for (int i = 0; i < 4; i++) {
      sA += vA[i].x * vA[i].x + vA[i].y * vA[i].y + vA[i].z * vA[i].z + vA[i].w * vA[i].w;
      sB += vB[i].x * vB[i].x + vB[i].y * vB[i].y + vB[i].z * vB[i].z + vB[i].w * vB[i].w;
    }
    sA = wave_sum(sA); sB = wave_sum(sB);
    const float rsA = rsqrtf(sA * (1.f / D) + EPS), rsB = rsqrtf(sB * (1.f / D) + EPS);
    const float* mdA = WS_F(O_MOD) + (size_t)(L * 3 + (rA < CTX ? 2 : b)) * NMOD;
    const float* mdB = WS_F(O_MOD) + (size_t)(L * 3 + (rB < CTX ? 2 : b)) * NMOD;
    bfr* hA = WS_B(O_H) + (size_t)rA * D;
    bfr* hB = WS_B(O_H) + (size_t)rB * D;
#pragma unroll
    for (int i = 0; i < 4; i++) {
      int c = lane * 4 + 256 * i;
      float4 gg = *(const float4*)(g + c);
      float4 scA = *(const float4*)(mdA + scale * D + c), shA = *(const float4*)(mdA + shift * D + c);
      float4 scB = *(const float4*)(mdB + scale * D + c), shB = *(const float4*)(mdB + shift * D + c);
      *(uint2*)(hA + c) = pack4(vA[i].x * rsA * gg.x * (1.f + scA.x) + shA.x, vA[i].y * rsA * gg.y * (1.f + scA.y) + shA.y,
                                vA[i].z * rsA * gg.z * (1.f + scA.z) + shA.z, vA[i].w * rsA * gg.w * (1.f + scA.w) + shA.w);
      if (hasB)
        *(uint2*)(hB + c) = pack4(vB[i].x * rsB * gg.x * (1.f + scB.x) + shB.x, vB[i].y * rsB * gg.y * (1.f + scB.y) + shB.y,
                                  vB[i].z * rsB * gg.z * (1.f + scB.z) + shB.z, vB[i].w * rsB * gg.w * (1.f + scB.w) + shB.w);
    }
  }
}
DEV void ph_final_norm(const Prm& p, int b) {
  const int lane = otid() & 63, wid = otid() >> 6;
  const float* g = p.in[I_FNG];
  for (int it = VBX; it < SEQ / 4; it += VGX) {
    float* xr = p.out + ((size_t)b * SEQ + it * 4 + wid) * D;
    float4 v[4]; float ss = 0.f;
#pragma unroll
    for (int i = 0; i < 4; i++) {
      v[i] = *(const float4*)(xr + lane * 4 + 256 * i);
      ss += v[i].x * v[i].x + v[i].y * v[i].y + v[i].z * v[i].z + v[i].w * v[i].w;
    }
    ss = wave_sum(ss);
    float rstd = rsqrtf(ss * (1.f / D) + EPS);
#pragma unroll
    for (int i = 0; i < 4; i++) {
      int c = lane * 4 + 256 * i;
      float4 gg = *(const float4*)(g + c);
      float4 o = {v[i].x * rstd * gg.x, v[i].y * rstd * gg.y, v[i].z * rstd * gg.z, v[i].w * rstd * gg.w};
      *(float4*)(xr + c) = o;
    }
  }
}

#define TILE_IDS                                                                   \
  int tid_ = otid();                           \
  const int tid = tid_, lane = tid & 63, wid = tid >> 6, l15 = lane & 15, quad = lane >> 4, \
            wm = wid >> 1, wn = wid & 1;                                           \
  (void)wm; (void)wn; (void)l15; (void)quad;

#define TILE_IDS3                                                                  \
  const int tid = rtid(), lane = tid & 63, wid = tid >> 6, l15 = lane & 15, quad = lane >> 4, \
            wm = wid >> 2, wn = wid & 3;                                           \
  (void)wm; (void)wn; (void)l15; (void)quad;
DEV void ph_inproj(const Prm& p, char* smem) {
  TILE_IDS3
  constexpr int NT = 19, MT = ROWS / 256;
  const bfr* g_pa = nullptr; const bfr* g_pb = nullptr; uint4 g_pa0{}, g_pa1{}, g_pb0{}, g_pb1{}, g_qa0{}, g_qa1{}, g_qb0{}, g_qb1{}; bool first = true;
  for (int rd = 0; rd * (int)gridDim.x < MT * NT; rd++) {
    int mt, nt; if (!tile_remap(rd, MT, NT, mt, nt, blockIdx.x, gridDim.x, false)) continue;
    int m0 = mt * 256, n0 = nt * 256;
    int mt2, nt2; const bool hasn = tile_remap(rd + 1, MT, NT, mt2, nt2, blockIdx.x, gridDim.x, false);
    if (!hasn) { mt2 = mt; nt2 = nt; }
    f32x4 acc[8][4]; zero_acc84(acc);
    gemm3_mainloop(WS_B(O_H) + (size_t)m0 * D, D, WS_B(O_WTIN) + (size_t)n0 * D, D, D, acc, smem,
                   WS_B(O_H) + (size_t)(mt2 * 256) * D, WS_B(O_WTIN) + (size_t)(nt2 * 256) * D, first, g_pa, g_pb, g_pa0, g_pa1, g_pb0, g_pb1, g_qa0, g_qa1, g_qb0, g_qb1);
    first = !hasn;
#pragma unroll
    for (int mi = 0; mi < 8; mi++)
#pragma unroll
      for (int ni = 0; ni < 4; ni++) {
        int row = m0 + wm * 128 + mi * 16 + l15, col = n0 + wn * 64 + ni * 16 + quad * 4;
        if (col < NU) *(uint2*)(WS_B(O_U) + (size_t)row * NU + col) = pack4(acc[mi][ni][0], acc[mi][ni][1], acc[mi][ni][2], acc[mi][ni][3]);
      }
  }
}
DEV void ph_gates(const Prm& p, int L, char* smem) {
  TILE_IDS3
  constexpr int NT = 16;
  const int mt0 = L == 1 ? 1 : 0, MT = ROWS / 256 - mt0;
  const bfr* g_pa = nullptr; const bfr* g_pb = nullptr; uint4 g_pa0{}, g_pa1{}, g_pb0{}, g_pb1{}, g_qa0{}, g_qa1{}, g_qb0{}, g_qb1{}; bool first = true;
  for (int rd = 0; rd * (int)gridDim.x < MT * NT; rd++) {
    int mt, nt; if (!tile_remap(rd, MT, NT, mt, nt, blockIdx.x, gridDim.x, false)) continue;
    mt += mt0; int m0 = mt * 256, n0 = nt * 256;
    int mt2, nt2; const bool hasn = tile_remap(rd + 1, MT, NT, mt2, nt2, blockIdx.x, gridDim.x, false);
    if (hasn) mt2 += mt0; else { mt2 = mt; nt2 = nt; }
    f32x4 acc[8][4]; zero_acc84(acc);
    gemm3_mainloop(WS_B(O_H) + (size_t)m0 * D, D, WS_B(O_WTIN) + (size_t)(NU + n0) * D, D, D, acc, smem,
                   WS_B(O_H) + (size_t)(mt2 * 256) * D, WS_B(O_WTIN) + (size_t)(NU + nt2 * 256) * D, first, g_pa, g_pb, g_pa0, g_pa1, g_pb0, g_pb1, g_qa0, g_qa1, g_qb0, g_qb1);
    first = !hasn;
#pragma unroll
    for (int mi = 0; mi < 8; mi++)
#pragma unroll
      for (int ni = 0; ni < 4; ni++) {
        int row = m0 + wm * 128 + mi * 16 + l15, col = n0 + wn * 64 + ni * 16 + quad * 4;
        *(uint2*)(WS_B(O_U) + (size_t)row * 4096 + col) =
            pack4(sigm_f(acc[mi][ni][0]), sigm_f(acc[mi][ni][1]), sigm_f(acc[mi][ni][2]), sigm_f(acc[mi][ni][3]));
      }
  }
}
DEV void ph_merge(const Prm& p, int L, char* smem) {
  TILE_IDS
  const int mt0 = L == 1 ? 2 : 0;
  const bfr* g_pa = nullptr; const bfr* g_pb = nullptr; uint4 g_a0{}, g_a1{}, g_b0{}, g_b1{}, g_c0{}, g_c1{}, g_d0{}, g_d1{}; bool first = true;
  const int NT_ = (NCH - mt0) * 8;
  for (int rd = 0; rd * (int)VGX < NT_; rd++) {
    int mt, nt; tile_remap(rd, NCH - mt0, 8, mt, nt, VBX, VGX, true);
    mt += mt0; int m0 = mt * 128, n0 = nt * 128;
    const bool hasn = (rd + 1) * (int)VGX < NT_;
    int mt2 = mt, nt2 = nt; if (hasn) { tile_remap(rd + 1, NCH - mt0, 8, mt2, nt2, VBX, VGX, true); mt2 += mt0; }
    f32x4 macc[4][4]; zero_acc44(macc);
#pragma unroll 1
    for (int i = 0; i < 4; i++) {
      f32x4 acc[4][4]; zero_acc44(acc);
      const bool lastb = i == 3;
      const bfr* nA_ = lastb ? WS_B(O_BR) + (size_t)(mt2 * 128) * 2048 : WS_B(O_BR) + (size_t)m0 * 2048 + (i + 1) * 512;
      const bfr* nB_ = lastb ? WS_B(O_WTBR) + (size_t)(nt2 * 128) * 512 : WS_B(O_WTBR) + ((size_t)(i + 1) * D + n0) * 512;
      gemm4_mainloop(WS_B(O_BR) + (size_t)m0 * 2048 + i * 512, 2048, WS_B(O_WTBR) + ((size_t)i * D + n0) * 512, 512, 512, acc, smem,
                     nA_, nB_, first, g_pa, g_pb, g_a0, g_a1, g_b0, g_b1, g_c0, g_c1, g_d0, g_d1);
      first = lastb && !hasn;
#pragma unroll
      for (int mi = 0; mi < 4; mi++)
#pragma unroll
        for (int ni = 0; ni < 4; ni++) {
          int row = m0 + wm * 64 + mi * 16 + l15, col = n0 + wn * 64 + ni * 16 + quad * 4;
          uint2 gv = *(const uint2*)(WS_B(O_U) + (size_t)row * 4096 + i * D + col);
          float gf[4]; unpack4(gv, gf);
#pragma unroll
          for (int r = 0; r < 4; r++) macc[mi][ni][r] += gf[r] * acc[mi][ni][r];
        }
    }
#pragma unroll
    for (int mi = 0; mi < 4; mi++)
#pragma unroll
      for (int ni = 0; ni < 4; ni++) {
        int row = m0 + wm * 64 + mi * 16 + l15, col = n0 + wn * 64 + ni * 16 + quad * 4;
        *(uint2*)(WS_B(O_H) + (size_t)row * D + col) = pack4(macc[mi][ni][0], macc[mi][ni][1], macc[mi][ni][2], macc[mi][ni][3]);
      }
  }
}
DEV void ph_resgemm(const Prm& p, int L, int b, const bfr* A, int lda, const bfr* Wt, int K, int gate_idx,
                    bool from_src, char* smem) {
  TILE_IDS3
  const int mt0 = L == 1 ? 1 : 0, MT = ROWS / 256 - mt0;
  const bfr* g_pa = nullptr; const bfr* g_pb = nullptr; uint4 g_pa0{}, g_pa1{}, g_pb0{}, g_pb1{}, g_qa0{}, g_qa1{}, g_qb0{}, g_qb1{}; bool first = true;
  for (int rd = 0; rd * (int)gridDim.x < MT * 4; rd++) {
    int mt, nt; if (!tile_remap(rd, MT, 4, mt, nt, blockIdx.x, gridDim.x, false)) continue;
    mt += mt0; int m0 = mt * 256, n0 = nt * 256;
    int mt2, nt2; const bool hasn = tile_remap(rd + 1, MT, 4, mt2, nt2, blockIdx.x, gridDim.x, false);
    if (hasn) mt2 += mt0; else { mt2 = mt; nt2 = nt; }
    f32x4 acc[8][4]; zero_acc84(acc);
    gemm3_mainloop(A + (size_t)m0 * lda, lda, Wt + (size_t)n0 * K, K, K, acc, smem,
                   A + (size_t)(mt2 * 256) * lda, Wt + (size_t)(nt2 * 256) * K, first, g_pa, g_pb, g_pa0, g_pa1, g_pb0, g_pb1, g_qa0, g_qa1, g_qb0, g_qb1);
    first = !hasn;
#pragma unroll
    for (int mi = 0; mi < 8; mi++) {
      int row = m0 + wm * 128 + mi * 16 + l15;
      const float* rs = from_src ? res_src(p, L, b, row) : (const float*)res_dst(p, b, row);
      float* rd = res_dst(p, b, row);
      const float* md = WS_F(O_MOD) + (size_t)(L * 3 + (row < CTX ? 2 : b)) * NMOD + gate_idx * D;
#pragma unroll
      for (int ni = 0; ni < 4; ni++) {
        int col = n0 + wn * 64 + ni * 16 + quad * 4;
        float4 x = *(const float4*)(rs + col), g = *(const float4*)(md + col);
        float4 o = {x.x + g.x * acc[mi][ni][0], x.y + g.y * acc[mi][ni][1], x.z + g.z * acc[mi][ni][2], x.w + g.w * acc[mi][ni][3]};
        *(float4*)(rd + col) = o;
      }
    }
  }
}
DEV void ph_ffn1(const Prm& p, int L, char* smem) {
  TILE_IDS3
  constexpr int NT = 22;
  const int mt0 = L == 1 ? 1 : 0, MT = ROWS / 256 - mt0;
  const bfr* g_pa = nullptr; const bfr* g_pb = nullptr; uint4 g_pa0{}, g_pa1{}, g_pb0{}, g_pb1{}, g_qa0{}, g_qa1{}, g_qb0{}, g_qb1{}; bool first = true;
  for (int rd = 0; rd * (int)gridDim.x < MT * NT; rd++) {
    int mt, nt; if (!tile_remap(rd, MT, NT, mt, nt, blockIdx.x, gridDim.x, false)) continue;
    mt += mt0; int m0 = mt * 256, n0 = nt * 256;
    int mt2, nt2; const bool hasn = tile_remap(rd + 1, MT, NT, mt2, nt2, blockIdx.x, gridDim.x, false);
    if (hasn) mt2 += mt0; else { mt2 = mt; nt2 = nt; }
    f32x4 acc[8][4]; zero_acc84(acc);
    gemm3_mainloop(WS_B(O_H) + (size_t)m0 * D, D, WS_B(O_WTF1) + (size_t)n0 * D, D, D, acc, smem,
                   WS_B(O_H) + (size_t)(mt2 * 256) * D, WS_B(O_WTF1) + (size_t)(nt2 * 256) * D, first, g_pa, g_pb, g_pa0, g_pa1, g_pb0, g_pb1, g_qa0, g_qa1, g_qb0, g_qb1);
    first = !hasn;
    int j0 = ((n0 + wn * 64) >> 6) * 32;
#pragma unroll
    for (int mi = 0; mi < 8; mi++)
#pragma unroll
      for (int ni = 0; ni < 2; ni++) {
        int row = m0 + wm * 128 + mi * 16 + l15, col = j0 + ni * 16 + quad * 4;
        float f[4];
#pragma unroll
        for (int r = 0; r < 4; r++) f[r] = silu_f(acc[mi][ni + 2][r]) * acc[mi][ni][r];
        *(uint2*)(WS_B(O_U) + (size_t)row * FFN + col) = pack4(f[0], f[1], f[2], f[3]);
      }
  }
}

DEV void conv_module_item(const Prm& p, int L, int grp, char* smem) {
  const int tid = otid(), lane = tid & 63, wid = tid >> 6;
  unsigned* sG = (unsigned*)smem;
  float* sR = (float*)(smem + 47104);
  const int t0 = grp * 16, seg0 = t0 < CTX ? 0 : CTX, seg1 = t0 < CTX ? CTX : ROWS;
  const int c = tid * 2;
  const bfr* U_ = WS_B(O_U);
  __syncthreads();
#pragma unroll 8
  for (int rr = 0; rr < 46; rr++) {
    const int r = t0 - 15 + rr, rc = min(max(r, seg0), seg1 - 1);
    const unsigned aa = *(const unsigned*)(U_ + (size_t)rc * NU + c), gg = *(const unsigned*)(U_ + (size_t)rc * NU + 512 + c);
    const unsigned v = pack2(lo16(aa) * sigm_f(lo16(gg)), hi16(aa) * sigm_f(hi16(gg)));
    sG[rr * 256 + tid] = (r == rc) ? v : 0u;
  }
  __syncthreads();
  const float* cw = p.in[I_CONVW] + (size_t)L * 31 * 512 + c;
  float2 cb = *(const float2*)(p.in[I_CONVB] + L * 512 + c);
  float a0[16], a1[16];
#pragma unroll
  for (int o = 0; o < 16; o++) { a0[o] = cb.x; a1[o] = cb.y; }
  float2 wj[31];
#pragma unroll
  for (int j = 0; j < 31; j++) wj[j] = *(const float2*)(cw + j * 512);
#pragma unroll
  for (int j = 0; j < 31; j++) {
    const float2 w = wj[j];
#pragma unroll
    for (int o = 0; o < 16; o++) {
      unsigned vv = sG[(o + j) * 256 + tid];
      a0[o] += w.x * lo16(vv); a1[o] += w.y * hi16(vv);
    }
  }
  float mu[16], rs[16];
#pragma unroll
  for (int o = 0; o < 16; o++) { float s = wave_sum(a0[o] + a1[o]); if (lane == 0) sR[wid * 16 + o] = s; }
  __syncthreads();
#pragma unroll
  for (int o = 0; o < 16; o++) mu[o] = (sR[o] + sR[16 + o] + sR[32 + o] + sR[48 + o]) * (1.f / 512.f);
  __syncthreads();
#pragma unroll
  for (int o = 0; o < 16; o++) {
    float d0 = a0[o] - mu[o], d1 = a1[o] - mu[o];
    float s = wave_sum(d0 * d0 + d1 * d1);
    if (lane == 0) sR[wid * 16 + o] = s;
  }
  __syncthreads();
#pragma unroll
  for (int o = 0; o < 16; o++) rs[o] = rsqrtf((sR[o] + sR[16 + o] + sR[32 + o] + sR[48 + o]) * (1.f / 512.f) + EPS);
  float2 lg = *(const float2*)(p.in[I_CLNG] + L * 512 + c), lb = *(const float2*)(p.in[I_CLNB] + L * 512 + c);
#pragma unroll
  for (int o = 0; o < 16; o++) {
    float y0 = (a0[o] - mu[o]) * rs[o] * lg.x + lb.x, y1 = (a1[o] - mu[o]) * rs[o] * lg.y + lb.y;
    *(unsigned*)(WS_B(O_BR) + (size_t)(t0 + o) * 2048 + c) = pack2(silu_f(y0), silu_f(y1));
  }
}
DEV void xbc_conv_item(const Prm& p, int L, int grp) {
  const int tid = otid();
  const int t0 = grp * 16, seg0 = t0 < CTX ? 0 : CTX, seg1 = t0 < CTX ? CTX : ROWS;
  const int c = tid * 4;
  float4 w[5];
#pragma unroll
  for (int j = 0; j < 5; j++) w[j] = *(const float4*)(p.in[I_SCW] + ((size_t)L * 5 + j) * 1024 + c);
  float4 bb = *(const float4*)(p.in[I_SCB] + L * 1024 + c);
  float4 a[16];
#pragma unroll
  for (int o = 0; o < 16; o++) a[o] = bb;
  const bfr* U_ = WS_B(O_U);
#pragma unroll
  for (int ii = 0; ii < 20; ii++) {
    const int r = t0 - 2 + ii, rc = min(max(r, seg0), seg1 - 1);
    float v[4];
    { uint2 t = *(const uint2*)(U_ + (size_t)rc * NU + C_XBC + c); if (r != rc) { t.x = 0u; t.y = 0u; } unpack4(t, v); }
#pragma unroll
    for (int o = 0; o < 16; o++) {
      if (ii - o >= 0 && ii - o <= 4) {
        a[o].x += w[ii - o].x * v[0]; a[o].y += w[ii - o].y * v[1]; a[o].z += w[ii - o].z * v[2]; a[o].w += w[ii - o].w * v[3];
      }
    }
  }
#pragma unroll
  for (int o = 0; o < 16; o++)
    *(uint2*)(WS_B(O_XBC) + (size_t)(t0 + o) * 1024 + c) = pack4(silu_f(a[o].x), silu_f(a[o].y), silu_f(a[o].z), silu_f(a[o].w));
}
DEV void mla_pre_item(const Prm& p, int it) {
  const int lane = otid() & 63, wid = otid() >> 6;
  const bfr* U_ = WS_B(O_U);
  const float2* mcs = (const float2*)(p.ws + O_MCS);
#pragma unroll 4
  for (int rr = 0; rr < 16; rr++) {
    int r = it * 64 + wid * 16 + rr;
    const bfr* ur = U_ + (size_t)r * NU;
    float sq = 0.f, sk = 0.f;
#pragma unroll
    for (int i = 0; i < 3; i++) { unsigned t = *(const unsigned*)(ur + C_CQ + lane * 2 + 128 * i); float x = lo16(t), y = hi16(t); sq += x * x + y * y; }
    { uint2 t = *(const uint2*)(ur + C_CKV + lane * 4); float f[4]; unpack4(t, f); sk = f[0] * f[0] + f[1] * f[1] + f[2] * f[2] + f[3] * f[3]; }
    sq = wave_sum(sq); sk = wave_sum(sk);
    if (lane == 0) { WS_F(O_RSQ)[r] = rsqrtf(sq * (1.f / 384.f) + EPS); WS_F(O_RSKV)[r] = rsqrtf(sk * (1.f / 256.f) + EPS); }
    if (lane < 16) {
      float x1 = bf2f(ur[C_KR + lane]), x2 = bf2f(ur[C_KR + 16 + lane]);
      float o1 = x1, o2 = x2;
      if (r >= CTX) {
        int t = r - CTX, pos = lane < 8 ? (t >> 6) : (t & 63);
        float2 cs = mcs[pos * 8 + (lane & 7)];
        o1 = x1 * cs.x - x2 * cs.y; o2 = x1 * cs.y + x2 * cs.x;
      }
      WS_B(O_KROPE)[(size_t)r * 32 + lane] = f2bf(o1);
      WS_B(O_KROPE)[(size_t)r * 32 + 16 + lane] = f2bf(o2);
    }
  }
}
DEV void ph_local(const Prm& p, int L, char* smem) {
  constexpr int NG = ROWS / 16;
  for (int it = VBX; it < 2 * NG + 260; it += VGX) {
#ifdef ONLY2
    it = ONLY2 == 0 ? 0 : ONLY2 == 1 ? NG : 2 * NG;
#endif
    if (it < NG) conv_module_item(p, L, it, smem);
    else if (it < 2 * NG) xbc_conv_item(p, L, it - NG);
    else mla_pre_item(p, it - 2 * NG);
  }
}

DEV void uq_tile(const Prm& p, int it, char* smem) {
  TILE_IDS
  int mt = it / 6, nt = it % 6, m0 = mt * 128, n0 = nt * 128;
  f32x4 acc[4][4]; zero_acc44(acc);
  gemm4_single(WS_B(O_U) + (size_t)m0 * NU + C_CQ, NU, WS_B(O_WTUQ) + (size_t)n0 * 384, 384, 384, acc, smem);
#pragma unroll
  for (int mi = 0; mi < 4; mi++) {
    int row = m0 + wm * 64 + mi * 16 + l15;
    float rs = WS_F(O_RSQ)[row];
#pragma unroll
    for (int ni = 0; ni < 4; ni++) {
      int col = n0 + wn * 64 + ni * 16 + quad * 4;
      *(uint2*)(WS_B(O_Q) + (size_t)row * 768 + col) = pack4(rs * acc[mi][ni][0], rs * acc[mi][ni][1], rs * acc[mi][ni][2], rs * acc[mi][ni][3]);
    }
  }
}
DEV void ukn_tile(const Prm& p, int it, char* smem) {
  TILE_IDS
  int mt = it / 4, nt = it % 4, m0 = mt * 128, n0 = nt * 128;
  f32x4 acc[4][4]; zero_acc44(acc);
  gemm4_single(WS_B(O_U) + (size_t)m0 * NU + C_CKV, NU, WS_B(O_WTUKV) + (size_t)n0 * 256, 256, 256, acc, smem);
#pragma unroll
  for (int mi = 0; mi < 4; mi++) {
    int row = m0 + wm * 64 + mi * 16 + l15;
    float rs = WS_F(O_RSKV)[row];
#pragma unroll
    for (int ni = 0; ni < 4; ni++) {
      int col = n0 + wn * 64 + ni * 16 + quad * 4;
      *(uint2*)(WS_B(O_KN) + (size_t)row * 512 + col) = pack4(rs * acc[mi][ni][0], rs * acc[mi][ni][1], rs * acc[mi][ni][2], rs * acc[mi][ni][3]);
    }
  }
}
DEV void uvt_tile(const Prm& p, int it, char* smem) {
  TILE_IDS
  int vt = it / NCH, tt = it % NCH, m0 = vt * 128, n0 = tt * 128;
  f32x4 acc[4][4]; zero_acc44(acc);
  gemm4_single(WS_B(O_WTUKV) + (size_t)(512 + m0) * 256, 256, WS_B(O_U) + (size_t)n0 * NU + C_CKV, NU, 256, acc, smem);
#pragma unroll
  for (int ni = 0; ni < 4; ni++) {
    int tok = n0 + wn * 64 + ni * 16 + quad * 4;
    float4 rs = *(const float4*)(WS_F(O_RSKV) + tok);
#pragma unroll
    for (int mi = 0; mi < 4; mi++) {
      int vrow = m0 + wm * 64 + mi * 16 + l15;
      *(uint2*)(WS_B(O_VT) + (size_t)vrow * ROWS + tok) = pack4(rs.x * acc[mi][ni][0], rs.y * acc[mi][ni][1], rs.z * acc[mi][ni][2], rs.w * acc[mi][ni][3]);
    }
  }
}

DEV void chunk_decay(const Prm& p, int L, float raw, int h, float* sCum, float* sDt, float* sTmp) {
  const int tid = otid(), dir = tid >> 7, i = tid & 127, l = dir ? 127 - i : i;
  float dt = softplus_f(raw + p.in[I_DTB][L * 16 + dir * 8 + h]);
  float v = -dt * expf(p.in[I_ALOG][L * 16 + dir * 8 + h]);
#pragma unroll
  for (int o = 1; o < 64; o <<= 1) { float t = __shfl_up(v, o); if ((tid & 63) >= o) v += t; }
  if ((tid & 63) == 63) sTmp[tid >> 6] = v;
  __syncthreads();
  if (tid & 64) v += sTmp[(tid >> 6) - 1];
  sCum[dir * 128 + l] = v; sDt[dir * 128 + l] = dt;
  __syncthreads();
}

DEV void ssm_state_item(const Prm& p, int L, int it, char* smem) {
  TILE_IDS
  bfr* sBT = (bfr*)smem;
  bfr* sXT = sBT + 128 * 136;
  float* sCum = (float*)(smem + 52224); float* sDt = sCum + 256; float* sTmp = sDt + 256;
  const int c = it >> 2, g = (it >> 1) & 1, hp = it & 1, r0 = c * 128;
  const bfr* X_ = WS_B(O_XBC);
  unsigned rawp;
  { const int dir_ = tid >> 7, i_ = tid & 127, l_ = dir_ ? 127 - i_ : i_;
    rawp = *(const unsigned*)(WS_B(O_U) + (size_t)(r0 + l_) * NU + C_DT + dir_ * 8 + g * 4 + hp * 2); }
  __syncthreads();
#pragma unroll 4
  for (int u = tid; u < 1024; u += 256) {
    int lp = u & 63, nc = u >> 6;
    const bfr* src = X_ + (size_t)(r0 + 2 * lp) * 1024 + 512 + g * 128 + nc * 8;
    uint4 a = *(const uint4*)src, b2 = *(const uint4*)(src + 1024);
#pragma unroll
    for (int e = 0; e < 8; e++) *(unsigned*)(sBT + (nc * 8 + e) * 136 + 2 * lp) = elem16(a, e) | (elem16(b2, e) << 16);
  }
  for (int hh = 0; hh < 2; hh++) {
    const int h = g * 4 + hp * 2 + hh;
    uint4 xs0, xs1, xs2, xs3;
    { const bfr* s0_ = X_ + (size_t)(r0 + 2 * (tid & 63)) * 1024 + h * 64 + (tid >> 6) * 8;
      xs0 = *(const uint4*)s0_; xs1 = *(const uint4*)(s0_ + 1024); xs2 = *(const uint4*)(s0_ + 32); xs3 = *(const uint4*)(s0_ + 1024 + 32); }
    chunk_decay(p, L, hh ? hi16(rawp) : lo16(rawp), h, sCum, sDt, sTmp);
    const float totf = sCum[127], totb = sCum[128];
    if (tid == 0) { WS_F(O_TOT)[(0 * NCH + c) * 8 + h] = __expf(totf); WS_F(O_TOT)[(1 * NCH + c) * 8 + h] = __expf(totb); }
    for (int dir = 0; dir < 2; dir++) {
      const float tot = dir ? totb : totf;
      {
        const int lp = tid & 63, pc = tid >> 6, l0 = 2 * lp;
        float w0 = __expf(tot - sCum[dir * 128 + l0]) * sDt[dir * 128 + l0];
        float w1 = __expf(tot - sCum[dir * 128 + l0 + 1]) * sDt[dir * 128 + l0 + 1];
        float fa[8], fb[8], fc[8], fd[8]; unpack8(xs0, fa); unpack8(xs1, fb); unpack8(xs2, fc); unpack8(xs3, fd);
#pragma unroll
        for (int e = 0; e < 8; e++) {
          *(unsigned*)(sXT + (pc * 8 + e) * 136 + l0) = pack2(fa[e] * w0, fb[e] * w1);
          *(unsigned*)(sXT + ((pc + 4) * 8 + e) * 136 + l0) = pack2(fc[e] * w0, fd[e] * w1);
        }
      }
      __syncthreads();
      f32x4 acc[4][2];
#pragma unroll
      for (int i = 0; i < 4; i++) { acc[i][0] = f32x4{0, 0, 0, 0}; acc[i][1] = f32x4{0, 0, 0, 0}; }
      lds_gemm<4, 2, 4>(sXT, 136, sBT + (wid * 32) * 136, 136, acc);
      float* dst = WS_F(O_SST) + ((size_t)((dir * NCH + c) * 8 + h)) * 8192;
#pragma unroll
      for (int mi = 0; mi < 4; mi++)
#pragma unroll
        for (int ni = 0; ni < 2; ni++) *(f32x4*)(dst + (mi * 16 + l15) * 128 + wid * 32 + ni * 16 + quad * 4) = acc[mi][ni];
      __syncthreads();
    }
  }
}

DEV void ret_rope8(const Prm& p, int r, int nc, const uint4& c1, const uint4& c2, float scale, float (&o1)[8], float (&o2)[8]) {
  float x1[8], x2[8]; unpack8(c1, x1); unpack8(c2, x2);
  if (r >= CTX) {
    const float2* rcs = (const float2*)(p.ws + O_RCS);
    int t = r - CTX, pos = nc < 2 ? (t >> 6) : (t & 63);
    const float2* cs = rcs + pos * 16 + (nc & 1) * 8;
#pragma unroll
    for (int e = 0; e < 8; e++) { float2 v = cs[e]; o1[e] = (x1[e] * v.x - x2[e] * v.y) * scale; o2[e] = (x1[e] * v.y + x2[e] * v.x) * scale; }
  } else {
#pragma unroll
    for (int e = 0; e < 8; e++) { o1[e] = x1[e] * scale; o2[e] = x2[e] * scale; }
  }
}

DEV void ret_state_item(const Prm& p, int L, int it, char* smem) {
  TILE_IDS
  bfr* sVT = (bfr*)smem;
  bfr* sKT = sVT + 128 * 136;
  const int c = it >> 2, h = it & 3, r0 = c * 128;
  const bfr* U_ = WS_B(O_U);
  const float lgf = -expf(p.in[I_RDEC][L * 8 + h]), lgb = -expf(p.in[I_RDEC][L * 8 + 4 + h]);
  __syncthreads();
#pragma unroll 4
  for (int u = tid; u < 1024; u += 256) {
    int lp = u & 63, pc = u >> 6;
    const bfr* src = U_ + (size_t)(r0 + 2 * lp) * NU + C_RV + h * 128 + pc * 8;
    uint4 a = *(const uint4*)src, b2 = *(const uint4*)(src + NU);
#pragma unroll
    for (int e = 0; e < 8; e++) *(unsigned*)(sVT + (pc * 8 + e) * 136 + 2 * lp) = elem16(a, e) | (elem16(b2, e) << 16);
  }
  uint4 a1, a2, b1, b2;
  { const bfr* src = U_ + (size_t)(r0 + 2 * (tid & 63)) * NU + C_RK + h * 64 + (tid >> 6) * 8;
    a1 = *(const uint4*)src; a2 = *(const uint4*)(src + 32); b1 = *(const uint4*)(src + NU); b2 = *(const uint4*)(src + NU + 32); }
  for (int dir = 0; dir < 2; dir++) {
    {
      int lp = tid & 63, nc = tid >> 6, l0 = 2 * lp;
      float w0 = dir ? __expf((float)l0 * lgb) : __expf((float)(127 - l0) * lgf);
      float w1 = dir ? __expf((float)(l0 + 1) * lgb) : __expf((float)(126 - l0) * lgf);
      float p1[8], p2[8], q1[8], q2[8];
      ret_rope8(p, r0 + l0, nc, a1, a2, 0.125f * w0, p1, p2);
      ret_rope8(p, r0 + l0 + 1, nc, b1, b2, 0.125f * w1, q1, q2);
#pragma unroll
      for (int e = 0; e < 8; e++) {
        *(unsigned*)(sKT + (nc * 8 + e) * 136 + l0) = pack2(p1[e], q1[e]);
        *(unsigned*)(sKT + (32 + nc * 8 + e) * 136 + l0) = pack2(p2[e], q2[e]);
      }
    }
    __syncthreads();
    f32x4 acc[2][4];
#pragma unroll
    for (int i = 0; i < 2; i++)
#pragma unroll
      for (int j = 0; j < 4; j++) acc[i][j] = f32x4{0, 0, 0, 0};
    lds_gemm<2, 4, 4>(sVT + (wid * 32) * 136, 136, sKT, 136, acc);
    float* dst = WS_F(O_RST) + ((size_t)((dir * NCH + c) * 4 + h)) * 8192;
#pragma unroll
    for (int mi = 0; mi < 2; mi++)
#pragma unroll
      for (int ni = 0; ni < 4; ni++) *(f32x4*)(dst + (wid * 32 + mi * 16 + l15) * 64 + ni * 16 + quad * 4) = acc[mi][ni];
    __syncthreads();
  }
}
DEV void ph_states(const Prm& p, int L, char* smem) {
  constexpr int N0 = NCH * 6, N1 = N0 + NCH * 8, N2 = N1 + NCH * 4, N3 = N2 + NCH * 4;
  for (int it = VBX; it < N3; it += VGX) {
#ifdef ONLY3
    it = ONLY3 == 0 ? 0 : ONLY3 == 1 ? N0 : ONLY3 == 2 ? N1 : N2;
#endif
    if (it < N0) uq_tile(p, it, smem);
    else if (it < N1) { if (it - N0 < NCH * 4) ukn_tile(p, it - N0, smem); else uvt_tile(p, it - N0 - NCH * 4, smem); }
    else if (it < N2) ssm_state_item(p, L, it - N1, smem);
    else ret_state_item(p, L, it - N2, smem);
  }
}

DEV int chunk_order(int dir, int i) { return dir == 0 ? i : (i < 2 ? 1 - i : 131 - i); }
DEV void ph_scan(const Prm& p, int L) {
  for (int it = VBX; it < 384; it += VGX) {
    if (it < 256) {
      int gid = it * 256 + otid(), dir = gid >> 15, h = (gid >> 12) & 7, e2 = gid & 4095;
      float2 hr = {0, 0};
      for (int i0 = 0; i0 < NCH; i0 += 13) {
        float2 s[13]; float g[13];
#pragma unroll
        for (int j = 0; j < 13; j++) {
          int c = chunk_order(dir, i0 + j);
          s[j] = *(const float2*)(WS_F(O_SST) + ((size_t)((dir * NCH + c) * 8 + h)) * 8192 + e2 * 2);
          g[j] = WS_F(O_TOT)[(dir * NCH + c) * 8 + h];
        }
#pragma unroll
        for (int j = 0; j < 13; j++) {
          int c = chunk_order(dir, i0 + j);
          *(float2*)(WS_F(O_SST) + ((size_t)((dir * NCH + c) * 8 + h)) * 8192 + e2 * 2) = hr;
          hr.x = g[j] * hr.x + s[j].x; hr.y = g[j] * hr.y + s[j].y;
        }
      }
    } else {
      int gid = (it - 256) * 256 + otid(), dir = gid >> 14, h = (gid >> 12) & 3, e2 = gid & 4095;
      const float G = expf(-128.f * expf(p.in[I_RDEC][L * 8 + dir * 4 + h]));
      float2 hr = {0, 0};
      for (int i0 = 0; i0 < NCH; i0 += 13) {
        float2 s[13];
#pragma unroll
        for (int j = 0; j < 13; j++) {
          int c = chunk_order(dir, i0 + j);
          s[j] = *(const float2*)(WS_F(O_RST) + ((size_t)((dir * NCH + c) * 4 + h)) * 8192 + e2 * 2);
        }
#pragma unroll
        for (int j = 0; j < 13; j++) {
          int c = chunk_order(dir, i0 + j);
          *(float2*)(WS_F(O_RST) + ((size_t)((dir * NCH + c) * 4 + h)) * 8192 + e2 * 2) = hr;
          hr.x = G * hr.x + s[j].x; hr.y = G * hr.y + s[j].y;
        }
      }
    }
  }
}

DEV void ssm_out_item(const Prm& p, int L, int it, char* smem) {
  TILE_IDS
  bfr* sC = (bfr*)smem;
  bfr* sB = sC + 64 * 136;
  bfr* sP = sB; bfr* sX = sB + 64 * 136;
  float* sCum = (float*)(smem + 52224); float* sDt = sCum + 256; float* sSS = sDt + 256; float* sTmp = sSS + 64;
  const int c = it >> 2, g = (it >> 1) & 1, lh = it & 1, r0 = c * 128, rq0 = r0 + lh * 64;
  const bfr* X_ = WS_B(O_XBC);
  const bfr* U_ = WS_B(O_U);
  uint2 rawq;
  { const int dir_ = tid >> 7, i_ = tid & 127, l_ = dir_ ? 127 - i_ : i_;
    rawq = *(const uint2*)(U_ + (size_t)(r0 + l_) * NU + C_DT + dir_ * 8 + g * 4); }
  uint4 xr0, xr1, xr2, xr3;
#define SSM_XLOAD(h_) do { \
    const bfr* s0_ = X_ + (size_t)(r0 + 2 * (tid & 63)) * 1024 + (h_) * 64 + (tid >> 6) * 8; \
    xr0 = *(const uint4*)s0_; xr1 = *(const uint4*)(s0_ + 1024); xr2 = *(const uint4*)(s0_ + 32); xr3 = *(const uint4*)(s0_ + 1024 + 32); } while (0)
  SSM_XLOAD(g * 4);
  __syncthreads();
#pragma unroll 4
  for (int u = tid; u < 1024; u += 256) {
    int row = u >> 4, ch = u & 15;
    *(uint4*)(sC + row * 136 + ch * 8) = *(const uint4*)(X_ + (size_t)(rq0 + row) * 1024 + 768 + g * 128 + ch * 8);
  }
#pragma unroll 4
  for (int u = tid; u < 2048; u += 256) {
    int row = u >> 4, ch = u & 15;
    *(uint4*)(sB + row * 136 + ch * 8) = *(const uint4*)(X_ + (size_t)(r0 + row) * 1024 + 512 + g * 128 + ch * 8);
  }
  if (tid < 64) sSS[tid] = 0.f;
  __syncthreads();
  f32x4 cb[2][4];
#pragma unroll
  for (int i = 0; i < 2; i++)
#pragma unroll
    for (int j = 0; j < 4; j++) cb[i][j] = f32x4{0, 0, 0, 0};
  lds_gemm<2, 4, 4>(sC + (wm * 32) * 136, 136, sB + (wn * 64) * 136, 136, cb);
#pragma unroll 1
  for (int hh = 0; hh < 4; hh++) {
    f32x4 y[2][2];
    const int h = g * 4 + hh;
    __syncthreads();
    chunk_decay(p, L, hh == 0 ? lo16(rawq.x) : hh == 1 ? hi16(rawq.x) : hh == 2 ? lo16(rawq.y) : hi16(rawq.y), h, sCum, sDt, sTmp);
#pragma unroll
    for (int mi = 0; mi < 2; mi++) {
      const int rl = wm * 32 + mi * 16 + l15, ll = lh * 64 + rl;
      const float cfl = sCum[ll], cbl = sCum[128 + ll];
#pragma unroll
      for (int ni = 0; ni < 4; ni++) {
        const int s0 = wn * 64 + ni * 16 + quad * 4;
        float pv[4];
#pragma unroll
        for (int r = 0; r < 4; r++) {
          int s = s0 + r;
          float ef = (s <= ll) ? __expf(cfl - sCum[s]) * sDt[s] : 0.f;
          float eb = (s >= ll) ? __expf(cbl - sCum[128 + s]) * sDt[128 + s] : 0.f;
          pv[r] = cb[mi][ni][r] * (ef + eb);
        }
        *(uint2*)(sP + rl * 136 + s0) = pack4(pv[0], pv[1], pv[2], pv[3]);
      }
    }
    {
      const int lp = tid & 63, pc = tid >> 6;
#pragma unroll
      for (int e = 0; e < 8; e++) {
        *(unsigned*)(sX + (pc * 8 + e) * 136 + 2 * lp) = elem16(xr0, e) | (elem16(xr1, e) << 16);
        *(unsigned*)(sX + ((pc + 4) * 8 + e) * 136 + 2 * lp) = elem16(xr2, e) | (elem16(xr3, e) << 16);
      }
      if (hh < 3) SSM_XLOAD(h + 1);
    }
    __syncthreads();
#pragma unroll
    for (int i = 0; i < 2; i++) { y[i][0] = f32x4{0, 0, 0, 0}; y[i][1] = f32x4{0, 0, 0, 0}; }
    float4 hreg[8];
    {
      const float* hsrc = WS_F(O_SST) + ((size_t)((0 * NCH + c) * 8 + h)) * 8192;
#pragma unroll
      for (int k = 0; k < 8; k++) { int u = tid + 256 * k; hreg[k] = *(const float4*)(hsrc + (u >> 5) * 128 + (u & 31) * 4); }
    }
    lds_gemm<2, 2, 4>(sP + (wm * 32) * 136, 136, sX + (wn * 32) * 136, 136, y);
#pragma unroll
    for (int dir = 0; dir < 2; dir++) {
      __syncthreads();
#pragma unroll
      for (int k = 0; k < 8; k++) { int u = tid + 256 * k; *(uint2*)(sX + (u >> 5) * 136 + (u & 31) * 4) = pack4(hreg[k].x, hreg[k].y, hreg[k].z, hreg[k].w); }
      if (dir == 0) {
        const float* hsrc = WS_F(O_SST) + ((size_t)((1 * NCH + c) * 8 + h)) * 8192;
#pragma unroll
        for (int k = 0; k < 8; k++) { int u = tid + 256 * k; hreg[k] = *(const float4*)(hsrc + (u >> 5) * 128 + (u & 31) * 4); }
      }
      __syncthreads();
      f32x4 t[2][2];
#pragma unroll
      for (int i = 0; i < 2; i++) { t[i][0] = f32x4{0, 0, 0, 0}; t[i][1] = f32x4{0, 0, 0, 0}; }
      lds_gemm<2, 2, 4>(sC + (wm * 32) * 136, 136, sX + (wn * 32) * 136, 136, t);
#pragma unroll
      for (int mi = 0; mi < 2; mi++) {
        float e = __expf(sCum[dir * 128 + lh * 64 + wm * 32 + mi * 16 + l15]);
#pragma unroll
        for (int ni = 0; ni < 2; ni++)
#pragma unroll
          for (int r = 0; r < 4; r++) y[mi][ni][r] += e * t[mi][ni][r];
      }
    }
    const float Dh = p.in[I_SSMD][L * 8 + h];
#pragma unroll
    for (int mi = 0; mi < 2; mi++) {
      const int rl = wm * 32 + mi * 16 + l15, row = rq0 + rl;
      float part = 0.f;
#pragma unroll
      for (int ni = 0; ni < 2; ni++) {
        int p0 = wn * 32 + ni * 16 + quad * 4;
        float xf[4], zf[4];
        unpack4(*(const uint2*)(X_ + (size_t)row * 1024 + h * 64 + p0), xf);
        unpack4(*(const uint2*)(U_ + (size_t)row * NU + C_Z + h * 64 + p0), zf);
#pragma unroll
        for (int r = 0; r < 4; r++) {
          float v = (y[mi][ni][r] + Dh * xf[r]) * silu_f(zf[r]);
          y[mi][ni][r] = v; part += v * v;
        }
      }
      part += __shfl_xor(part, 16); part += __shfl_xor(part, 32);
      if (quad == 0) atomicAdd(&sSS[rl], part);
#pragma unroll
      for (int ni = 0; ni < 2; ni++) {
        int ch = hh * 64 + wn * 32 + ni * 16 + quad * 4;
        *(uint2*)(WS_B(O_BR) + (size_t)row * 2048 + 512 + g * 256 + ch) = pack4(y[mi][ni][0], y[mi][ni][1], y[mi][ni][2], y[mi][ni][3]);
      }
    }
  }
  __syncthreads();
  const float* ng = p.in[I_SNG] + L * 512 + g * 256;
#pragma unroll
  for (int mi = 0; mi < 2; mi++) {
    const int rl = wm * 32 + mi * 16 + l15, row = rq0 + rl;
    const float rstd = rsqrtf(sSS[rl] * (1.f / 256.f) + EPS);
#pragma unroll
    for (int hh = 0; hh < 4; hh++)
#pragma unroll
      for (int ni = 0; ni < 2; ni++) {
        int ch = hh * 64 + wn * 32 + ni * 16 + quad * 4;
        float4 gg = *(const float4*)(ng + ch);
        bfr* dst = WS_B(O_BR) + (size_t)row * 2048 + 512 + g * 256 + ch;
        float v[4]; unpack4(*(const uint2*)dst, v);
        *(uint2*)dst = pack4(v[0] * rstd * gg.x, v[1] * rstd * gg.y, v[2] * rstd * gg.z, v[3] * rstd * gg.w);
      }
  }
}

#undef SSM_XLOAD
DEV void ret_out_item(const Prm& p, int L, int it, char* smem) {
  TILE_IDS
  bfr* sQ = (bfr*)smem;
  bfr* sK = sQ + 64 * 72;
  bfr* sP = sK;
  bfr* sV = (bfr*)(smem + 27648);
  bfr* sH = sV;
  float* sSum = (float*)(smem + 62464); float* sSq = sSum + 64;
  const int c = it >> 3, h = (it >> 1) & 3, lh = it & 1, r0 = c * 128, rq0 = r0 + lh * 64;
  const bfr* U_ = WS_B(O_U);
  const float lgf = -expf(p.in[I_RDEC][L * 8 + h]), lgb = -expf(p.in[I_RDEC][L * 8 + 4 + h]);
  __syncthreads();
  {
    int row = tid >> 2, nc = tid & 3, r = rq0 + row;
    const bfr* src = U_ + (size_t)r * NU + C_RQ + h * 64 + nc * 8;
    float o1[8], o2[8];
    ret_rope8(p, r, nc, *(const uint4*)src, *(const uint4*)(src + 32), 1.f, o1, o2);
    *(uint4*)(sQ + row * 72 + nc * 8) = pack8(o1); *(uint4*)(sQ + row * 72 + 32 + nc * 8) = pack8(o2);
  }
  for (int u = tid; u < 512; u += 256) {
    int row = u >> 2, nc = u & 3, r = r0 + row;
    const bfr* src = U_ + (size_t)r * NU + C_RK + h * 64 + nc * 8;
    float o1[8], o2[8];
    ret_rope8(p, r, nc, *(const uint4*)src, *(const uint4*)(src + 32), 0.125f, o1, o2);
    *(uint4*)(sK + row * 72 + nc * 8) = pack8(o1); *(uint4*)(sK + row * 72 + 32 + nc * 8) = pack8(o2);
  }
#pragma unroll 4
  for (int u = tid; u < 1024; u += 256) {
    int lp = u & 63, pc = u >> 6;
    const bfr* src = U_ + (size_t)(r0 + 2 * lp) * NU + C_RV + h * 128 + pc * 8;
    uint4 a = *(const uint4*)src, b2 = *(const uint4*)(src + NU);
#pragma unroll
    for (int e = 0; e < 8; e++) *(unsigned*)(sV + (pc * 8 + e) * 136 + 2 * lp) = elem16(a, e) | (elem16(b2, e) << 16);
  }
  if (tid < 128) sSum[tid] = 0.f;
  __syncthreads();
  f32x4 qk[2][4];
#pragma unroll
  for (int i = 0; i < 2; i++)
#pragma unroll
    for (int j = 0; j < 4; j++) qk[i][j] = f32x4{0, 0, 0, 0};
  lds_gemm<2, 4, 2>(sQ + (wm * 32) * 72, 72, sK + (wn * 64) * 72, 72, qk);
  __syncthreads();
#pragma unroll
  for (int mi = 0; mi < 2; mi++) {
    const int rl = wm * 32 + mi * 16 + l15, ll = lh * 64 + rl;
#pragma unroll
    for (int ni = 0; ni < 4; ni++) {
      const int s0 = wn * 64 + ni * 16 + quad * 4;
      float pv[4];
#pragma unroll
      for (int r = 0; r < 4; r++) {
        int d = ll - (s0 + r);
        float wgt = (d >= 0 ? __expf((float)d * lgf) : 0.f) + (d <= 0 ? __expf((float)(-d) * lgb) : 0.f);
        pv[r] = qk[mi][ni][r] * wgt;
      }
      *(uint2*)(sP + rl * 136 + s0) = pack4(pv[0], pv[1], pv[2], pv[3]);
    }
  }
  __syncthreads();
  f32x4 y[2][4];
#pragma unroll
  for (int i = 0; i < 2; i++)
#pragma unroll
    for (int j = 0; j < 4; j++) y[i][j] = f32x4{0, 0, 0, 0};
  float4 hreg[8];
  {
    const float* hsrc = WS_F(O_RST) + ((size_t)((0 * NCH + c) * 4 + h)) * 8192;
#pragma unroll
    for (int k = 0; k < 8; k++) { int u = tid + 256 * k; hreg[k] = *(const float4*)(hsrc + (u >> 4) * 64 + (u & 15) * 4); }
  }
  lds_gemm<2, 4, 4>(sP + (wm * 32) * 136, 136, sV + (wn * 64) * 136, 136, y);
#pragma unroll
  for (int dir = 0; dir < 2; dir++) {
    __syncthreads();
#pragma unroll
    for (int k = 0; k < 8; k++) { int u = tid + 256 * k; *(uint2*)(sH + (u >> 4) * 72 + (u & 15) * 4) = pack4(hreg[k].x, hreg[k].y, hreg[k].z, hreg[k].w); }
    if (dir == 0) {
      const float* hsrc = WS_F(O_RST) + ((size_t)((1 * NCH + c) * 4 + h)) * 8192;
#pragma unroll
      for (int k = 0; k < 8; k++) { int u = tid + 256 * k; hreg[k] = *(const float4*)(hsrc + (u >> 4) * 64 + (u & 15) * 4); }
    }
    __syncthreads();
    f32x4 t[2][4];
#pragma unroll
    for (int i = 0; i < 2; i++)
#pragma unroll
      for (int j = 0; j < 4; j++) t[i][j] = f32x4{0, 0, 0, 0};
    lds_gemm<2, 4, 2>(sQ + (wm * 32) * 72, 72, sH + (wn * 64) * 72, 72, t);
#pragma unroll
    for (int mi = 0; mi < 2; mi++) {
      const int ll = lh * 64 + wm * 32 + mi * 16 + l15;
      float e = dir == 0 ? __expf((float)(ll + 1) * lgf) : __expf((float)(128 - ll) * lgb);
#pragma unroll
      for (int ni = 0; ni < 4; ni++)
#pragma unroll
        for (int r = 0; r < 4; r++) y[mi][ni][r] += e * t[mi][ni][r];
    }
  }
#pragma unroll
  for (int mi = 0; mi < 2; mi++) {
    const int rl = wm * 32 + mi * 16 + l15;
    float s1 = 0.f, s2 = 0.f;
#pragma unroll
    for (int ni = 0; ni < 4; ni++)
#pragma unroll
      for (int r = 0; r < 4; r++) { float v = y[mi][ni][r]; s1 += v; s2 += v * v; }
    s1 += __shfl_xor(s1, 16); s1 += __shfl_xor(s1, 32);
    s2 += __shfl_xor(s2, 16); s2 += __shfl_xor(s2, 32);
    if (quad == 0) { atomicAdd(&sSum[rl], s1); atomicAdd(&sSq[rl], s2); }
  }
  __syncthreads();
  const float* gg = p.in[I_RGNG] + L * 512 + h * 128;
  const float* gb = p.in[I_RGNB] + L * 512 + h * 128;
#pragma unroll
  for (int mi = 0; mi < 2; mi++) {
    const int rl = wm * 32 + mi * 16 + l15, row = rq0 + rl;
    const float mu = sSum[rl] * (1.f / 128.f);
    const float var = fmaxf(sSq[rl] * (1.f / 128.f) - mu * mu, 0.f);
    const float rstd = rsqrtf(var + EPS);
#pragma unroll
    for (int ni = 0; ni < 4; ni++) {
      int p0 = wn * 64 + ni * 16 + quad * 4;
      float gf[4]; unpack4(*(const uint2*)(U_ + (size_t)row * NU + C_RG + h * 128 + p0), gf);
      float4 g4 = *(const float4*)(gg + p0), b4 = *(const float4*)(gb + p0);
      float o0 = silu_f(gf[0]) * ((y[mi][ni][0] - mu) * rstd * g4.x + b4.x);
      float o1 = silu_f(gf[1]) * ((y[mi][ni][1] - mu) * rstd * g4.y + b4.y);
      float o2 = silu_f(gf[2]) * ((y[mi][ni][2] - mu) * rstd * g4.z + b4.z);
      float o3 = silu_f(gf[3]) * ((y[mi][ni][3] - mu) * rstd * g4.w + b4.w);
      *(uint2*)(WS_B(O_BR) + (size_t)row * 2048 + 1024 + h * 128 + p0) = pack4(o0, o1, o2, o3);
    }
  }
}

typedef __attribute__((ext_vector_type(16))) float f32x16;
DEV unsigned cvtpk(float lo, float hi) { unsigned r; asm("v_cvt_pk_bf16_f32 %0, %1, %2" : "=v"(r) : "v"(lo), "v"(hi)); return r; }
DEV void attn_item(const Prm& p, int q0, int head, int nkeys, char* smem) {
  const int tid = rtid(), lane = tid & 63, wid = tid >> 6, l31 = lane & 31, hi = lane >> 5;
  constexpr int LDK = 104, LDV = 72;
  bfr* sK0 = (bfr*)smem;
  bfr* sV0 = sK0 + 2 * 64 * LDK;
  const bfr* KN = WS_B(O_KN);
  const bfr* KR = WS_B(O_KROPE);
  const bfr* VT = WS_B(O_VT);
  const float qs = 0.10206207261596577f * 1.4426950408889634f;
  const float THR2 = 11.5f;
  bf16x8 qf[6];
  const int row = q0 + wid * 32 + l31;
  {
    const bfr* qp = WS_B(O_Q) + (size_t)row * 768 + head * 96;
#pragma unroll
    for (int ks = 0; ks < 4; ks++) {
      float f[8]; unpack8(*(const uint4*)(qp + ks * 16 + hi * 8), f);
      uint4 t = {cvtpk(f[0] * qs, f[1] * qs), cvtpk(f[2] * qs, f[3] * qs), cvtpk(f[4] * qs, f[5] * qs), cvtpk(f[6] * qs, f[7] * qs)};
      qf[ks] = *(bf16x8*)&t;
    }
    float x1[8], x2[8], o1[8], o2[8];
    unpack8(*(const uint4*)(qp + 64 + hi * 8), x1);
    unpack8(*(const uint4*)(qp + 80 + hi * 8), x2);
    if (row >= CTX) {
      const float2* mcs = (const float2*)(p.ws + O_MCS);
      int t = row - CTX, pos = hi ? (t & 63) : (t >> 6);
#pragma unroll
      for (int e = 0; e < 8; e++) {
        float2 cs = mcs[pos * 8 + e];
        o1[e] = (x1[e] * cs.x - x2[e] * cs.y) * qs; o2[e] = (x1[e] * cs.y + x2[e] * cs.x) * qs;
      }
    } else {
#pragma unroll
      for (int e = 0; e < 8; e++) { o1[e] = x1[e] * qs; o2[e] = x2[e] * qs; }
    }
    uint4 t1 = {cvtpk(o1[0], o1[1]), cvtpk(o1[2], o1[3]), cvtpk(o1[4], o1[5]), cvtpk(o1[6], o1[7])};
    uint4 t2 = {cvtpk(o2[0], o2[1]), cvtpk(o2[2], o2[3]), cvtpk(o2[4], o2[5]), cvtpk(o2[6], o2[7])};
    qf[4] = *(bf16x8*)&t1; qf[5] = *(bf16x8*)&t2;
  }
  f32x16 O0, O1;
#pragma unroll
  for (int r = 0; r < 16; r++) { O0[r] = 0.f; O1[r] = 0.f; }
  float mrun = -1e30f, lrun = 0.f;
  uint4 ek0, ek1, ev0, ok0, ok1, ov0;
  const int nt = nkeys >> 6;
  const bool k2 = tid < 256;
  const int ku0 = tid, ku1 = tid + 512;
  const int kk0 = ku0 / 12, kc0 = ku0 - kk0 * 12, kk1 = ku1 / 12, kc1 = ku1 - kk1 * 12;
  const bfr* ks0 = kc0 < 8 ? KN + (size_t)kk0 * 512 + head * 64 + kc0 * 8 : KR + (size_t)kk0 * 32 + (kc0 - 8) * 8;
  const bfr* ks1 = kc1 < 8 ? KN + (size_t)kk1 * 512 + head * 64 + kc1 * 8 : KR + (size_t)kk1 * 32 + (kc1 - 8) * 8;
  const int kst0 = kc0 < 8 ? 512 * 64 : 32 * 64, kst1 = kc1 < 8 ? 512 * 64 : 32 * 64;
  const int vd0 = tid >> 3, vc0 = tid & 7;
  const bfr* vs0 = VT + (size_t)(head * 64 + vd0) * ROWS + vc0 * 8;
  const int kw0 = kk0 * LDK + kc0 * 8, kw1 = kk1 * LDK + kc1 * 8;
  const int vw0 = vd0 * LDV + (vc0 >> 1) * 16 + (vc0 & 1) * 4;
#define ATT_KLOAD(S, t_) do { const int tc_ = min((int)(t_), nt - 1); S##k0 = *(const uint4*)(ks0 + (size_t)tc_ * kst0); if (k2) S##k1 = *(const uint4*)(ks1 + (size_t)tc_ * kst1); } while (0)
#define ATT_VLOAD(S, t_) do { const int tc_ = min((int)(t_), nt - 1); S##v0 = *(const uint4*)(vs0 + tc_ * 64); } while (0)
#define ATT_KSTORE(S, buf_) do { bfr* sK_ = sK0 + (buf_) * 64 * LDK; *(uint4*)(sK_ + kw0) = S##k0; if (k2) *(uint4*)(sK_ + kw1) = S##k1; } while (0)
#define ATT_VSTORE(S, buf_) do { bfr* sV_ = sV0 + (buf_) * 64 * LDV; \
       *(uint2*)(sV_ + vw0) = make_uint2(S##v0.x, S##v0.y); *(uint2*)(sV_ + vw0 + 8) = make_uint2(S##v0.z, S##v0.w); } while (0)
#define ATT_QK(SA_, SB_, buf_) do { const bfr* sK = sK0 + (buf_) * 64 * LDK; \
    _Pragma("unroll") for (int r = 0; r < 16; r++) { SA_[r] = 0.f; SB_[r] = 0.f; } \
    _Pragma("unroll") for (int ks = 0; ks < 6; ks++) { \
      bf16x8 k0 = *(const bf16x8*)(sK + l31 * LDK + ks * 16 + hi * 8); \
      bf16x8 k1 = *(const bf16x8*)(sK + (32 + l31) * LDK + ks * 16 + hi * 8); \
      SA_ = __builtin_amdgcn_mfma_f32_32x32x16_bf16(k0, qf[ks], SA_, 0, 0, 0); \
      SB_ = __builtin_amdgcn_mfma_f32_32x32x16_bf16(k1, qf[ks], SB_, 0, 0, 0); } } while (0)
#define ATT_SMPV(S0, S1, buf_) do { const bfr* sV = sV0 + (buf_) * 64 * LDV; \
    float pmax; asm("v_max_f32 %0, %1, %2" : "=v"(pmax) : "v"(S0[0]), "v"(S1[0])); \
    _Pragma("unroll") for (int r = 1; r < 16; r++) asm("v_max3_f32 %0, %1, %2, %3" : "=v"(pmax) : "v"(pmax), "v"(S0[r]), "v"(S1[r])); \
    { auto rr_ = __builtin_amdgcn_permlane32_swap(__float_as_uint(pmax), __float_as_uint(pmax), false, false); \
      pmax = fmaxf(__uint_as_float(rr_[0]), __uint_as_float(rr_[1])); } \
    if (!__all(pmax - mrun <= THR2)) { \
      const float mn = fmaxf(mrun, pmax); const float alpha = __builtin_amdgcn_exp2f(mrun - mn); \
      mrun = mn; lrun *= alpha; \
      _Pragma("unroll") for (int r = 0; r < 16; r++) { O0[r] *= alpha; O1[r] *= alpha; } } \
    float rs = 0.f; \
    _Pragma("unroll") for (int r = 0; r < 16; r++) { \
      S0[r] = __builtin_amdgcn_exp2f(S0[r] - mrun); S1[r] = __builtin_amdgcn_exp2f(S1[r] - mrun); rs += S0[r] + S1[r]; } \
    lrun += rs; \
    _Pragma("unroll") for (int kt = 0; kt < 2; kt++) \
    _Pragma("unroll") for (int sx = 0; sx < 2; sx++) { \
        uint4 pw; \
        if (kt == 0) pw = uint4{cvtpk(S0[8 * sx + 0], S0[8 * sx + 1]), cvtpk(S0[8 * sx + 2], S0[8 * sx + 3]), cvtpk(S0[8 * sx + 4], S0[8 * sx + 5]), cvtpk(S0[8 * sx + 6], S0[8 * sx + 7])}; \
        else         pw = uint4{cvtpk(S1[8 * sx + 0], S1[8 * sx + 1]), cvtpk(S1[8 * sx + 2], S1[8 * sx + 3]), cvtpk(S1[8 * sx + 4], S1[8 * sx + 5]), cvtpk(S1[8 * sx + 6], S1[8 * sx + 7])}; \
        bf16x8 pf = *(bf16x8*)&pw; \
        const int ko = kt * 32 + sx * 16 + hi * 8; \
        uint4 va = *(const uint4*)(sV + l31 * LDV + ko), vb = *(const uint4*)(sV + (32 + l31) * LDV + ko); \
        O0 = __builtin_amdgcn_mfma_f32_32x32x16_bf16(*(bf16x8*)&va, pf, O0, 0, 0, 0); \
        O1 = __builtin_amdgcn_mfma_f32_32x32x16_bf16(*(bf16x8*)&vb, pf, O1, 0, 0, 0); } } while (0)
#define ATT_STEP(S, SC0, SC1, SN0, SN1, t_) do { \
    ATT_KSTORE(S, (t_) & 1); \
    ATT_VSTORE(S, ((t_) + 1) & 1); \
    ATT_KLOAD(S, (t_) + 4); \
    ATT_VLOAD(S, (t_) + 3); \
    ATT_QK(SN0, SN1, ((t_) + 1) & 1); \
    ATT_SMPV(SC0, SC1, (t_) & 1); \
    __syncthreads(); } while (0)
  f32x16 SA0, SA1, SB0, SB1;
  __syncthreads();
  ATT_KLOAD(e, 0); ATT_VLOAD(e, 0); ATT_KLOAD(o, 1);
  ATT_KSTORE(e, 0); ATT_VSTORE(e, 0); ATT_KSTORE(o, 1);
  ATT_KLOAD(e, 2); ATT_VLOAD(e, 1); ATT_KLOAD(o, 3); ATT_VLOAD(o, 2);
  __syncthreads();
  ATT_QK(SA0, SA1, 0);
  __syncthreads();
#pragma unroll 1
  for (int t = 0; t < nt; t += 2) {
    ATT_STEP(e, SA0, SA1, SB0, SB1, t);
    ATT_STEP(o, SB0, SB1, SA0, SA1, t + 1);
  }
#undef ATT_KLOAD
#undef ATT_VLOAD
#undef ATT_KSTORE
#undef ATT_VSTORE
#undef ATT_QK
#undef ATT_SMPV
#undef ATT_STEP
  {
    float l = lrun + __shfl_xor(lrun, 32);
    const float inv = 1.f / l;
    bfr* orow = WS_B(O_BR) + (size_t)row * 2048 + 1536 + head * 64 + 4 * hi;
#pragma unroll
    for (int g4 = 0; g4 < 4; g4++) {
      *(uint2*)(orow + 8 * g4) = make_uint2(cvtpk(O0[4 * g4] * inv, O0[4 * g4 + 1] * inv), cvtpk(O0[4 * g4 + 2] * inv, O0[4 * g4 + 3] * inv));
      *(uint2*)(orow + 32 + 8 * g4) = make_uint2(cvtpk(O1[4 * g4] * inv, O1[4 * g4 + 1] * inv), cvtpk(O1[4 * g4 + 2] * inv, O1[4 * g4 + 3] * inv));
    }
  }
}

DEV void ph_mix(const Prm& p, int L, char* smem_base, char* smem) {
  constexpr int NQB = SEQ / 256;
  const int NA = NQB * 8 + (L == 0 ? 8 : 0);
#ifdef ATT_REP
  for (int rp_ = 0; rp_ < ATT_REP; rp_++)
#endif
  for (int it = blockIdx.x; it < NA; it += gridDim.x) {
    if (it < NQB * 8) {
      int head = it / NQB, qb = it % NQB;
      if (gridDim.x == 256) { const int b = blockIdx.x, xcd = b & 7, j = b >> 3, k = it >> 8; head = (xcd >> 1) + 4 * k; qb = (xcd & 1) * 32 + j; }
      attn_item(p, CTX + qb * 256, head, ROWS, smem_base);
    } else attn_item(p, 0, it - NQB * 8, CTX, smem_base);
  }
  constexpr int N2 = NCH * 4, N3 = N2 + NCH * 8;
  for (int it = VBX; it < N3; it += VGX) {
    if (it < N2) ssm_out_item(p, L, it, smem);
    else ret_out_item(p, L, it - N2, smem);
  }
}

#define XB_TMO      128
#define XB_XCNT(j)  (256  + 64 * (j))
#define XB_XSUB(j)  (1280 + 64 * (j))
#define XB_XGEN(j)  (2304 + 64 * (j))
#define XB_TOP      3328
#define XB_TOPGEN   3392
#define XCD_BAR_WORDS 3456
#define XB_SPIN_CAP (1u << 18)
#define LAS __attribute__((address_space(3)))
DEV unsigned xb_ld(unsigned* p)              { return __hip_atomic_load(p, __ATOMIC_RELAXED, __HIP_MEMORY_SCOPE_AGENT); }
DEV unsigned xb_add(unsigned* p, unsigned v) { return __hip_atomic_fetch_add(p, v, __ATOMIC_RELAXED, __HIP_MEMORY_SCOPE_AGENT); }
DEV unsigned xb_xcc_id() { return (unsigned)__builtin_amdgcn_s_getreg((3 << 11) | 20) & 0xFu; }
#define XB_SPIN(cond, bar) do { unsigned _sp = 0; while (cond) { __builtin_amdgcn_s_sleep(1); \
    if ((++_sp & 255u) == 0u) { if (xb_ld(&(bar)[XB_TMO])) break; if (_sp > XB_SPIN_CAP) { atomicAdd(&(bar)[XB_TMO], 1u); break; } } } } while (0)
struct XcdBarrier { unsigned* bar; unsigned x; volatile LAS unsigned* st; };
DEV XcdBarrier xcd_barrier_post(unsigned* bar, volatile LAS unsigned* st) {
  XcdBarrier b; b.bar = bar; b.x = xb_xcc_id(); b.st = st;
  if (__builtin_amdgcn_workitem_id_x() == 0) (void)xb_add(&bar[XB_XCNT(b.x)], 1u);
  return b;
}
DEV void xcd_barrier_complete(unsigned* bar, unsigned x, unsigned& nloc, unsigned& nx) {
  const unsigned G = gridDim.x * gridDim.y * gridDim.z;
  unsigned sum, cnt, mine, sp = 0u;
  for (;;) {
    sum = 0u; cnt = 0u; mine = 0u;
#pragma unroll
    for (unsigned j = 0; j < 16; ++j) { const unsigned c = xb_ld(&bar[XB_XCNT(j)]); sum += c; cnt += (c > 0u) ? 1u : 0u; mine = (j == x) ? c : mine; }
    if (sum == G) break;
    __builtin_amdgcn_s_sleep(1);
    if ((++sp & 255u) == 0u) { if (xb_ld(&bar[XB_TMO])) break; if (sp > XB_SPIN_CAP) { atomicAdd(&bar[XB_TMO], 1u); break; } }
  }
  nloc = mine > 0u ? mine : 1u; nx = cnt > 0u ? cnt : 1u;
}
DEV void xcd_barrier(const XcdBarrier& b) {
  asm volatile("s_waitcnt vmcnt(0)" ::: "memory");
  __syncthreads();
  if (__builtin_amdgcn_workitem_id_x() == 0) {
    unsigned* bar = b.bar;
    __builtin_amdgcn_s_waitcnt(0);
    unsigned nloc = b.st[0], nx = b.st[1];
    if (nloc == 0u) { xcd_barrier_complete(bar, b.x, nloc, nx); b.st[0] = nloc; b.st[1] = nx; }
    const unsigned old = xb_add(&bar[XB_XSUB(b.x)], 1u);
    const unsigned gen = old / nloc;
    if (old + 1u == (gen + 1u) * nloc) {
      __builtin_amdgcn_fence(__ATOMIC_RELEASE, "agent");
      asm volatile("s_waitcnt vmcnt(0)" ::: "memory");
      const unsigned og = xb_add(&bar[XB_TOP], 1u);
      const unsigned tg = og / nx;
      if (og + 1u == (tg + 1u) * nx) xb_add(&bar[XB_TOPGEN], 1u);
      else XB_SPIN(xb_ld(&bar[XB_TOPGEN]) == tg, bar);
      __builtin_amdgcn_fence(__ATOMIC_ACQUIRE, "agent");
      xb_add(&bar[XB_XGEN(b.x)], 1u);
      asm volatile("s_waitcnt vmcnt(0)" ::: "memory");
    } else {
      XB_SPIN(xb_ld(&bar[XB_XGEN(b.x)]) == gen, bar);
      __builtin_amdgcn_fence(__ATOMIC_ACQUIRE, "agent");
      asm volatile("s_waitcnt vmcnt(0)" ::: "memory");
    }
  }
  __syncthreads();
}

constexpr int NST = 13, NPH = 2 + 2 * (1 + 2 * NST);
DEV void run_phase(const Prm& p, int ph, char* smem_base) {
  char* smem = smem_base + (rtid() >> 8) * 63488;
  if (ph == 0) { ph_ada(p); return; }
  if (ph == 1) { ph_ada_reduce(p); return; }
  int q = ph - 2, L = q / (1 + 2 * NST), s = q % (1 + 2 * NST);
#ifdef CONV_REP
  if (s == 0) { for (int r_ = 0; r_ < CONV_REP; r_++) ph_convert(p, L, smem); return; }
#endif
  if (s == 0) { ph_convert(p, L, smem); return; }
  s -= 1;
  int b = s / NST, st = s % NST;
#ifdef ONLY
  st = ONLY;
#endif
#ifdef REP_MASK
  for (int rep_ = 0; rep_ < (((REP_MASK >> st) & 1) ? REP_N : 1); rep_++)
#endif
  switch (st) {
    case 0: ph_norm(p, L, b, 0); break;
    case 1: ph_inproj(p, smem_base); break;
    case 2: ph_local(p, L, smem); break;
    case 3: ph_states(p, L, smem); break;
    case 4: ph_scan(p, L); break;
    case 5: ph_mix(p, L, smem_base, smem); break;
    case 6: ph_gates(p, L, smem_base); break;
    case 7: ph_merge(p, L, smem); break;
    case 8: ph_resgemm(p, L, b, WS_B(O_H), D, WS_B(O_WTOUT), D, 2, true, smem_base); break;
    case 9: ph_norm(p, L, b, 1); break;
    case 10: ph_ffn1(p, L, smem_base); break;
    case 11: ph_resgemm(p, L, b, WS_B(O_U), FFN, WS_B(O_WTF2), FFN, 5, false, smem_base); break;
    case 12: if (L == 1) ph_final_norm(p, b); break;
  }
}

constexpr int DYN_LDS = 2 * 63488;
__global__ void __launch_bounds__(512) mega(Prm p, int ph0, int ph1) {
  extern __shared__ __attribute__((aligned(16))) char smem[];
  __shared__ uint4 xb_words;
#if COOP
  if (__builtin_amdgcn_workitem_id_x() == 0) xb_words = make_uint4(0u, 0u, 0u, 0u);
  __syncthreads();
  (void)xcd_barrier_post((unsigned*)(p.ws + O_BAR), (volatile LAS unsigned*)&xb_words);
#define GRID_BARRIER() do { if (ph1 > 100000) cg::this_grid().sync(); else { XcdBarrier xb_; xb_.bar = (unsigned*)(p.ws + O_BAR); xb_.x = xb_xcc_id(); xb_.st = (volatile LAS unsigned*)&xb_words; xcd_barrier(xb_); } } while (0)
#else
#define GRID_BARRIER() do {} while (0)
#endif
  for (int ph = ph0; ph < ph1; ph++) {
    if (ph >= 2 && ph < 2 + (1 + 2 * NST) && ((ph - 2) % (1 + 2 * NST)) >= 1 && (((ph - 2) % (1 + 2 * NST)) - 1) % NST == 12) continue;
    run_phase(p, ph, smem);
    if (ph + 1 < ph1) GRID_BARRIER();
  }
}

extern "C" void kernel_launch(void* const* d_in, const int* in_sizes, int n_in, void* d_out, int out_size, void* d_ws,
                              size_t ws_size, hipStream_t stream) {
  static int grid_blocks = 0;
  if (!grid_blocks) {
    int dev = 0, cus = 0, per_cu = 0;
    (void)hipGetDevice(&dev);
    (void)hipDeviceGetAttribute(&cus, hipDeviceAttributeMultiprocessorCount, dev);
    (void)hipFuncSetAttribute((const void*)mega, hipFuncAttributeMaxDynamicSharedMemorySize, DYN_LDS);
    (void)hipOccupancyMaxActiveBlocksPerMultiprocessor(&per_cu, mega, 512, DYN_LDS);
    if (per_cu > 1) per_cu = 1;
    if (per_cu < 1) per_cu = 1;
    grid_blocks = cus * per_cu;
  }
  Prm p{};
  for (int i = 0; i < N_INPUTS; i++) p.in[i] = (const float*)d_in[i];
  p.out = (float*)d_out;
  p.ws = (char*)d_ws;
#if COOP
  hipMemsetAsync((char*)d_ws + O_BAR, 0, 3456 * 4, stream);
  int ph0 = 0, ph1 = NPH;
  void* args[] = {&p, &ph0, &ph1};
  hipError_t e = hipLaunchCooperativeKernel((void*)mega, dim3(grid_blocks), dim3(512), args, DYN_LDS, stream);
  if (e != hipSuccess) fprintf(stderr, "cooperative launch failed: %s (grid %d)\n", hipGetErrorString(e), grid_blocks);
#else
  for (int ph = 0; ph < NPH; ph++) mega<<<grid_blocks, 512, DYN_LDS, stream>>>(p, ph, ph + 1);
#endif
}
```

```cpp
#include <hip/hip_runtime.h>
#include <hip/hip_cooperative_groups.h>
#include <cstdio>
namespace cg = cooperative_groups;

#ifndef COOP
#define COOP 1
#endif
#define REP_N 4

typedef unsigned short bfr;
typedef __attribute__((ext_vector_type(8))) short bf16x8;
typedef __attribute__((ext_vector_type(4))) float f32x4;
#define DEV __device__ __forceinline__

constexpr int D = 1024, SEQ = 16384, CTX = 256, ROWS = SEQ + CTX, NCH = ROWS / 128;
constexpr int NIN = 8880, NU = 4784, FFN = 2816, NMOD = 6144;
constexpr int C_Z = 1024, C_XBC = 1536, C_DT = 2560, C_RQ = 2576, C_RK = 2832, C_RV = 3088, C_RG = 3600,
              C_CQ = 4112, C_CKV = 4496, C_KR = 4752;
constexpr float EPS = 1e-6f;

enum { I_X, I_C, I_CTX, I_CCTX, I_WADA, I_BADA, I_N1G, I_N2G, I_WIN, I_CONVW, I_CONVB, I_CLNG, I_CLNB, I_SCW, I_SCB,
       I_DTB, I_ALOG, I_SSMD, I_SNG, I_RDEC, I_RGNG, I_RGNB, I_QNG, I_KVNG, I_WUQ, I_WUKV, I_WBR, I_WOUT, I_WF1,
       I_WF2, I_FNG, N_INPUTS };

struct Prm { const float* in[N_INPUTS]; float* out; char* ws; };

constexpr size_t al256(size_t x) { return (x + 255) & ~(size_t)255; }
constexpr size_t O_MOD   = 0;
constexpr size_t O_MODP  = al256(O_MOD + (size_t)2 * 3 * NMOD * 4);
constexpr size_t O_RCS   = al256(O_MODP + (size_t)16 * 2 * 3 * NMOD * 4);
constexpr size_t O_MCS   = al256(O_RCS + 256 * 16 * 8);
constexpr size_t O_CS    = al256(O_MCS + 256 * 8 * 8);
constexpr size_t O_RSQ   = al256(O_CS + (size_t)2 * CTX * D * 4);
constexpr size_t O_RSKV  = al256(O_RSQ + ROWS * 4);
constexpr size_t O_TOT   = al256(O_RSKV + ROWS * 4);
constexpr size_t O_KROPE = al256(O_TOT + 2 * NCH * 8 * 4);
constexpr size_t O_WTIN  = al256(O_KROPE + (size_t)ROWS * 32 * 2);
constexpr size_t O_WTBR  = al256(O_WTIN + (size_t)NIN * D * 2);
constexpr size_t O_WTOUT = al256(O_WTBR + (size_t)4 * D * 512 * 2);
constexpr size_t O_WTF1  = al256(O_WTOUT + (size_t)D * D * 2);
constexpr size_t O_WTF2  = al256(O_WTF1 + (size_t)2 * FFN * D * 2);
constexpr size_t O_WTUQ  = al256(O_WTF2 + (size_t)D * FFN * 2);
constexpr size_t O_WTUKV = al256(O_WTUQ + (size_t)768 * 384 * 2);
constexpr size_t O_H     = al256(O_WTUKV + (size_t)1024 * 256 * 2);
constexpr size_t O_U     = al256(O_H + (size_t)ROWS * D * 2);
constexpr size_t O_BR    = al256(O_U + (size_t)ROWS * NU * 2);
constexpr size_t O_XBC   = al256(O_BR + (size_t)ROWS * 2048 * 2);
constexpr size_t O_SST   = al256(O_XBC + (size_t)ROWS * 1024 * 2);
constexpr size_t O_RST   = al256(O_SST + (size_t)2 * NCH * 8 * 8192 * 4);
constexpr size_t O_Q     = al256(O_RST + (size_t)2 * NCH * 4 * 8192 * 4);
constexpr size_t O_KN    = al256(O_Q + (size_t)ROWS * 768 * 2);
constexpr size_t O_VT    = al256(O_KN + (size_t)ROWS * 512 * 2);
constexpr size_t O_BAR   = al256(O_VT + (size_t)512 * ROWS * 2);
constexpr size_t O_END   = al256(O_BAR + 3456 * 4);
static_assert(O_END <= (size_t)512 * 1024 * 1024, "workspace too large");

#define WS_F(off) ((float*)(p.ws + (off)))
#define WS_B(off) ((bfr*)(p.ws + (off)))

DEV int rtid() { int t = __builtin_amdgcn_workitem_id_x(); asm volatile("" : "+v"(t)); return t; }
DEV int otid() { return rtid() & 255; }
#define VBX ((int)(blockIdx.x * 2 + (rtid() >> 8)))
#define VGX ((int)(gridDim.x * 2))
DEV bfr f2bf(float f) { unsigned u = __float_as_uint(f); u += 0x7fffu + ((u >> 16) & 1u); return (bfr)(u >> 16); }
DEV float bf2f(unsigned h) { return __uint_as_float(h << 16); }
DEV unsigned pack2(float a, float b) { unsigned r; asm("v_cvt_pk_bf16_f32 %0, %1, %2" : "=v"(r) : "v"(a), "v"(b)); return r; }
DEV uint2 pack4(float a, float b, float c, float d) { uint2 r; r.x = pack2(a, b); r.y = pack2(c, d); return r; }
DEV float lo16(unsigned w) { return __uint_as_float(w << 16); }
DEV float hi16(unsigned w) { return __uint_as_float(w & 0xffff0000u); }
DEV void unpack8(const uint4& v, float (&f)[8]) {
  f[0] = lo16(v.x); f[1] = hi16(v.x); f[2] = lo16(v.y); f[3] = hi16(v.y);
  f[4] = lo16(v.z); f[5] = hi16(v.z); f[6] = lo16(v.w); f[7] = hi16(v.w);
}
DEV void unpack4(const uint2& v, float (&f)[4]) { f[0] = lo16(v.x); f[1] = hi16(v.x); f[2] = lo16(v.y); f[3] = hi16(v.y); }
DEV uint4 pack8(const float (&f)[8]) {
  uint4 r; r.x = pack2(f[0], f[1]); r.y = pack2(f[2], f[3]); r.z = pack2(f[4], f[5]); r.w = pack2(f[6], f[7]); return r;
}
DEV unsigned elem16(const uint4& v, int e) {
  unsigned w = (e >> 1) == 0 ? v.x : (e >> 1) == 1 ? v.y : (e >> 1) == 2 ? v.z : v.w;
  return (e & 1) ? (w >> 16) : (w & 0xffffu);
}
DEV float silu_f(float x) { return x / (1.f + __expf(-x)); }
DEV float sigm_f(float x) { return 1.f / (1.f + __expf(-x)); }
DEV float softplus_f(float x) { return x > 20.f ? x : log1pf(__expf(x)); }
DEV float wave_sum(float v) {
#pragma unroll
  for (int o = 32; o >= 1; o >>= 1) v += __shfl_xor(v, o);
  return v;
}

template <int MI, int NI, int KS>
DEV void lds_gemm(const bfr* sX, int ldx, const bfr* sW, int ldw, f32x4 (&acc)[MI][NI]) {
  const int lane = otid() & 63, l15 = lane & 15, quad = lane >> 4;
#pragma unroll
  for (int ks = 0; ks < KS; ks++) {
    bf16x8 xa[MI], wb[NI];
#pragma unroll
    for (int mi = 0; mi < MI; mi++) xa[mi] = *(const bf16x8*)(sX + (mi * 16 + l15) * ldx + ks * 32 + quad * 8);
#pragma unroll
    for (int ni = 0; ni < NI; ni++) wb[ni] = *(const bf16x8*)(sW + (ni * 16 + l15) * ldw + ks * 32 + quad * 8);
#pragma unroll
    for (int mi = 0; mi < MI; mi++)
#pragma unroll
      for (int ni = 0; ni < NI; ni++)
        acc[mi][ni] = __builtin_amdgcn_mfma_f32_16x16x32_bf16(wb[ni], xa[mi], acc[mi][ni], 0, 0, 0);
  }
}

DEV void gemm_mainloop(const bfr* __restrict__ A, int lda, const bfr* __restrict__ Bt, int ldb, int K,
                       f32x4 (&acc)[4][4], char* smem) {
  bfr* sA = (bfr*)smem;
  bfr* sB = sA + 128 * 72;
  const int tid = otid(), wid = tid >> 6, wm = wid >> 1, wn = wid & 1;
  const int lrow = tid >> 3, lkc = (tid & 7) * 8;
  const bfr* pa = A + (size_t)lrow * lda + lkc;
  const bfr* pb = Bt + (size_t)lrow * ldb + lkc;
  const size_t sa = (size_t)32 * lda, sb = (size_t)32 * ldb;
  uint4 ra0 = *(const uint4*)(pa), ra1 = *(const uint4*)(pa + sa), ra2 = *(const uint4*)(pa + 2 * sa), ra3 = *(const uint4*)(pa + 3 * sa);
  uint4 rb0 = *(const uint4*)(pb), rb1 = *(const uint4*)(pb + sb), rb2 = *(const uint4*)(pb + 2 * sb), rb3 = *(const uint4*)(pb + 3 * sb);
  bfr* wa = sA + lrow * 72 + lkc;
  bfr* wb = sB + lrow * 72 + lkc;
  const int nk = K >> 6;
#pragma unroll 1
  for (int kt = 0; kt < nk; kt++) {
    __syncthreads();
    *(uint4*)(wa) = ra0; *(uint4*)(wa + 32 * 72) = ra1; *(uint4*)(wa + 64 * 72) = ra2; *(uint4*)(wa + 96 * 72) = ra3;
    *(uint4*)(wb) = rb0; *(uint4*)(wb + 32 * 72) = rb1; *(uint4*)(wb + 64 * 72) = rb2; *(uint4*)(wb + 96 * 72) = rb3;
    __syncthreads();
    if (kt + 1 < nk) {
      pa += 64; pb += 64;
      ra0 = *(const uint4*)(pa); ra1 = *(const uint4*)(pa + sa); ra2 = *(const uint4*)(pa + 2 * sa); ra3 = *(const uint4*)(pa + 3 * sa);
      rb0 = *(const uint4*)(pb); rb1 = *(const uint4*)(pb + sb); rb2 = *(const uint4*)(pb + 2 * sb); rb3 = *(const uint4*)(pb + 3 * sb);
    }
    lds_gemm<4, 4, 2>(sA + (wm * 64) * 72, 72, sB + (wn * 64) * 72, 72, acc);
  }
}

DEV void gemm2_mainloop(const bfr* __restrict__ A, int lda, const bfr* __restrict__ Bt, int ldb, int K,
                        f32x4 (&acc)[8][4], char* smem) {
  constexpr int LDT = 32;
  bfr* sA0 = (bfr*)smem;
  bfr* sB0 = sA0 + 2 * 256 * LDT;
  const int tid = otid(), lane = tid & 63, wid = tid >> 6, wm = wid >> 1, wn = wid & 1, l15 = lane & 15, quad = lane >> 4;
  const int lrow = tid >> 2, lkc = (tid & 3) * 8;
  const bfr* pa = A + (size_t)lrow * lda + lkc;
  const bfr* pb = Bt + (size_t)lrow * ldb + lkc;
  const size_t sa = (size_t)64 * lda, sb = (size_t)64 * ldb;
  const int wo = lrow * LDT + (((tid & 3) ^ ((0x1320 >> (4 * ((lrow >> 2) & 3))) & 3)) * 8);
  const int rsw = ((quad ^ ((0x1320 >> (4 * ((l15 >> 2) & 3))) & 3)) * 8);
  uint4 ra0, ra1, ra2, ra3, rb0, rb1;
#define SBAR() __builtin_amdgcn_sched_barrier(0)
#define G2_LOADA() do { ra0 = *(const uint4*)(pa); ra1 = *(const uint4*)(pa + sa); ra2 = *(const uint4*)(pa + 2 * sa); ra3 = *(const uint4*)(pa + 3 * sa); pa += 32; } while (0)
#define G2_LOADB() do { rb0 = *(const uint4*)(pb); rb1 = *(const uint4*)(pb + sb); pb += 32; } while (0)
#define G2_STOREA(buf_) do { bfr* a_ = sA0 + (buf_) * 256 * LDT + wo; \
                       *(uint4*)(a_) = ra0; *(uint4*)(a_ + 64 * LDT) = ra1; *(uint4*)(a_ + 128 * LDT) = ra2; *(uint4*)(a_ + 192 * LDT) = ra3; } while (0)
#define G2_STOREB(buf_) do { bfr* b_ = sB0 + (buf_) * 128 * LDT + wo; *(uint4*)(b_) = rb0; *(uint4*)(b_ + 64 * LDT) = rb1; } while (0)
#ifdef PROBE_DMFMA
  f32x4 dacc[4] = {f32x4{0,0,0,0}, f32x4{0,0,0,0}, f32x4{0,0,0,0}, f32x4{0,0,0,0}};
#define MF4(xa_, mi_) do { _Pragma("unroll") for (int ni = 0; ni < 4; ni++) { acc[mi_][ni] = __builtin_amdgcn_mfma_f32_16x16x32_bf16(wb[ni], xa_, acc[mi_][ni], 0, 0, 0); dacc[ni] = __builtin_amdgcn_mfma_f32_16x16x32_bf16(wb[ni], xa_, dacc[ni], 0, 0, 0); } } while (0)
#else
#define MF4(xa_, mi_) do { _Pragma("unroll") for (int ni = 0; ni < 4; ni++) acc[mi_][ni] = __builtin_amdgcn_mfma_f32_16x16x32_bf16(wb[ni], xa_, acc[mi_][ni], 0, 0, 0); } while (0)
#endif
  const int nk = K >> 5;
  __syncthreads();
  G2_LOADA(); G2_LOADB(); G2_STOREA(0); G2_STOREB(0);
  if (nk > 1) { G2_LOADA(); G2_LOADB(); }
  __syncthreads();
#pragma unroll 1
  for (int kt = 0; kt < nk; kt++) {
    const int cur = kt & 1, nxt = cur ^ 1;
    const bool st = kt + 1 < nk, ld = kt + 2 < nk;
    const bfr* sA = sA0 + cur * 256 * LDT + (wm * 128 + l15) * LDT + rsw;
    const bfr* sB = sB0 + cur * 128 * LDT + (wn * 64 + l15) * LDT + rsw;
    bf16x8 wb[4];
#pragma unroll
    for (int ni = 0; ni < 4; ni++) wb[ni] = *(const bf16x8*)(sB + ni * 16 * LDT);
    bf16x8 f0 = *(const bf16x8*)(sA), f1 = *(const bf16x8*)(sA + 16 * LDT), f2;
    SBAR();
    f2 = *(const bf16x8*)(sA + 32 * LDT); MF4(f0, 0); SBAR();
    f0 = *(const bf16x8*)(sA + 48 * LDT); MF4(f1, 1); if (st) G2_STOREA(nxt); SBAR();
    f1 = *(const bf16x8*)(sA + 64 * LDT); MF4(f2, 2); if (st) G2_STOREB(nxt); SBAR();
    f2 = *(const bf16x8*)(sA + 80 * LDT); MF4(f0, 3); if (ld) G2_LOADA(); SBAR();
    f0 = *(const bf16x8*)(sA + 96 * LDT); MF4(f1, 4); if (ld) G2_LOADB(); SBAR();
    f1 = *(const bf16x8*)(sA + 112 * LDT); MF4(f2, 5); SBAR();
    MF4(f0, 6); SBAR();
    MF4(f1, 7);
    __syncthreads();
  }
#undef G2_LOADA
#undef G2_LOADB
#undef G2_STOREA
#undef G2_STOREB
#undef MF4
#ifdef PROBE_DMFMA
  if (dacc[0][0] + dacc[1][1] + dacc[2][2] + dacc[3][3] == 12345.678f) smem[otid()] = 1;
#endif
}
DEV void gemm4_mainloop(const bfr* __restrict__ A, int lda, const bfr* __restrict__ Bt, int ldb, int K,
                        f32x4 (&acc)[4][4], char* smem, const bfr* nA, const bfr* nBt, bool first,
                        const bfr*& g_pa, const bfr*& g_pb, uint4& g_pa0, uint4& g_pa1, uint4& g_pb0, uint4& g_pb1, uint4& g_qa0, uint4& g_qa1, uint4& g_qb0, uint4& g_qb1) {
  constexpr int LDT = 32;
  bfr* sA0 = (bfr*)smem;
  bfr* sB0 = sA0 + 2 * 128 * LDT;
  const int tid = otid(), lane = tid & 63, wid = tid >> 6, wm = wid >> 1, wn = wid & 1, l15 = lane & 15, quad = lane >> 4;
  const int lrow = tid >> 2, lkc = (tid & 3) * 8;
  const size_t offA = (size_t)lrow * lda + lkc, offB = (size_t)lrow * ldb + lkc;
  const size_t sa = (size_t)64 * lda, sb = (size_t)64 * ldb;
  const int wo = lrow * LDT + (((tid & 3) ^ ((0x1320 >> (4 * ((lrow >> 2) & 3))) & 3)) * 8);
  const int rsw = ((quad ^ ((0x1320 >> (4 * ((l15 >> 2) & 3))) & 3)) * 8);
  const bfr* npa = nA + offA; const bfr* npb = nBt + offB;
  int g_rem;
#define G4_LOAD(S) do { g_##S##a0 = *(const uint4*)(g_pa); g_##S##a1 = *(const uint4*)(g_pa + sa); g_##S##b0 = *(const uint4*)(g_pb); g_##S##b1 = *(const uint4*)(g_pb + sb); \
      g_rem -= 1; const bool sw_ = g_rem == 0; g_pa = sw_ ? npa : g_pa + 32; g_pb = sw_ ? npb : g_pb + 32; } while (0)
#define G4_STORE(S, buf_) do { bfr* a_ = sA0 + (buf_) * 128 * LDT + wo; bfr* b_ = sB0 + (buf_) * 128 * LDT + wo; \
      *(uint4*)(a_) = g_##S##a0; *(uint4*)(a_ + 64 * LDT) = g_##S##a1; *(uint4*)(b_) = g_##S##b0; *(uint4*)(b_ + 64 * LDT) = g_##S##b1; } while (0)
#define MF4(xa_, mi_) do { _Pragma("unroll") for (int ni = 0; ni < 4; ni++) acc[mi_][ni] = __builtin_amdgcn_mfma_f32_16x16x32_bf16(wb[ni], xa_, acc[mi_][ni], 0, 0, 0); } while (0)
#define G4_ITER(S, cur_) do { \
    const bfr* sA = sA0 + (cur_) * 128 * LDT + (wm * 64 + l15) * LDT + rsw; \
    const bfr* sB = sB0 + (cur_) * 128 * LDT + (wn * 64 + l15) * LDT + rsw; \
    bf16x8 wb[4]; \
    _Pragma("unroll") for (int ni = 0; ni < 4; ni++) wb[ni] = *(const bf16x8*)(sB + ni * 16 * LDT); \
    bf16x8 f0 = *(const bf16x8*)(sA), f1 = *(const bf16x8*)(sA + 16 * LDT), f2, f3; \
    SBAR(); \
    f2 = *(const bf16x8*)(sA + 32 * LDT); MF4(f0, 0); G4_STORE(S, (cur_) ^ 1); SBAR(); \
    f3 = *(const bf16x8*)(sA + 48 * LDT); MF4(f1, 1); G4_LOAD(S); SBAR(); \
    MF4(f2, 2); SBAR(); \
    MF4(f3, 3); \
    __syncthreads(); } while (0)
  const int nk = K >> 5;
  if (first) {
    g_pa = A + offA; g_pb = Bt + offB; g_rem = nk;
    __syncthreads();
    G4_LOAD(p); G4_LOAD(q);
    G4_STORE(p, 0);
    G4_LOAD(p);
    __syncthreads();
  } else {
    g_rem = nk - 3;
  }
#pragma unroll 1
  for (int kt = 0; kt < nk; kt += 2) {
    G4_ITER(q, 0);
    G4_ITER(p, 1);
  }
#undef G4_LOAD
#undef G4_STORE
#undef G4_ITER
#undef MF4
}
DEV void gemm4_single(const bfr* __restrict__ A, int lda, const bfr* __restrict__ Bt, int ldb, int K, f32x4 (&acc)[4][4], char* smem) {
  const bfr* g_pa = nullptr; const bfr* g_pb = nullptr; uint4 a0{}, a1{}, b0{}, b1{}, c0{}, c1{}, d0{}, d1{};
  gemm4_mainloop(A, lda, Bt, ldb, K, acc, smem, A, Bt, true, g_pa, g_pb, a0, a1, b0, b1, c0, c1, d0, d1);
}

DEV void gemm3_mainloop(const bfr* __restrict__ A, int lda, const bfr* __restrict__ Bt, int ldb, int K,
                        f32x4 (&acc)[8][4], char* smem, const bfr* nA, const bfr* nBt, bool first,
                        const bfr*& g_pa, const bfr*& g_pb, uint4& g_pa0, uint4& g_pa1, uint4& g_pb0, uint4& g_pb1, uint4& g_qa0, uint4& g_qa1, uint4& g_qb0, uint4& g_qb1) {
  int g_rem;
  constexpr int LDT = 32;
  bfr* sA0 = (bfr*)smem;
  bfr* sB0 = sA0 + 2 * 256 * LDT;
  const int tid = rtid(), lane = tid & 63, wid = tid >> 6, wm = wid >> 2, wn = wid & 3, l15 = lane & 15, quad = lane >> 4;
  const int lrow = tid >> 2, lkc = (tid & 3) * 8;
  const size_t offA = (size_t)lrow * lda + lkc, offB = (size_t)lrow * ldb + lkc;
  const size_t sa = (size_t)128 * lda, sb = (size_t)128 * ldb;
  const int wo = lrow * LDT + (((tid & 3) ^ ((0x1320 >> (4 * ((lrow >> 2) & 3))) & 3)) * 8);
  const int rsw = ((quad ^ ((0x1320 >> (4 * ((l15 >> 2) & 3))) & 3)) * 8);
  const bfr* npa = nA + offA; const bfr* npb = nBt + offB;
#define G3_LOAD(S) do { g_##S##a0 = *(const uint4*)(g_pa); g_##S##a1 = *(const uint4*)(g_pa + sa); g_##S##b0 = *(const uint4*)(g_pb); g_##S##b1 = *(const uint4*)(g_pb + sb); \
      g_rem -= 1; const bool sw_ = g_rem == 0;                   \
      g_pa = sw_ ? npa : g_pa + 32; g_pb = sw_ ? npb : g_pb + 32; } while (0)
#define G3_STORE(S, buf_) do { bfr* a_ = sA0 + (buf_) * 256 * LDT + wo; bfr* b_ = sB0 + (buf_) * 256 * LDT + wo; \
      *(uint4*)(a_) = g_##S##a0; *(uint4*)(a_ + 128 * LDT) = g_##S##a1; *(uint4*)(b_) = g_##S##b0; *(uint4*)(b_ + 128 * LDT) = g_##S##b1; } while (0)
#define MF4(xa_, mi_) do { _Pragma("unroll") for (int ni = 0; ni < 4; ni++) acc[mi_][ni] = __builtin_amdgcn_mfma_f32_16x16x32_bf16(wb[ni], xa_, acc[mi_][ni], 0, 0, 0); } while (0)
#define G3_ITER(S, cur_) do { \
    const bfr* sA = sA0 + (cur_) * 256 * LDT + (wm * 128 + l15) * LDT + rsw; \
    const bfr* sB = sB0 + (cur_) * 256 * LDT + (wn * 64 + l15) * LDT + rsw; \
    bf16x8 wb[4]; \
    _Pragma("unroll") for (int ni = 0; ni < 4; ni++) wb[ni] = *(const bf16x8*)(sB + ni * 16 * LDT); \
    bf16x8 f0 = *(const bf16x8*)(sA), f1 = *(const bf16x8*)(sA + 16 * LDT), f2; \
    SBAR(); \
    f2 = *(const bf16x8*)(sA + 32 * LDT); MF4(f0, 0); SBAR(); \
    f0 = *(const bf16x8*)(sA + 48 * LDT); MF4(f1, 1); G3_STORE(S, (cur_) ^ 1); SBAR(); \
    f1 = *(const bf16x8*)(sA + 64 * LDT); MF4(f2, 2); G3_LOAD(S); SBAR(); \
    f2 = *(const bf16x8*)(sA + 80 * LDT); MF4(f0, 3); SBAR(); \
    f0 = *(const bf16x8*)(sA + 96 * LDT); MF4(f1, 4); SBAR(); \
    f1 = *(const bf16x8*)(sA + 112 * LDT); MF4(f2, 5); SBAR(); \
    MF4(f0, 6); SBAR(); \
    MF4(f1, 7); \
    __syncthreads(); } while (0)
  const int nk = K >> 5;
  if (first) {
    g_pa = A + offA; g_pb = Bt + offB; g_rem = nk;
    __syncthreads();
    G3_LOAD(p); G3_LOAD(q);
    G3_STORE(p, 0);
    G3_LOAD(p);
    __syncthreads();
  } else {
    g_rem = nk - 3;
  }
#pragma unroll 1
  for (int kt = 0; kt < nk; kt += 2) {
    G3_ITER(q, 0);
    G3_ITER(p, 1);
  }
#undef G3_LOAD
#undef G3_STORE
#undef G3_ITER
#undef MF4
}
DEV void zero_acc84(f32x4 (&acc)[8][4]) {
#pragma unroll
  for (int i = 0; i < 8; i++)
#pragma unroll
    for (int j = 0; j < 4; j++) acc[i][j] = f32x4{0.f, 0.f, 0.f, 0.f};
}


DEV bool tile_remap(int r, int MT, int NT, int& mt, int& nt, int b, int G, bool clamp) {
  const int per = G >> 3;
  int lin = r * G + (b & 7) * per + (b >> 3);
  if (lin >= MT * NT) { if (!clamp) return false; lin = MT * NT - 1; }
  const int g = lin / (8 * NT), rem = lin - g * 8 * NT;
  const int gsz = min(8, MT - 8 * g);
  nt = rem / gsz; mt = 8 * g + rem - nt * gsz;
  return true;
}
DEV void zero_acc44(f32x4 (&acc)[4][4]) {
#pragma unroll
  for (int i = 0; i < 4; i++)
#pragma unroll
    for (int j = 0; j < 4; j++) acc[i][j] = f32x4{0.f, 0.f, 0.f, 0.f};
}

DEV const float* res_src(const Prm& p, int L, int b, int r) {
  if (r < CTX) return (L == 0 ? p.in[I_CTX] : (const float*)WS_F(O_CS)) + ((size_t)(b * CTX + r)) * D;
  return (L == 0 ? p.in[I_X] : (const float*)p.out) + ((size_t)b * SEQ + (r - CTX)) * D;
}
DEV float* res_dst(const Prm& p, int b, int r) {
  if (r < CTX) return WS_F(O_CS) + ((size_t)(b * CTX + r)) * D;
  return p.out + ((size_t)b * SEQ + (r - CTX)) * D;
}

DEV void ph_ada(const Prm& p) {
  const int tid = otid();
  for (int it = VBX; it < 193; it += VGX) {
    if (it < 192) {
      int L = it / 96, rem = it % 96, ks = rem / 6, cb = rem % 6;
      int j = (cb * 256 + tid) * 4;
      float4 a0 = {0, 0, 0, 0}, a1 = a0, a2 = a0;
      const float* W = p.in[I_WADA] + (size_t)L * D * NMOD;
      for (int k = ks * 64; k < ks * 64 + 64; k++) {
        float4 w = *(const float4*)(W + (size_t)k * NMOD + j);
        float s0 = silu_f(p.in[I_C][k]), s1 = silu_f(p.in[I_C][D + k]), s2 = silu_f(p.in[I_CCTX][k]);
        a0.x += s0 * w.x; a0.y += s0 * w.y; a0.z += s0 * w.z; a0.w += s0 * w.w;
        a1.x += s1 * w.x; a1.y += s1 * w.y; a1.z += s1 * w.z; a1.w += s1 * w.w;
        a2.x += s2 * w.x; a2.y += s2 * w.y; a2.z += s2 * w.z; a2.w += s2 * w.w;
      }
      float* MP = WS_F(O_MODP) + ((size_t)(ks * 2 + L) * 3) * NMOD;
      *(float4*)(MP + j) = a0; *(float4*)(MP + NMOD + j) = a1; *(float4*)(MP + 2 * NMOD + j) = a2;
    } else {
      float2* rcs = (float2*)(p.ws + O_RCS);
      float2* mcs = (float2*)(p.ws + O_MCS);
      for (int idx = tid; idx < 256 * 16; idx += 256) {
        int pos = idx >> 4, i = idx & 15;
        float inv = powf(10000.f, -(float)i / 16.f);
        float ang = (float)pos * inv;
        double t = (double)ang * 0.15915494309189535; t -= floor(t);
        float rr = (float)(t * 6.283185307179586);
        rcs[idx] = make_float2(__cosf(rr), __sinf(rr));
      }
      for (int idx = tid; idx < 256 * 8; idx += 256) {
        int pos = idx >> 3, i = idx & 7;
        float inv = powf(10000.f, -(float)i / 8.f);
        float ang = (float)pos * inv;
        double t = (double)ang * 0.15915494309189535; t -= floor(t);
        float rr = (float)(t * 6.283185307179586);
        mcs[idx] = make_float2(__cosf(rr), __sinf(rr));
      }
    }
  }
}
DEV void ph_ada_reduce(const Prm& p) {
  for (int idx = VBX * 256 + otid(); idx < 2 * 3 * NMOD; idx += VGX * 256) {
    int L = idx / (3 * NMOD), j = idx % NMOD;
    float s = p.in[I_BADA][L * NMOD + j];
    for (int ks = 0; ks < 16; ks++) {
      int r = (idx / NMOD) % 3;
      s += WS_F(O_MODP)[((size_t)(ks * 2 + L) * 3 + r) * NMOD + j];
    }
    WS_F(O_MOD)[idx] = s;
  }
}

DEV void transpose_tile(const float* __restrict__ src, int lds, int N, int k0, int n0, bfr* __restrict__ dst,
                        int ldd, int mode, const float* gain, float* sT) {
  const int tx = otid() & 63, ty = otid() >> 6;
  __syncthreads();
#pragma unroll
  for (int i = 0; i < 16; i++) {
    int k = k0 + ty + 4 * i, n = n0 + tx;
    float v = 0.f;
    if (n < N) { v = src[(size_t)k * lds + n]; if (gain) v *= gain[k]; }
    sT[(ty + 4 * i) * 65 + tx] = v;
  }
  __syncthreads();
#pragma unroll
  for (int i = 0; i < 16; i++) {
    int n = n0 + ty + 4 * i;
    if (n < N) {
      int dr = n;
      if (mode == 1) { int j = n < FFN ? n : n - FFN; dr = (j >> 5) * 64 + (n < FFN ? 0 : 32) + (j & 31); }
      if (mode == 2) { int hd = n >> 7, j = n & 127; dr = j < 64 ? hd * 64 + j : 512 + hd * 64 + (j - 64); }
      dst[(size_t)dr * ldd + k0 + tx] = f2bf(sT[tx * 65 + ty + 4 * i]);
    }
  }
}
DEV void ph_convert(const Prm& p, int L, char* smem) {
  float* sT = (float*)smem;
  constexpr int T0 = 16 * 139, T1 = T0 + 512, T2 = T1 + 256, T3 = T2 + 16 * 88, T4 = T3 + 44 * 16, T5 = T4 + 72,
                T6 = T5 + 64;
  for (int it = VBX; it < T6; it += VGX) {
    if (it < T0) {
      int kt = it % 16, nt = it / 16;
      transpose_tile(p.in[I_WIN] + (size_t)L * D * NIN, NIN, NIN, kt * 64, nt * 64, WS_B(O_WTIN), D, 0, nullptr, sT);
    } else if (it < T1) {
      int q = it - T0, i = q / 128, r = q % 128, kt = r % 8, nt = r / 8;
      transpose_tile(p.in[I_WBR] + ((size_t)L * 4 + i) * 512 * D, D, D, kt * 64, nt * 64,
                     WS_B(O_WTBR) + (size_t)i * D * 512, 512, 0, nullptr, sT);
    } else if (it < T2) {
      int q = it - T1, kt = q % 16, nt = q / 16;
      transpose_tile(p.in[I_WOUT] + (size_t)L * D * D, D, D, kt * 64, nt * 64, WS_B(O_WTOUT), D, 0, nullptr, sT);
    } else if (it < T3) {
      int q = it - T2, kt = q % 16, nt = q / 16;
      transpose_tile(p.in[I_WF1] + (size_t)L * D * 2 * FFN, 2 * FFN, 2 * FFN, kt * 64, nt * 64, WS_B(O_WTF1), D, 1,
                     nullptr, sT);
    } else if (it < T4) {
      int q = it - T3, kt = q % 44, nt = q / 44;
      transpose_tile(p.in[I_WF2] + (size_t)L * FFN * D, D, D, kt * 64, nt * 64, WS_B(O_WTF2), FFN, 0, nullptr, sT);
    } else if (it < T5) {
      int q = it - T4, kt = q % 6, nt = q / 6;
      transpose_tile(p.in[I_WUQ] + (size_t)L * 384 * 768, 768, 768, kt * 64, nt * 64, WS_B(O_WTUQ), 384, 0,
                     p.in[I_QNG] + L * 384, sT);
    } else {
      int q = it - T5, kt = q % 4, nt = q / 4;
      transpose_tile(p.in[I_WUKV] + (size_t)L * 256 * 1024, 1024, 1024, kt * 64, nt * 64, WS_B(O_WTUKV), 256, 2,
                     p.in[I_KVNG] + L * 256, sT);
    }
  }
}

DEV void ph_norm(const Prm& p, int L, int b, int which) {
  const int lane = otid() & 63, wid = otid() >> 6;
  const float* g = p.in[which ? I_N2G : I_N1G] + L * D;
  const int shift = which ? 3 : 0, scale = which ? 4 : 1;
  const int it0 = (which && L == 1) ? CTX / 4 : 0;
  for (int it = VBX + it0; it < ROWS / 4; it += 2 * VGX) {
    const bool hasB = it + VGX < ROWS / 4;
    const int rA = it * 4 + wid, rB = hasB ? (it + VGX) * 4 + wid : rA;
    const float* xA = which ? (const float*)res_dst(p, b, rA) : res_src(p, L, b, rA);
    const float* xB = which ? (const float*)res_dst(p, b, rB) : res_src(p, L, b, rB);
    float4 vA[4], vB[4]; float sA = 0.f, sB = 0.f;
#pragma unroll
    for (int i = 0; i < 4; i++) { vA[i] = *(const float4*)(xA + lane * 4 + 256 * i); vB[i] = *(const float4*)(xB + lane * 4 + 256 * i); }
#pragma unroll
    for (int i = 0; i < 4; i++) {
      sA += vA[i].x * vA[i].x + vA[i].y * vA[i].y + vA[i].z * vA[i].z + vA[i].w * vA[i].w;
      sB += vB[i].x * vB[i].x + vB[i].y * vB[i].y + vB[i].z * vB[i].z + vB[i].w * vB[i].w;
    }
    sA = wave_sum(sA); sB = wave_sum(sB);
    const float rsA = rsqrtf(sA * (1.f / D) + EPS), rsB = rsqrtf(sB * (1.f / D) + EPS);
    const float* mdA = WS_F(O_MOD) + (size_t)(L * 3 + (rA < CTX ? 2 : b)) * NMOD;
    const float* mdB = WS_F(O_MOD) + (size_t)(L * 3 + (rB < CTX ? 2 : b)) * NMOD;
    bfr* hA = WS_B(O_H) + (size_t)rA * D;
    bfr* hB = WS_B(O_H) + (size_t)rB * D;
#pragma unroll
    for (int i = 0; i < 4; i++) {
      int c = lane * 4 + 256 * i;
      float4 gg = *(const float4*)(g + c);
      float4 scA = *(const float4*)(mdA + scale * D + c), shA = *(const float4*)(mdA + shift * D + c);
      float4 scB = *(const float4*)(mdB + scale * D + c), shB = *(const float4*)(mdB + shift * D + c);
      *(uint2*)(hA + c) = pack4(vA[i].x * rsA * gg.x * (1.f + scA.x) + shA.x, vA[i].y * rsA * gg.y * (1.f + scA.y) + shA.y,
                                vA[i].z * rsA * gg.z * (1.f + scA.z) + shA.z, vA[i].w * rsA * gg.w * (1.f + scA.w) + shA.w);
      if (hasB)
        *(uint2*)(hB + c) = pack4(vB[i].x * rsB * gg.x * (1.f + scB.x) + shB.x, vB[i].y * rsB * gg.y * (1.f + scB.y) + shB.y,
                                  vB[i].z * rsB * gg.z * (1.f + scB.z) + shB.z, vB[i].w * rsB * gg.w * (1.f + scB.w) + shB.w);
    }
  }
}
DEV void ph_final_norm(const Prm& p, int b) {
  const int lane = otid() & 63, wid = otid() >> 6;
  const float* g = p.in[I_FNG];
  for (int it = VBX; it < SEQ / 4; it += VGX) {
    float* xr = p.out + ((size_t)b * SEQ + it * 4 + wid) * D;
    float4 v[4]; float ss = 0.f;
#pragma unroll
    for (int i = 0; i < 4; i++) {
      v[i] = *(const float4*)(xr + lane * 4 + 256 * i);
      ss += v[i].x * v[i].x + v[i].y * v[i].y + v[i].z * v[i].z + v[i].w * v[i].w;
    }
    ss = wave_sum(ss);
    float rstd = rsqrtf(ss * (1.f / D) + EPS);
#pragma unroll
    for (int i = 0; i < 4; i++) {
      int c = lane * 4 + 256 * i;
      float4 gg = *(const float4*)(g + c);
      float4 o = {v[i].x * rstd * gg.x, v[i].y * rstd * gg.y, v[i].z * rstd * gg.z, v[i].w * rstd * gg.w};
      *(float4*)(xr + c) = o;
    }
  }
}

#define TILE_IDS                                                                   \
  int tid_ = otid();                           \
  const int tid = tid_, lane = tid & 63, wid = tid >> 6, l15 = lane & 15, quad = lane >> 4, \
            wm = wid >> 1, wn = wid & 1;                                           \
  (void)wm; (void)wn; (void)l15; (void)quad;

#define TILE_IDS3                                                                  \
  const int tid = rtid(), lane = tid & 63, wid = tid >> 6, l15 = lane & 15, quad = lane >> 4, \
            wm = wid >> 2, wn = wid & 3;                                           \
  (void)wm; (void)wn; (void)l15; (void)quad;
DEV void ph_inproj(const Prm& p, char* smem) {
  TILE_IDS3
  constexpr int NT = 19, MT = ROWS / 256;
  const bfr* g_pa = nullptr; const bfr* g_pb = nullptr; uint4 g_pa0{}, g_pa1{}, g_pb0{}, g_pb1{}, g_qa0{}, g_qa1{}, g_qb0{}, g_qb1{}; bool first = true;
  for (int rd = 0; rd * (int)gridDim.x < MT * NT; rd++) {
    int mt, nt; if (!tile_remap(rd, MT, NT, mt, nt, blockIdx.x, gridDim.x, false)) continue;
    int m0 = mt * 256, n0 = nt * 256;
    int mt2, nt2; const bool hasn = tile_remap(rd + 1, MT, NT, mt2, nt2, blockIdx.x, gridDim.x, false);
    if (!hasn) { mt2 = mt; nt2 = nt; }
    f32x4 acc[8][4]; zero_acc84(acc);
    gemm3_mainloop(WS_B(O_H) + (size_t)m0 * D, D, WS_B(O_WTIN) + (size_t)n0 * D, D, D, acc, smem,
                   WS_B(O_H) + (size_t)(mt2 * 256) * D, WS_B(O_WTIN) + (size_t)(nt2 * 256) * D, first, g_pa, g_pb, g_pa0, g_pa1, g_pb0, g_pb1, g_qa0, g_qa1, g_qb0, g_qb1);
    first = !hasn;
#pragma unroll
    for (int mi = 0; mi < 8; mi++)
#pragma unroll
      for (int ni = 0; ni < 4; ni++) {
        int row = m0 + wm * 128 + mi * 16 + l15, col = n0 + wn * 64 + ni * 16 + quad * 4;
        if (col < NU) *(uint2*)(WS_B(O_U) + (size_t)row * NU + col) = pack4(acc[mi][ni][0], acc[mi][ni][1], acc[mi][ni][2], acc[mi][ni][3]);
      }
  }
}
DEV void ph_gates(const Prm& p, int L, char* smem) {
  TILE_IDS3
  constexpr int NT = 16;
  const int mt0 = L == 1 ? 1 : 0, MT = ROWS / 256 - mt0;
  const bfr* g_pa = nullptr; const bfr* g_pb = nullptr; uint4 g_pa0{}, g_pa1{}, g_pb0{}, g_pb1{}, g_qa0{}, g_qa1{}, g_qb0{}, g_qb1{}; bool first = true;
  for (int rd = 0; rd * (int)gridDim.x < MT * NT; rd++) {
    int mt, nt; if (!tile_remap(rd, MT, NT, mt, nt, blockIdx.x, gridDim.x, false)) continue;
    mt += mt0; int m0 = mt * 256, n0 = nt * 256;
    int mt2, nt2; const bool hasn = tile_remap(rd + 1, MT, NT, mt2, nt2, blockIdx.x, gridDim.x, false);
    if (hasn) mt2 += mt0; else { mt2 = mt; nt2 = nt; }
    f32x4 acc[8][4]; zero_acc84(acc);
    gemm3_mainloop(WS_B(O_H) + (size_t)m0 * D, D, WS_B(O_WTIN) + (size_t)(NU + n0) * D, D, D, acc, smem,
                   WS_B(O_H) + (size_t)(mt2 * 256) * D, WS_B(O_WTIN) + (size_t)(NU + nt2 * 256) * D, first, g_pa, g_pb, g_pa0, g_pa1, g_pb0, g_pb1, g_qa0, g_qa1, g_qb0, g_qb1);
    first = !hasn;
#pragma unroll
    for (int mi = 0; mi < 8; mi++)
#pragma unroll
      for (int ni = 0; ni < 4; ni++) {
        int row = m0 + wm * 128 + mi * 16 + l15, col = n0 + wn * 64 + ni * 16 + quad * 4;
        *(uint2*)(WS_B(O_U) + (size_t)row * 4096 + col) =
            pack4(sigm_f(acc[mi][ni][0]), sigm_f(acc[mi][ni][1]), sigm_f(acc[mi][ni][2]), sigm_f(acc[mi][ni][3]));
      }
  }
}
DEV void ph_merge(const Prm& p, int L, char* smem) {
  TILE_IDS
  const int mt0 = L == 1 ? 2 : 0;
  const bfr* g_pa = nullptr; const bfr* g_pb = nullptr; uint4 g_a0{}, g_a1{}, g_b0{}, g_b1{}, g_c0{}, g_c1{}, g_d0{}, g_d1{}; bool first = true;
  const int NT_ = (NCH - mt0) * 8;
  for (int rd = 0; rd * (int)VGX < NT_; rd++) {
    int mt, nt; tile_remap(rd, NCH - mt0, 8, mt, nt, VBX, VGX, true);
    mt += mt0; int m0 = mt * 128, n0 = nt * 128;
    const bool hasn = (rd + 1) * (int)VGX < NT_;
    int mt2 = mt, nt2 = nt; if (hasn) { tile_remap(rd + 1, NCH - mt0, 8, mt2, nt2, VBX, VGX, true); mt2 += mt0; }
    f32x4 macc[4][4]; zero_acc44(macc);
#pragma unroll 1
    for (int i = 0; i < 4; i++) {
      f32x4 acc[4][4]; zero_acc44(acc);
      const bool lastb = i == 3;
      const bfr* nA_ = lastb ? WS_B(O_BR) + (size_t)(mt2 * 128) * 2048 : WS_B(O_BR) + (size_t)m0 * 2048 + (i + 1) * 512;
      const bfr* nB_ = lastb ? WS_B(O_WTBR) + (size_t)(nt2 * 128) * 512 : WS_B(O_WTBR) + ((size_t)(i + 1) * D + n0) * 512;
      gemm4_mainloop(WS_B(O_BR) + (size_t)m0 * 2048 + i * 512, 2048, WS_B(O_WTBR) + ((size_t)i * D + n0) * 512, 512, 512, acc, smem,
                     nA_, nB_, first, g_pa, g_pb, g_a0, g_a1, g_b0, g_b1, g_c0, g_c1, g_d0, g_d1);
      first = lastb && !hasn;
#pragma unroll
      for (int mi = 0; mi < 4; mi++)
#pragma unroll
        for (int ni = 0; ni < 4; ni++) {
          int row = m0 + wm * 64 + mi * 16 + l15, col = n0 + wn * 64 + ni * 16 + quad * 4;
          uint2 gv = *(const uint2*)(WS_B(O_U) + (size_t)row * 4096 + i * D + col);
          float gf[4]; unpack4(gv, gf);
#pragma unroll
          for (int r = 0; r < 4; r++) macc[mi][ni][r] += gf[r] * acc[mi][ni][r];
        }
    }
#pragma unroll
    for (int mi = 0; mi < 4; mi++)
#pragma unroll
      for (int ni = 0; ni < 4; ni++) {
        int row = m0 + wm * 64 + mi * 16 + l15, col = n0 + wn * 64 + ni * 16 + quad * 4;
        *(uint2*)(WS_B(O_H) + (size_t)row * D + col) = pack4(macc[mi][ni][0], macc[mi][ni][1], macc[mi][ni][2], macc[mi][ni][3]);
      }
  }
}
DEV void ph_resgemm(const Prm& p, int L, int b, const bfr* A, int lda, const bfr* Wt, int K, int gate_idx,
                    bool from_src, char* smem) {
  TILE_IDS3
  const int mt0 = L == 1 ? 1 : 0, MT = ROWS / 256 - mt0;
  const bfr* g_pa = nullptr; const bfr* g_pb = nullptr; uint4 g_pa0{}, g_pa1{}, g_pb0{}, g_pb1{}, g_qa0{}, g_qa1{}, g_qb0{}, g_qb1{}; bool first = true;
  for (int rd = 0; rd * (int)gridDim.x < MT * 4; rd++) {
    int mt, nt; if (!tile_remap(rd, MT, 4, mt, nt, blockIdx.x, gridDim.x, false)) continue;
    mt += mt0; int m0 = mt * 256, n0 = nt * 256;
    int mt2, nt2; const bool hasn = tile_remap(rd + 1, MT, 4, mt2, nt2, blockIdx.x, gridDim.x, false);
    if (hasn) mt2 += mt0; else { mt2 = mt; nt2 = nt; }
    f32x4 acc[8][4]; zero_acc84(acc);
    gemm3_mainloop(A + (size_t)m0 * lda, lda, Wt + (size_t)n0 * K, K, K, acc, smem,
                   A + (size_t)(mt2 * 256) * lda, Wt + (size_t)(nt2 * 256) * K, first, g_pa, g_pb, g_pa0, g_pa1, g_pb0, g_pb1, g_qa0, g_qa1, g_qb0, g_qb1);
    first = !hasn;
#pragma unroll
    for (int mi = 0; mi < 8; mi++) {
      int row = m0 + wm * 128 + mi * 16 + l15;
      const float* rs = from_src ? res_src(p, L, b, row) : (const float*)res_dst(p, b, row);
      float* rd = res_dst(p, b, row);
      const float* md = WS_F(O_MOD) + (size_t)(L * 3 + (row < CTX ? 2 : b)) * NMOD + gate_idx * D;
#pragma unroll
      for (int ni = 0; ni < 4; ni++) {
        int col = n0 + wn * 64 + ni * 16 + quad * 4;
        float4 x = *(const float4*)(rs + col), g = *(const float4*)(md + col);
        float4 o = {x.x + g.x * acc[mi][ni][0], x.y + g.y * acc[mi][ni][1], x.z + g.z * acc[mi][ni][2], x.w + g.w * acc[mi][ni][3]};
        *(float4*)(rd + col) = o;
      }
    }
  }
}
DEV void ph_ffn1(const Prm& p, int L, char* smem) {
  TILE_IDS3
  constexpr int NT = 22;
  const int mt0 = L == 1 ? 1 : 0, MT = ROWS / 256 - mt0;
  const bfr* g_pa = nullptr; const bfr* g_pb = nullptr; uint4 g_pa0{}, g_pa1{}, g_pb0{}, g_pb1{}, g_qa0{}, g_qa1{}, g_qb0{}, g_qb1{}; bool first = true;
  for (int rd = 0; rd * (int)gridDim.x < MT * NT; rd++) {
    int mt, nt; if (!tile_remap(rd, MT, NT, mt, nt, blockIdx.x, gridDim.x, false)) continue;
    mt += mt0; int m0 = mt * 256, n0 = nt * 256;
    int mt2, nt2; const bool hasn = tile_remap(rd + 1, MT, NT, mt2, nt2, blockIdx.x, gridDim.x, false);
    if (hasn) mt2 += mt0; else { mt2 = mt; nt2 = nt; }
    f32x4 acc[8][4]; zero_acc84(acc);
    gemm3_mainloop(WS_B(O_H) + (size_t)m0 * D, D, WS_B(O_WTF1) + (size_t)n0 * D, D, D, acc, smem,
                   WS_B(O_H) + (size_t)(mt2 * 256) * D, WS_B(O_WTF1) + (size_t)(nt2 * 256) * D, first, g_pa, g_pb, g_pa0, g_pa1, g_pb0, g_pb1, g_qa0, g_qa1, g_qb0, g_qb1);
    first = !hasn;
    int j0 = ((n0 + wn * 64) >> 6) * 32;
#pragma unroll
    for (int mi = 0; mi < 8; mi++)
#pragma unroll
      for (int ni = 0; ni < 2; ni++) {
        int row = m0 + wm * 128 + mi * 16 + l15, col = j0 + ni * 16 + quad * 4;
        float f[4];
#pragma unroll
        for (int r = 0; r < 4; r++) f[r] = silu_f(acc[mi][ni + 2][r]) * acc[mi][ni][r];
        *(uint2*)(WS_B(O_U) + (size_t)row * FFN + col) = pack4(f[0], f[1], f[2], f[3]);
      }
  }
}

DEV void conv_module_item(const Prm& p, int L, int grp, char* smem) {
  const int tid = otid(), lane = tid & 63, wid = tid >> 6;
  unsigned* sG = (unsigned*)smem;
  float* sR = (float*)(smem + 47104);
  const int t0 = grp * 16, seg0 = t0 < CTX ? 0 : CTX, seg1 = t0 < CTX ? CTX : ROWS;
  const int c = tid * 2;
  const bfr* U_ = WS_B(O_U);
  __syncthreads();
#pragma unroll 8
  for (int rr = 0; rr < 46; rr++) {
    const int r = t0 - 15 + rr, rc = min(max(r, seg0), seg1 - 1);
    const unsigned aa = *(const unsigned*)(U_ + (size_t)rc * NU + c), gg = *(const unsigned*)(U_ + (size_t)rc * NU + 512 + c);
    const unsigned v = pack2(lo16(aa) * sigm_f(lo16(gg)), hi16(aa) * sigm_f(hi16(gg)));
    sG[rr * 256 + tid] = (r == rc) ? v : 0u;
  }
  __syncthreads();
  const float* cw = p.in[I_CONVW] + (size_t)L * 31 * 512 + c;
  float2 cb = *(const float2*)(p.in[I_CONVB] + L * 512 + c);
  float a0[16], a1[16];
#pragma unroll
  for (int o = 0; o < 16; o++) { a0[o] = cb.x; a1[o] = cb.y; }
  float2 wj[31];
#pragma unroll
  for (int j = 0; j < 31; j++) wj[j] = *(const float2*)(cw + j * 512);
#pragma unroll
  for (int j = 0; j < 31; j++) {
    const float2 w = wj[j];
#pragma unroll
    for (int o = 0; o < 16; o++) {
      unsigned vv = sG[(o + j) * 256 + tid];
      a0[o] += w.x * lo16(vv); a1[o] += w.y * hi16(vv);
    }
  }
  float mu[16], rs[16];
#pragma unroll
  for (int o = 0; o < 16; o++) { float s = wave_sum(a0[o] + a1[o]); if (lane == 0) sR[wid * 16 + o] = s; }
  __syncthreads();
#pragma unroll
  for (int o = 0; o < 16; o++) mu[o] = (sR[o] + sR[16 + o] + sR[32 + o] + sR[48 + o]) * (1.f / 512.f);
  __syncthreads();
#pragma unroll
  for (int o = 0; o < 16; o++) {
    float d0 = a0[o] - mu[o], d1 = a1[o] - mu[o];
    float s = wave_sum(d0 * d0 + d1 * d1);
    if (lane == 0) sR[wid * 16 + o] = s;
  }
  __syncthreads();
#pragma unroll
  for (int o = 0; o < 16; o++) rs[o] = rsqrtf((sR[o] + sR[16 + o] + sR[32 + o] + sR[48 + o]) * (1.f / 512.f) + EPS);
  float2 lg = *(const float2*)(p.in[I_CLNG] + L * 512 + c), lb = *(const float2*)(p.in[I_CLNB] + L * 512 + c);
#pragma unroll
  for (int o = 0; o < 16; o++) {
    float y0 = (a0[o] - mu[o]) * rs[o] * lg.x + lb.x, y1 = (a1[o] - mu[o]) * rs[o] * lg.y + lb.y;
    *(unsigned*)(WS_B(O_BR) + (size_t)(t0 + o) * 2048 + c) = pack2(silu_f(y0), silu_f(y1));
  }
}
DEV void xbc_conv_item(const Prm& p, int L, int grp) {
  const int tid = otid();
  const int t0 = grp * 16, seg0 = t0 < CTX ? 0 : CTX, seg1 = t0 < CTX ? CTX : ROWS;
  const int c = tid * 4;
  float4 w[5];
#pragma unroll
  for (int j = 0; j < 5; j++) w[j] = *(const float4*)(p.in[I_SCW] + ((size_t)L * 5 + j) * 1024 + c);
  float4 bb = *(const float4*)(p.in[I_SCB] + L * 1024 + c);
  float4 a[16];
#pragma unroll
  for (int o = 0; o < 16; o++) a[o] = bb;
  const bfr* U_ = WS_B(O_U);
#pragma unroll
  for (int ii = 0; ii < 20; ii++) {
    const int r = t0 - 2 + ii, rc = min(max(r, seg0), seg1 - 1);
    float v[4];
    { uint2 t = *(const uint2*)(U_ + (size_t)rc * NU + C_XBC + c); if (r != rc) { t.x = 0u; t.y = 0u; } unpack4(t, v); }
#pragma unroll
    for (int o = 0; o < 16; o++) {
      if (ii - o >= 0 && ii - o <= 4) {
        a[o].x += w[ii - o].x * v[0]; a[o].y += w[ii - o].y * v[1]; a[o].z += w[ii - o].z * v[2]; a[o].w += w[ii - o].w * v[3];
      }
    }
  }
#pragma unroll
  for (int o = 0; o < 16; o++)
    *(uint2*)(WS_B(O_XBC) + (size_t)(t0 + o) * 1024 + c) = pack4(silu_f(a[o].x), silu_f(a[o].y), silu_f(a[o].z), silu_f(a[o].w));
}
DEV void mla_pre_item(const Prm& p, int it) {
  const int lane = otid() & 63, wid = otid() >> 6;
  const bfr* U_ = WS_B(O_U);
  const float2* mcs = (const float2*)(p.ws + O_MCS);
#pragma unroll 4
  for (int rr = 0; rr < 16; rr++) {
    int r = it * 64 + wid * 16 + rr;
    const bfr* ur = U_ + (size_t)r * NU;
    float sq = 0.f, sk = 0.f;
#pragma unroll
    for (int i = 0; i < 3; i++) { unsigned t = *(const unsigned*)(ur + C_CQ + lane * 2 + 128 * i); float x = lo16(t), y = hi16(t); sq += x * x + y * y; }
    { uint2 t = *(const uint2*)(ur + C_CKV + lane * 4); float f[4]; unpack4(t, f); sk = f[0] * f[0] + f[1] * f[1] + f[2] * f[2] + f[3] * f[3]; }
    sq = wave_sum(sq); sk = wave_sum(sk);
    if (lane == 0) { WS_F(O_RSQ)[r] = rsqrtf(sq * (1.f / 384.f) + EPS); WS_F(O_RSKV)[r] = rsqrtf(sk * (1.f / 256.f) + EPS); }
    if (lane < 16) {
      float x1 = bf2f(ur[C_KR + lane]), x2 = bf2f(ur[C_KR + 16 + lane]);
      float o1 = x1, o2 = x2;
      if (r >= CTX) {
        int t = r - CTX, pos = lane < 8 ? (t >> 6) : (t & 63);
        float2 cs = mcs[pos * 8 + (lane & 7)];
        o1 = x1 * cs.x - x2 * cs.y; o2 = x1 * cs.y + x2 * cs.x;
      }
      WS_B(O_KROPE)[(size_t)r * 32 + lane] = f2bf(o1);
      WS_B(O_KROPE)[(size_t)r * 32 + 16 + lane] = f2bf(o2);
    }
  }
}
DEV void ph_local(const Prm& p, int L, char* smem) {
  constexpr int NG = ROWS / 16;
  for (int it = VBX; it < 2 * NG + 260; it += VGX) {
#ifdef ONLY2
    it = ONLY2 == 0 ? 0 : ONLY2 == 1 ? NG : 2 * NG;
#endif
    if (it < NG) conv_module_item(p, L, it, smem);
    else if (it < 2 * NG) xbc_conv_item(p, L, it - NG);
    else mla_pre_item(p, it - 2 * NG);
  }
}

DEV void uq_tile(const Prm& p, int it, char* smem) {
  TILE_IDS
  int mt = it / 6, nt = it % 6, m0 = mt * 128, n0 = nt * 128;
  f32x4 acc[4][4]; zero_acc44(acc);
  gemm4_single(WS_B(O_U) + (size_t)m0 * NU + C_CQ, NU, WS_B(O_WTUQ) + (size_t)n0 * 384, 384, 384, acc, smem);
#pragma unroll
  for (int mi = 0; mi < 4; mi++) {
    int row = m0 + wm * 64 + mi * 16 + l15;
    float rs = WS_F(O_RSQ)[row];
#pragma unroll
    for (int ni = 0; ni < 4; ni++) {
      int col = n0 + wn * 64 + ni * 16 + quad * 4;
      *(uint2*)(WS_B(O_Q) + (size_t)row * 768 + col) = pack4(rs * acc[mi][ni][0], rs * acc[mi][ni][1], rs * acc[mi][ni][2], rs * acc[mi][ni][3]);
    }
  }
}
DEV void ukn_tile(const Prm& p, int it, char* smem) {
  TILE_IDS
  int mt = it / 4, nt = it % 4, m0 = mt * 128, n0 = nt * 128;
  f32x4 acc[4][4]; zero_acc44(acc);
  gemm4_single(WS_B(O_U) + (size_t)m0 * NU + C_CKV, NU, WS_B(O_WTUKV) + (size_t)n0 * 256, 256, 256, acc, smem);
#pragma unroll
  for (int mi = 0; mi < 4; mi++) {
    int row = m0 + wm * 64 + mi * 16 + l15;
    float rs = WS_F(O_RSKV)[row];
#pragma unroll
    for (int ni = 0; ni < 4; ni++) {
      int col = n0 + wn * 64 + ni * 16 + quad * 4;
      *(uint2*)(WS_B(O_KN) + (size_t)row * 512 + col) = pack4(rs * acc[mi][ni][0], rs * acc[mi][ni][1], rs * acc[mi][ni][2], rs * acc[mi][ni][3]);
    }
  }
}
DEV void uvt_tile(const Prm& p, int it, char* smem) {
  TILE_IDS
  int vt = it / NCH, tt = it % NCH, m0 = vt * 128, n0 = tt * 128;
  f32x4 acc[4][4]; zero_acc44(acc);
  gemm4_single(WS_B(O_WTUKV) + (size_t)(512 + m0) * 256, 256, WS_B(O_U) + (size_t)n0 * NU + C_CKV, NU, 256, acc, smem);
#pragma unroll
  for (int ni = 0; ni < 4; ni++) {
    int tok = n0 + wn * 64 + ni * 16 + quad * 4;
    float4 rs = *(const float4*)(WS_F(O_RSKV) + tok);
#pragma unroll
    for (int mi = 0; mi < 4; mi++) {
      int vrow = m0 + wm * 64 + mi * 16 + l15;
      *(uint2*)(WS_B(O_VT) + (size_t)vrow * ROWS + tok) = pack4(rs.x * acc[mi][ni][0], rs.y * acc[mi][ni][1], rs.z * acc[mi][ni][2], rs.w * acc[mi][ni][3]);
    }
  }
}

DEV void chunk_decay(const Prm& p, int L, float raw, int h, float* sCum, float* sDt, float* sTmp) {
  const int tid = otid(), dir = tid >> 7, i = tid & 127, l = dir ? 127 - i : i;
  float dt = softplus_f(raw + p.in[I_DTB][L * 16 + dir * 8 + h]);
  float v = -dt * expf(p.in[I_ALOG][L * 16 + dir * 8 + h]);
#pragma unroll
  for (int o = 1; o < 64; o <<= 1) { float t = __shfl_up(v, o); if ((tid & 63) >= o) v += t; }
  if ((tid & 63) == 63) sTmp[tid >> 6] = v;
  __syncthreads();
  if (tid & 64) v += sTmp[(tid >> 6) - 1];
  sCum[dir * 128 + l] = v; sDt[dir * 128 + l] = dt;
  __syncthreads();
}

DEV void ssm_state_item(const Prm& p, int L, int it, char* smem) {
  TILE_IDS
  bfr* sBT = (bfr*)smem;
  bfr* sXT = sBT + 128 * 136;
  float* sCum = (float*)(smem + 52224); float* sDt = sCum + 256; float* sTmp = sDt + 256;
  const int c = it >> 2, g = (it >> 1) & 1, hp = it & 1, r0 = c * 128;
  const bfr* X_ = WS_B(O_XBC);
  unsigned rawp;
  { const int dir_ = tid >> 7, i_ = tid & 127, l_ = dir_ ? 127 - i_ : i_;
    rawp = *(const unsigned*)(WS_B(O_U) + (size_t)(r0 + l_) * NU + C_DT + dir_ * 8 + g * 4 + hp * 2); }
  __syncthreads();
#pragma unroll 4
  for (int u = tid; u < 1024; u += 256) {
    int lp = u & 63, nc = u >> 6;
    const bfr* src = X_ + (size_t)(r0 + 2 * lp) * 1024 + 512 + g * 128 + nc * 8;
    uint4 a = *(const uint4*)src, b2 = *(const uint4*)(src + 1024);
#pragma unroll
    for (int e = 0; e < 8; e++) *(unsigned*)(sBT + (nc * 8 + e) * 136 + 2 * lp) = elem16(a, e) | (elem16(b2, e) << 16);
  }
  for (int hh = 0; hh < 2; hh++) {
    const int h = g * 4 + hp * 2 + hh;
    uint4 xs0, xs1, xs2, xs3;
    { const bfr* s0_ = X_ + (size_t)(r0 + 2 * (tid & 63)) * 1024 + h * 64 + (tid >> 6) * 8;
      xs0 = *(const uint4*)s0_; xs1 = *(const uint4*)(s0_ + 1024); xs2 = *(const uint4*)(s0_ + 32); xs3 = *(const uint4*)(s0_ + 1024 + 32); }
    chunk_decay(p, L, hh ? hi16(rawp) : lo16(rawp), h, sCum, sDt, sTmp);
    const float totf = sCum[127], totb = sCum[128];
    if (tid == 0) { WS_F(O_TOT)[(0 * NCH + c) * 8 + h] = __expf(totf); WS_F(O_TOT)[(1 * NCH + c) * 8 + h] = __expf(totb); }
    for (int dir = 0; dir < 2; dir++) {
      const float tot = dir ? totb : totf;
      {
        const int lp = tid & 63, pc = tid >> 6, l0 = 2 * lp;
        float w0 = __expf(tot - sCum[dir * 128 + l0]) * sDt[dir * 128 + l0];
        float w1 = __expf(tot - sCum[dir * 128 + l0 + 1]) * sDt[dir * 128 + l0 + 1];
        float fa[8], fb[8], fc[8], fd[8]; unpack8(xs0, fa); unpack8(xs1, fb); unpack8(xs2, fc); unpack8(xs3, fd);
#pragma unroll
        for (int e = 0; e < 8; e++) {
          *(unsigned*)(sXT + (pc * 8 + e) * 136 + l0) = pack2(fa[e] * w0, fb[e] * w1);
          *(unsigned*)(sXT + ((pc + 4) * 8 + e) * 136 + l0) = pack2(fc[e] * w0, fd[e] * w1);
        }
      }
      __syncthreads();
      f32x4 acc[4][2];
#pragma unroll
      for (int i = 0; i < 4; i++) { acc[i][0] = f32x4{0, 0, 0, 0}; acc[i][1] = f32x4{0, 0, 0, 0}; }
      lds_gemm<4, 2, 4>(sXT, 136, sBT + (wid * 32) * 136, 136, acc);
      float* dst = WS_F(O_SST) + ((size_t)((dir * NCH + c) * 8 + h)) * 8192;
#pragma unroll
      for (int mi = 0; mi < 4; mi++)
#pragma unroll
        for (int ni = 0; ni < 2; ni++) *(f32x4*)(dst + (mi * 16 + l15) * 128 + wid * 32 + ni * 16 + quad * 4) = acc[mi][ni];
      __syncthreads();
    }
  }
}

DEV void ret_rope8(const Prm& p, int r, int nc, const uint4& c1, const uint4& c2, float scale, float (&o1)[8], float (&o2)[8]) {
  float x1[8], x2[8]; unpack8(c1, x1); unpack8(c2, x2);
  if (r >= CTX) {
    const float2* rcs = (const float2*)(p.ws + O_RCS);
    int t = r - CTX, pos = nc < 2 ? (t >> 6) : (t & 63);
    const float2* cs = rcs + pos * 16 + (nc & 1) * 8;
#pragma unroll
    for (int e = 0; e < 8; e++) { float2 v = cs[e]; o1[e] = (x1[e] * v.x - x2[e] * v.y) * scale; o2[e] = (x1[e] * v.y + x2[e] * v.x) * scale; }
  } else {
#pragma unroll
    for (int e = 0; e < 8; e++) { o1[e] = x1[e] * scale; o2[e] = x2[e] * scale; }
  }
}

DEV void ret_state_item(const Prm& p, int L, int it, char* smem) {
  TILE_IDS
  bfr* sVT = (bfr*)smem;
  bfr* sKT = sVT + 128 * 136;
  const int c = it >> 2, h = it & 3, r0 = c * 128;
  const bfr* U_ = WS_B(O_U);
  const float lgf = -expf(p.in[I_RDEC][L * 8 + h]), lgb = -expf(p.in[I_RDEC][L * 8 + 4 + h]);
  __syncthreads();
#pragma unroll 4
  for (int u = tid; u < 1024; u += 256) {
    int lp = u & 63, pc = u >> 6;
    const bfr* src = U_ + (size_t)(r0 + 2 * lp) * NU + C_RV + h * 128 + pc * 8;
    uint4 a = *(const uint4*)src, b2 = *(const uint4*)(src + NU);
#pragma unroll
    for (int e = 0; e < 8; e++) *(unsigned*)(sVT + (pc * 8 + e) * 136 + 2 * lp) = elem16(a, e) | (elem16(b2, e) << 16);
  }
  uint4 a1, a2, b1, b2;
  { const bfr* src = U_ + (size_t)(r0 + 2 * (tid & 63)) * NU + C_RK + h * 64 + (tid >> 6) * 8;
    a1 = *(const uint4*)src; a2 = *(const uint4*)(src + 32); b1 = *(const uint4*)(src + NU); b2 = *(const uint4*)(src + NU + 32); }
  for (int dir = 0; dir < 2; dir++) {
    {
      int lp = tid & 63, nc = tid >> 6, l0 = 2 * lp;
      float w0 = dir ? __expf((float)l0 * lgb) : __expf((float)(127 - l0) * lgf);
      float w1 = dir ? __expf((float)(l0 + 1) * lgb) : __expf((float)(126 - l0) * lgf);
      float p1[8], p2[8], q1[8], q2[8];
      ret_rope8(p, r0 + l0, nc, a1, a2, 0.125f * w0, p1, p2);
      ret_rope8(p, r0 + l0 + 1, nc, b1, b2, 0.125f * w1, q1, q2);
#pragma unroll
      for (int e = 0; e < 8; e++) {
        *(unsigned*)(sKT + (nc * 8 + e) * 136 + l0) = pack2(p1[e], q1[e]);
        *(unsigned*)(sKT + (32 + nc * 8 + e) * 136 + l0) = pack2(p2[e], q2[e]);
      }
    }
    __syncthreads();
    f32x4 acc[2][4];
#pragma unroll
    for (int i = 0; i < 2; i++)
#pragma unroll
      for (int j = 0; j < 4; j++) acc[i][j] = f32x4{0, 0, 0, 0};
    lds_gemm<2, 4, 4>(sVT + (wid * 32) * 136, 136, sKT, 136, acc);
    float* dst = WS_F(O_RST) + ((size_t)((dir * NCH + c) * 4 + h)) * 8192;
#pragma unroll
    for (int mi = 0; mi < 2; mi++)
#pragma unroll
      for (int ni = 0; ni < 4; ni++) *(f32x4*)(dst + (wid * 32 + mi * 16 + l15) * 64 + ni * 16 + quad * 4) = acc[mi][ni];
    __syncthreads();
  }
}
DEV void ph_states(const Prm& p, int L, char* smem) {
  constexpr int N0 = NCH * 6, N1 = N0 + NCH * 8, N2 = N1 + NCH * 4, N3 = N2 + NCH * 4;
  for (int it = VBX; it < N3; it += VGX) {
#ifdef ONLY3
    it = ONLY3 == 0 ? 0 : ONLY3 == 1 ? N0 : ONLY3 == 2 ? N1 : N2;
#endif
    if (it < N0) uq_tile(p, it, smem);
    else if (it < N1) { if (it - N0 < NCH * 4) ukn_tile(p, it - N0, smem); else uvt_tile(p, it - N0 - NCH * 4, smem); }
    else if (it < N2) ssm_state_item(p, L, it - N1, smem);
    else ret_state_item(p, L, it - N2, smem);
  }
}

DEV int chunk_order(int dir, int i) { return dir == 0 ? i : (i < 2 ? 1 - i : 131 - i); }
DEV void ph_scan(const Prm& p, int L) {
  for (int it = VBX; it < 384; it += VGX) {
    if (it < 256) {
      int gid = it * 256 + otid(), dir = gid >> 15, h = (gid >> 12) & 7, e2 = gid & 4095;
      float2 hr = {0, 0};
      for (int i0 = 0; i0 < NCH; i0 += 13) {
        float2 s[13]; float g[13];
#pragma unroll
        for (int j = 0; j < 13; j++) {
          int c = chunk_order(dir, i0 + j);
          s[j] = *(const float2*)(WS_F(O_SST) + ((size_t)((dir * NCH + c) * 8 + h)) * 8192 + e2 * 2);
          g[j] = WS_F(O_TOT)[(dir * NCH + c) * 8 + h];
        }
#pragma unroll
        for (int j = 0; j < 13; j++) {
          int c = chunk_order(dir, i0 + j);
          *(float2*)(WS_F(O_SST) + ((size_t)((dir * NCH + c) * 8 + h)) * 8192 + e2 * 2) = hr;
          hr.x = g[j] * hr.x + s[j].x; hr.y = g[j] * hr.y + s[j].y;
        }
      }
    } else {
      int gid = (it - 256) * 256 + otid(), dir = gid >> 14, h = (gid >> 12) & 3, e2 = gid & 4095;
      const float G = expf(-128.f * expf(p.in[I_RDEC][L * 8 + dir * 4 + h]));
      float2 hr = {0, 0};
      for (int i0 = 0; i0 < NCH; i0 += 13) {
        float2 s[13];
#pragma unroll
        for (int j = 0; j < 13; j++) {
          int c = chunk_order(dir, i0 + j);
          s[j] = *(const float2*)(WS_F(O_RST) + ((size_t)((dir * NCH + c) * 4 + h)) * 8192 + e2 * 2);
        }
#pragma unroll
        for (int j = 0; j < 13; j++) {
          int c = chunk_order(dir, i0 + j);
          *(float2*)(WS_F(O_RST) + ((size_t)((dir * NCH + c) * 4 + h)) * 8192 + e2 * 2) = hr;
          hr.x = G * hr.x + s[j].x; hr.y = G * hr.y + s[j].y;
        }
      }
    }
  }
}

DEV void ssm_out_item(const Prm& p, int L, int it, char* smem) {
  TILE_IDS
  bfr* sC = (bfr*)smem;
  bfr* sB = sC + 64 * 136;
  bfr* sP = sB; bfr* sX = sB + 64 * 136;
  float* sCum = (float*)(smem + 52224); float* sDt = sCum + 256; float* sSS = sDt + 256; float* sTmp = sSS + 64;
  const int c = it >> 2, g = (it >> 1) & 1, lh = it & 1, r0 = c * 128, rq0 = r0 + lh * 64;
  const bfr* X_ = WS_B(O_XBC);
  const bfr* U_ = WS_B(O_U);
  uint2 rawq;
  { const int dir_ = tid >> 7, i_ = tid & 127, l_ = dir_ ? 127 - i_ : i_;
    rawq = *(const uint2*)(U_ + (size_t)(r0 + l_) * NU + C_DT + dir_ * 8 + g * 4); }
  uint4 xr0, xr1, xr2, xr3;
#define SSM_XLOAD(h_) do { \
    const bfr* s0_ = X_ + (size_t)(r0 + 2 * (tid & 63)) * 1024 + (h_) * 64 + (tid >> 6) * 8; \
    xr0 = *(const uint4*)s0_; xr1 = *(const uint4*)(s0_ + 1024); xr2 = *(const uint4*)(s0_ + 32); xr3 = *(const uint4*)(s0_ + 1024 + 32); } while (0)
  SSM_XLOAD(g * 4);
  __syncthreads();
#pragma unroll 4
  for (int u = tid; u < 1024; u += 256) {
    int row = u >> 4, ch = u & 15;
    *(uint4*)(sC + row * 136 + ch * 8) = *(const uint4*)(X_ + (size_t)(rq0 + row) * 1024 + 768 + g * 128 + ch * 8);
  }
#pragma unroll 4
  for (int u = tid; u < 2048; u += 256) {
    int row = u >> 4, ch = u & 15;
    *(uint4*)(sB + row * 136 + ch * 8) = *(const uint4*)(X_ + (size_t)(r0 + row) * 1024 + 512 + g * 128 + ch * 8);
  }
  if (tid < 64) sSS[tid] = 0.f;
  __syncthreads();
  f32x4 cb[2][4];
#pragma unroll
  for (int i = 0; i < 2; i++)
#pragma unroll
    for (int j = 0; j < 4; j++) cb[i][j] = f32x4{0, 0, 0, 0};
  lds_gemm<2, 4, 4>(sC + (wm * 32) * 136, 136, sB + (wn * 64) * 136, 136, cb);
#pragma unroll 1
  for (int hh = 0; hh < 4; hh++) {
    f32x4 y[2][2];
    const int h = g * 4 + hh;
    __syncthreads();
    chunk_decay(p, L, hh == 0 ? lo16(rawq.x) : hh == 1 ? hi16(rawq.x) : hh == 2 ? lo16(rawq.y) : hi16(rawq.y), h, sCum, sDt, sTmp);
#pragma unroll
    for (int mi = 0; mi < 2; mi++) {
      const int rl = wm * 32 + mi * 16 + l15, ll = lh * 64 + rl;
      const float cfl = sCum[ll], cbl = sCum[128 + ll];
#pragma unroll
      for (int ni = 0; ni < 4; ni++) {
        const int s0 = wn * 64 + ni * 16 + quad * 4;
        float pv[4];
#pragma unroll
        for (int r = 0; r < 4; r++) {
          int s = s0 + r;
          float ef = (s <= ll) ? __expf(cfl - sCum[s]) * sDt[s] : 0.f;
          float eb = (s >= ll) ? __expf(cbl - sCum[128 + s]) * sDt[128 + s] : 0.f;
          pv[r] = cb[mi][ni][r] * (ef + eb);
        }
        *(uint2*)(sP + rl * 136 + s0) = pack4(pv[0], pv[1], pv[2], pv[3]);
      }
    }
    {
      const int lp = tid & 63, pc = tid >> 6;
#pragma unroll
      for (int e = 0; e < 8; e++) {
        *(unsigned*)(sX + (pc * 8 + e) * 136 + 2 * lp) = elem16(xr0, e) | (elem16(xr1, e) << 16);
        *(unsigned*)(sX + ((pc + 4) * 8 + e) * 136 + 2 * lp) = elem16(xr2, e) | (elem16(xr3, e) << 16);
      }
      if (hh < 3) SSM_XLOAD(h + 1);
    }
    __syncthreads();
#pragma unroll
    for (int i = 0; i < 2; i++) { y[i][0] = f32x4{0, 0, 0, 0}; y[i][1] = f32x4{0, 0, 0, 0}; }
    float4 hreg[8];
    {
      const float* hsrc = WS_F(O_SST) + ((size_t)((0 * NCH + c) * 8 + h)) * 8192;
#pragma unroll
      for (int k = 0; k < 8; k++) { int u = tid + 256 * k; hreg[k] = *(const float4*)(hsrc + (u >> 5) * 128 + (u & 31) * 4); }
    }
    lds_gemm<2, 2, 4>(sP + (wm * 32) * 136, 136, sX + (wn * 32) * 136, 136, y);
#pragma unroll
    for (int dir = 0; dir < 2; dir++) {
      __syncthreads();
#pragma unroll
      for (int k = 0; k < 8; k++) { int u = tid + 256 * k; *(uint2*)(sX + (u >> 5) * 136 + (u & 31) * 4) = pack4(hreg[k].x, hreg[k].y, hreg[k].z, hreg[k].w); }
      if (dir == 0) {
        const float* hsrc = WS_F(O_SST) + ((size_t)((1 * NCH + c) * 8 + h)) * 8192;
#pragma unroll
        for (int k = 0; k < 8; k++) { int u = tid + 256 * k; hreg[k] = *(const float4*)(hsrc + (u >> 5) * 128 + (u & 31) * 4); }
      }
      __syncthreads();
      f32x4 t[2][2];
#pragma unroll
      for (int i = 0; i < 2; i++) { t[i][0] = f32x4{0, 0, 0, 0}; t[i][1] = f32x4{0, 0, 0, 0}; }
      lds_gemm<2, 2, 4>(sC + (wm * 32) * 136, 136, sX + (wn * 32) * 136, 136, t);
#pragma unroll
      for (int mi = 0; mi < 2; mi++) {
        float e = __expf(sCum[dir * 128 + lh * 64 + wm * 32 + mi * 16 + l15]);
#pragma unroll
        for (int ni = 0; ni < 2; ni++)
#pragma unroll
          for (int r = 0; r < 4; r++) y[mi][ni][r] += e * t[mi][ni][r];
      }
    }
    const float Dh = p.in[I_SSMD][L * 8 + h];
#pragma unroll
    for (int mi = 0; mi < 2; mi++) {
      const int rl = wm * 32 + mi * 16 + l15, row = rq0 + rl;
      float part = 0.f;
#pragma unroll
      for (int ni = 0; ni < 2; ni++) {
        int p0 = wn * 32 + ni * 16 + quad * 4;
        float xf[4], zf[4];
        unpack4(*(const uint2*)(X_ + (size_t)row * 1024 + h * 64 + p0), xf);
        unpack4(*(const uint2*)(U_ + (size_t)row * NU + C_Z + h * 64 + p0), zf);
#pragma unroll
        for (int r = 0; r < 4; r++) {
          float v = (y[mi][ni][r] + Dh * xf[r]) * silu_f(zf[r]);
          y[mi][ni][r] = v; part += v * v;
        }
      }
      part += __shfl_xor(part, 16); part += __shfl_xor(part, 32);
      if (quad == 0) atomicAdd(&sSS[rl], part);
#pragma unroll
      for (int ni = 0; ni < 2; ni++) {
        int ch = hh * 64 + wn * 32 + ni * 16 + quad * 4;
        *(uint2*)(WS_B(O_BR) + (size_t)row * 2048 + 512 + g * 256 + ch) = pack4(y[mi][ni][0], y[mi][ni][1], y[mi][ni][2], y[mi][ni][3]);
      }
    }
  }
  __syncthreads();
  const float* ng = p.in[I_SNG] + L * 512 + g * 256;
#pragma unroll
  for (int mi = 0; mi < 2; mi++) {
    const int rl = wm * 32 + mi * 16 + l15, row = rq0 + rl;
    const float rstd = rsqrtf(sSS[rl] * (1.f / 256.f) + EPS);
#pragma unroll
    for (int hh = 0; hh < 4; hh++)
#pragma unroll
      for (int ni = 0; ni < 2; ni++) {
        int ch = hh * 64 + wn * 32 + ni * 16 + quad * 4;
        float4 gg = *(const float4*)(ng + ch);
        bfr* dst = WS_B(O_BR) + (size_t)row * 2048 + 512 + g * 256 + ch;
        float v[4]; unpack4(*(const uint2*)dst, v);
        *(uint2*)dst = pack4(v[0] * rstd * gg.x, v[1] * rstd * gg.y, v[2] * rstd * gg.z, v[3] * rstd * gg.w);
      }
  }
}

#undef SSM_XLOAD
DEV void ret_out_item(const Prm& p, int L, int it, char* smem) {
  TILE_IDS
  bfr* sQ = (bfr*)smem;
  bfr* sK = sQ + 64 * 72;
  bfr* sP = sK;
  bfr* sV = (bfr*)(smem + 27648);
  bfr* sH = sV;
  float* sSum = (float*)(smem + 62464); float* sSq = sSum + 64;
  const int c = it >> 3, h = (it >> 1) & 3, lh = it & 1, r0 = c * 128, rq0 = r0 + lh * 64;
  const bfr* U_ = WS_B(O_U);
  const float lgf = -expf(p.in[I_RDEC][L * 8 + h]), lgb = -expf(p.in[I_RDEC][L * 8 + 4 + h]);
  __syncthreads();
  {
    int row = tid >> 2, nc = tid & 3, r = rq0 + row;
    const bfr* src = U_ + (size_t)r * NU + C_RQ + h * 64 + nc * 8;
    float o1[8], o2[8];
    ret_rope8(p, r, nc, *(const uint4*)src, *(const uint4*)(src + 32), 1.f, o1, o2);
    *(uint4*)(sQ + row * 72 + nc * 8) = pack8(o1); *(uint4*)(sQ + row * 72 + 32 + nc * 8) = pack8(o2);
  }
  for (int u = tid; u < 512; u += 256) {
    int row = u >> 2, nc = u & 3, r = r0 + row;
    const bfr* src = U_ + (size_t)r * NU + C_RK + h * 64 + nc * 8;
    float o1[8], o2[8];
    ret_rope8(p, r, nc, *(const uint4*)src, *(const uint4*)(src + 32), 0.125f, o1, o2);
    *(uint4*)(sK + row * 72 + nc * 8) = pack8(o1); *(uint4*)(sK + row * 72 + 32 + nc * 8) = pack8(o2);
  }
#pragma unroll 4
  for (int u = tid; u < 1024; u += 256) {
    int lp = u & 63, pc = u >> 6;
    const bfr* src = U_ + (size_t)(r0 + 2 * lp) * NU + C_RV + h * 128 + pc * 8;
    uint4 a = *(const uint4*)src, b2 = *(const uint4*)(src + NU);
#pragma unroll
    for (int e = 0; e < 8; e++) *(unsigned*)(sV + (pc * 8 + e) * 136 + 2 * lp) = elem16(a, e) | (elem16(b2, e) << 16);
  }
  if (tid < 128) sSum[tid] = 0.f;
  __syncthreads();
  f32x4 qk[2][4];
#pragma unroll
  for (int i = 0; i < 2; i++)
#pragma unroll
    for (int j = 0; j < 4; j++) qk[i][j] = f32x4{0, 0, 0, 0};
  lds_gemm<2, 4, 2>(sQ + (wm * 32) * 72, 72, sK + (wn * 64) * 72, 72, qk);
  __syncthreads();
#pragma unroll
  for (int mi = 0; mi < 2; mi++) {
    const int rl = wm * 32 + mi * 16 + l15, ll = lh * 64 + rl;
#pragma unroll
    for (int ni = 0; ni < 4; ni++) {
      const int s0 = wn * 64 + ni * 16 + quad * 4;
      float pv[4];
#pragma unroll
      for (int r = 0; r < 4; r++) {
        int d = ll - (s0 + r);
        float wgt = (d >= 0 ? __expf((float)d * lgf) : 0.f) + (d <= 0 ? __expf((float)(-d) * lgb) : 0.f);
        pv[r] = qk[mi][ni][r] * wgt;
      }
      *(uint2*)(sP + rl * 136 + s0) = pack4(pv[0], pv[1], pv[2], pv[3]);
    }
  }
  __syncthreads();
  f32x4 y[2][4];
#pragma unroll
  for (int i = 0; i < 2; i++)
#pragma unroll
    for (int j = 0; j < 4; j++) y[i][j] = f32x4{0, 0, 0, 0};
  float4 hreg[8];
  {
    const float* hsrc = WS_F(O_RST) + ((size_t)((0 * NCH + c) * 4 + h)) * 8192;
#pragma unroll
    for (int k = 0; k < 8; k++) { int u = tid + 256 * k; hreg[k] = *(const float4*)(hsrc + (u >> 4) * 64 + (u & 15) * 4); }
  }
  lds_gemm<2, 4, 4>(sP + (wm * 32) * 136, 136, sV + (wn * 64) * 136, 136, y);
#pragma unroll
  for (int dir = 0; dir < 2; dir++) {
    __syncthreads();
#pragma unroll
    for (int k = 0; k < 8; k++) { int u = tid + 256 * k; *(uint2*)(sH + (u >> 4) * 72 + (u & 15) * 4) = pack4(hreg[k].x, hreg[k].y, hreg[k].z, hreg[k].w); }
    if (dir == 0) {
      const float* hsrc = WS_F(O_RST) + ((size_t)((1 * NCH + c) * 4 + h)) * 8192;
#pragma unroll
      for (int k = 0; k < 8; k++) { int u = tid + 256 * k; hreg[k] = *(const float4*)(hsrc + (u >> 4) * 64 + (u & 15) * 4); }
    }
    __syncthreads();
    f32x4 t[2][4];
#pragma unroll
    for (int i = 0; i < 2; i++)
#pragma unroll
      for (int j = 0; j < 4; j++) t[i][j] = f32x4{0, 0, 0, 0};
    lds_gemm<2, 4, 2>(sQ + (wm * 32) * 72, 72, sH + (wn * 64) * 72, 72, t);
#pragma unroll
    for (int mi = 0; mi < 2; mi++) {
      const int ll = lh * 64 + wm * 32 + mi * 16 + l15;
      float e = dir == 0 ? __expf((float)(ll + 1) * lgf) : __expf((float)(128 - ll) * lgb);
#pragma unroll
      for (int ni = 0; ni < 4; ni++)
#pragma unroll
        for (int r = 0; r < 4; r++) y[mi][ni][r] += e * t[mi][ni][r];
    }
  }
#pragma unroll
  for (int mi = 0; mi < 2; mi++) {
    const int rl = wm * 32 + mi * 16 + l15;
    float s1 = 0.f, s2 = 0.f;
#pragma unroll
    for (int ni = 0; ni < 4; ni++)
#pragma unroll
      for (int r = 0; r < 4; r++) { float v = y[mi][ni][r]; s1 += v; s2 += v * v; }
    s1 += __shfl_xor(s1, 16); s1 += __shfl_xor(s1, 32);
    s2 += __shfl_xor(s2, 16); s2 += __shfl_xor(s2, 32);
    if (quad == 0) { atomicAdd(&sSum[rl], s1); atomicAdd(&sSq[rl], s2); }
  }
  __syncthreads();
  const float* gg = p.in[I_RGNG] + L * 512 + h * 128;
  const float* gb = p.in[I_RGNB] + L * 512 + h * 128;
#pragma unroll
  for (int mi = 0; mi < 2; mi++) {
    const int rl = wm * 32 + mi * 16 + l15, row = rq0 + rl;
    const float mu = sSum[rl] * (1.f / 128.f);
    const float var = fmaxf(sSq[rl] * (1.f / 128.f) - mu * mu, 0.f);
    const float rstd = rsqrtf(var + EPS);
#pragma unroll
    for (int ni = 0; ni < 4; ni++) {
      int p0 = wn * 64 + ni * 16 + quad * 4;
      float gf[4]; unpack4(*(const uint2*)(U_ + (size_t)row * NU + C_RG + h * 128 + p0), gf);
      float4 g4 = *(const float4*)(gg + p0), b4 = *(const float4*)(gb + p0);
      float o0 = silu_f(gf[0]) * ((y[mi][ni][0] - mu) * rstd * g4.x + b4.x);
      float o1 = silu_f(gf[1]) * ((y[mi][ni][1] - mu) * rstd * g4.y + b4.y);
      float o2 = silu_f(gf[2]) * ((y[mi][ni][2] - mu) * rstd * g4.z + b4.z);
      float o3 = silu_f(gf[3]) * ((y[mi][ni][3] - mu) * rstd * g4.w + b4.w);
      *(uint2*)(WS_B(O_BR) + (size_t)row * 2048 + 1024 + h * 128 + p0) = pack4(o0, o1, o2, o3);
    }
  }
}

typedef __attribute__((ext_vector_type(16))) float f32x16;
DEV unsigned cvtpk(float lo, float hi) { unsigned r; asm("v_cvt_pk_bf16_f32 %0, %1, %2" : "=v"(r) : "v"(lo), "v"(hi)); return r; }
DEV void attn_item(const Prm& p, int q0, int head, int nkeys, char* smem) {
  const int tid = rtid(), lane = tid & 63, wid = tid >> 6, l31 = lane & 31, hi = lane >> 5;
  constexpr int LDK = 104, LDV = 72;
  bfr* sK0 = (bfr*)smem;
  bfr* sV0 = sK0 + 2 * 64 * LDK;
  const bfr* KN = WS_B(O_KN);
  const bfr* KR = WS_B(O_KROPE);
  const bfr* VT = WS_B(O_VT);
  const float qs = 0.10206207261596577f * 1.4426950408889634f;
  const float THR2 = 11.5f;
  bf16x8 qf[6];
  const int row = q0 + wid * 32 + l31;
  {
    const bfr* qp = WS_B(O_Q) + (size_t)row * 768 + head * 96;
#pragma unroll
    for (int ks = 0; ks < 4; ks++) {
      float f[8]; unpack8(*(const uint4*)(qp + ks * 16 + hi * 8), f);
      uint4 t = {cvtpk(f[0] * qs, f[1] * qs), cvtpk(f[2] * qs, f[3] * qs), cvtpk(f[4] * qs, f[5] * qs), cvtpk(f[6] * qs, f[7] * qs)};
      qf[ks] = *(bf16x8*)&t;
    }
    float x1[8], x2[8], o1[8], o2[8];
    unpack8(*(const uint4*)(qp + 64 + hi * 8), x1);
    unpack8(*(const uint4*)(qp + 80 + hi * 8), x2);
    if (row >= CTX) {
      const float2* mcs = (const float2*)(p.ws + O_MCS);
      int t = row - CTX, pos = hi ? (t & 63) : (t >> 6);
#pragma unroll
      for (int e = 0; e < 8; e++) {
        float2 cs = mcs[pos * 8 + e];
        o1[e] = (x1[e] * cs.x - x2[e] * cs.y) * qs; o2[e] = (x1[e] * cs.y + x2[e] * cs.x) * qs;
      }
    } else {
#pragma unroll
      for (int e = 0; e < 8; e++) { o1[e] = x1[e] * qs; o2[e] = x2[e] * qs; }
    }
    uint4 t1 = {cvtpk(o1[0], o1[1]), cvtpk(o1[2], o1[3]), cvtpk(o1[4], o1[5]), cvtpk(o1[6], o1[7])};
    uint4 t2 = {cvtpk(o2[0], o2[1]), cvtpk(o2[2], o2[3]), cvtpk(o2[4], o2[5]), cvtpk(o2[6], o2[7])};
    qf[4] = *(bf16x8*)&t1; qf[5] = *(bf16x8*)&t2;
  }
  f32x16 O0, O1;
#pragma unroll
  for (int r = 0; r < 16; r++) { O0[r] = 0.f; O1[r] = 0.f; }
  float mrun = -1e30f, lrun = 0.f;
  uint4 ek0, ek1, ev0, ok0, ok1, ov0;
  const int nt = nkeys >> 6;
  const bool k2 = tid < 256;
  const int ku0 = tid, ku1 = tid + 512;
  const int kk0 = ku0 / 12, kc0 = ku0 - kk0 * 12, kk1 = ku1 / 12, kc1 = ku1 - kk1 * 12;
  const bfr* ks0 = kc0 < 8 ? KN + (size_t)kk0 * 512 + head * 64 + kc0 * 8 : KR + (size_t)kk0 * 32 + (kc0 - 8) * 8;
  const bfr* ks1 = kc1 < 8 ? KN + (size_t)kk1 * 512 + head * 64 + kc1 * 8 : KR + (size_t)kk1 * 32 + (kc1 - 8) * 8;
  const int kst0 = kc0 < 8 ? 512 * 64 : 32 * 64, kst1 = kc1 < 8 ? 512 * 64 : 32 * 64;
  const int vd0 = tid >> 3, vc0 = tid & 7;
  const bfr* vs0 = VT + (size_t)(head * 64 + vd0) * ROWS + vc0 * 8;
  const int kw0 = kk0 * LDK + kc0 * 8, kw1 = kk1 * LDK + kc1 * 8;
  const int vw0 = vd0 * LDV + (vc0 >> 1) * 16 + (vc0 & 1) * 4;
#define ATT_KLOAD(S, t_) do { const int tc_ = min((int)(t_), nt - 1); S##k0 = *(const uint4*)(ks0 + (size_t)tc_ * kst0); if (k2) S##k1 = *(const uint4*)(ks1 + (size_t)tc_ * kst1); } while (0)
#define ATT_VLOAD(S, t_) do { const int tc_ = min((int)(t_), nt - 1); S##v0 = *(const uint4*)(vs0 + tc_ * 64); } while (0)
#define ATT_KSTORE(S, buf_) do { bfr* sK_ = sK0 + (buf_) * 64 * LDK; *(uint4*)(sK_ + kw0) = S##k0; if (k2) *(uint4*)(sK_ + kw1) = S##k1; } while (0)
#define ATT_VSTORE(S, buf_) do { bfr* sV_ = sV0 + (buf_) * 64 * LDV; \
       *(uint2*)(sV_ + vw0) = make_uint2(S##v0.x, S##v0.y); *(uint2*)(sV_ + vw0 + 8) = make_uint2(S##v0.z, S##v0.w); } while (0)
#define ATT_QK(SA_, SB_, buf_) do { const bfr* sK = sK0 + (buf_) * 64 * LDK; \
    _Pragma("unroll") for (int r = 0; r < 16; r++) { SA_[r] = 0.f; SB_[r] = 0.f; } \
    _Pragma("unroll") for (int ks = 0; ks < 6; ks++) { \
      bf16x8 k0 = *(const bf16x8*)(sK + l31 * LDK + ks * 16 + hi * 8); \
      bf16x8 k1 = *(const bf16x8*)(sK + (32 + l31) * LDK + ks * 16 + hi * 8); \
      SA_ = __builtin_amdgcn_mfma_f32_32x32x16_bf16(k0, qf[ks], SA_, 0, 0, 0); \
      SB_ = __builtin_amdgcn_mfma_f32_32x32x16_bf16(k1, qf[ks], SB_, 0, 0, 0); } } while (0)
#define ATT_SMPV(S0, S1, buf_) do { const bfr* sV = sV0 + (buf_) * 64 * LDV; \
    float pmax; asm("v_max_f32 %0, %1, %2" : "=v"(pmax) : "v"(S0[0]), "v"(S1[0])); \
    _Pragma("unroll") for (int r = 1; r < 16; r++) asm("v_max3_f32 %0, %1, %2, %3" : "=v"(pmax) : "v"(pmax), "v"(S0[r]), "v"(S1[r])); \
    { auto rr_ = __builtin_amdgcn_permlane32_swap(__float_as_uint(pmax), __float_as_uint(pmax), false, false); \
      pmax = fmaxf(__uint_as_float(rr_[0]), __uint_as_float(rr_[1])); } \
    if (!__all(pmax - mrun <= THR2)) { \
      const float mn = fmaxf(mrun, pmax); const float alpha = __builtin_amdgcn_exp2f(mrun - mn); \
      mrun = mn; lrun *= alpha; \
      _Pragma("unroll") for (int r = 0; r < 16; r++) { O0[r] *= alpha; O1[r] *= alpha; } } \
    float rs = 0.f; \
    _Pragma("unroll") for (int r = 0; r < 16; r++) { \
      S0[r] = __builtin_amdgcn_exp2f(S0[r] - mrun); S1[r] = __builtin_amdgcn_exp2f(S1[r] - mrun); rs += S0[r] + S1[r]; } \
    lrun += rs; \
    _Pragma("unroll") for (int kt = 0; kt < 2; kt++) \
    _Pragma("unroll") for (int sx = 0; sx < 2; sx++) { \
        uint4 pw; \
        if (kt == 0) pw = uint4{cvtpk(S0[8 * sx + 0], S0[8 * sx + 1]), cvtpk(S0[8 * sx + 2], S0[8 * sx + 3]), cvtpk(S0[8 * sx + 4], S0[8 * sx + 5]), cvtpk(S0[8 * sx + 6], S0[8 * sx + 7])}; \
        else         pw = uint4{cvtpk(S1[8 * sx + 0], S1[8 * sx + 1]), cvtpk(S1[8 * sx + 2], S1[8 * sx + 3]), cvtpk(S1[8 * sx + 4], S1[8 * sx + 5]), cvtpk(S1[8 * sx + 6], S1[8 * sx + 7])}; \
        bf16x8 pf = *(bf16x8*)&pw; \
        const int ko = kt * 32 + sx * 16 + hi * 8; \
        uint4 va = *(const uint4*)(sV + l31 * LDV + ko), vb = *(const uint4*)(sV + (32 + l31) * LDV + ko); \
        O0 = __builtin_amdgcn_mfma_f32_32x32x16_bf16(*(bf16x8*)&va, pf, O0, 0, 0, 0); \
        O1 = __builtin_amdgcn_mfma_f32_32x32x16_bf16(*(bf16x8*)&vb, pf, O1, 0, 0, 0); } } while (0)
#define ATT_STEP(S, SC0, SC1, SN0, SN1, t_) do { \
    ATT_KSTORE(S, (t_) & 1); \
    ATT_VSTORE(S, ((t_) + 1) & 1); \
    ATT_KLOAD(S, (t_) + 4); \
    ATT_VLOAD(S, (t_) + 3); \
    ATT_QK(SN0, SN1, ((t_) + 1) & 1); \
    ATT_SMPV(SC0, SC1, (t_) & 1); \
    __syncthreads(); } while (0)
  f32x16 SA0, SA1, SB0, SB1;
  __syncthreads();
  ATT_KLOAD(e, 0); ATT_VLOAD(e, 0); ATT_KLOAD(o, 1);
  ATT_KSTORE(e, 0); ATT_VSTORE(e, 0); ATT_KSTORE(o, 1);
  ATT_KLOAD(e, 2); ATT_VLOAD(e, 1); ATT_KLOAD(o, 3); ATT_VLOAD(o, 2);
  __syncthreads();
  ATT_QK(SA0, SA1, 0);
  __syncthreads();
#pragma unroll 1
  for (int t = 0; t < nt; t += 2) {
    ATT_STEP(e, SA0, SA1, SB0, SB1, t);
    ATT_STEP(o, SB0, SB1, SA0, SA1, t + 1);
  }
#undef ATT_KLOAD
#undef ATT_VLOAD
#undef ATT_KSTORE
#undef ATT_VSTORE
#undef ATT_QK
#undef ATT_SMPV
#undef ATT_STEP
  {
    float l = lrun + __shfl_xor(lrun, 32);
    const float inv = 1.f / l;
    bfr* orow = WS_B(O_BR) + (size_t)row * 2048 + 1536 + head * 64 + 4 * hi;
#pragma unroll
    for (int g4 = 0; g4 < 4; g4++) {
      *(uint2*)(orow + 8 * g4) = make_uint2(cvtpk(O0[4 * g4] * inv, O0[4 * g4 + 1] * inv), cvtpk(O0[4 * g4 + 2] * inv, O0[4 * g4 + 3] * inv));
      *(uint2*)(orow + 32 + 8 * g4) = make_uint2(cvtpk(O1[4 * g4] * inv, O1[4 * g4 + 1] * inv), cvtpk(O1[4 * g4 + 2] * inv, O1[4 * g4 + 3] * inv));
    }
  }
}

DEV void ph_mix(const Prm& p, int L, char* smem_base, char* smem) {
  constexpr int NQB = SEQ / 256;
  const int NA = NQB * 8 + (L == 0 ? 8 : 0);
#ifdef ATT_REP
  for (int rp_ = 0; rp_ < ATT_REP; rp_++)
#endif
  for (int it = blockIdx.x; it < NA; it += gridDim.x) {
    if (it < NQB * 8) {
      int head = it / NQB, qb = it % NQB;
      if (gridDim.x == 256) { const int b = blockIdx.x, xcd = b & 7, j = b >> 3, k = it >> 8; head = (xcd >> 1) + 4 * k; qb = (xcd & 1) * 32 + j; }
      attn_item(p, CTX + qb * 256, head, ROWS, smem_base);
    } else attn_item(p, 0, it - NQB * 8, CTX, smem_base);
  }
  constexpr int N2 = NCH * 4, N3 = N2 + NCH * 8;
  for (int it = VBX; it < N3; it += VGX) {
    if (it < N2) ssm_out_item(p, L, it, smem);
    else ret_out_item(p, L, it - N2, smem);
  }
}

#define XB_TMO      128
#define XB_XCNT(j)  (256  + 64 * (j))
#define XB_XSUB(j)  (1280 + 64 * (j))
#define XB_XGEN(j)  (2304 + 64 * (j))
#define XB_TOP      3328
#define XB_TOPGEN   3392
#define XCD_BAR_WORDS 3456
#define XB_SPIN_CAP (1u << 18)
#define LAS __attribute__((address_space(3)))
DEV unsigned xb_ld(unsigned* p)              { return __hip_atomic_load(p, __ATOMIC_RELAXED, __HIP_MEMORY_SCOPE_AGENT); }
DEV unsigned xb_add(unsigned* p, unsigned v) { return __hip_atomic_fetch_add(p, v, __ATOMIC_RELAXED, __HIP_MEMORY_SCOPE_AGENT); }
DEV unsigned xb_xcc_id() { return (unsigned)__builtin_amdgcn_s_getreg((3 << 11) | 20) & 0xFu; }
#define XB_SPIN(cond, bar) do { unsigned _sp = 0; while (cond) { __builtin_amdgcn_s_sleep(1); \
    if ((++_sp & 255u) == 0u) { if (xb_ld(&(bar)[XB_TMO])) break; if (_sp > XB_SPIN_CAP) { atomicAdd(&(bar)[XB_TMO], 1u); break; } } } } while (0)
struct XcdBarrier { unsigned* bar; unsigned x; volatile LAS unsigned* st; };
DEV XcdBarrier xcd_barrier_post(unsigned* bar, volatile LAS unsigned* st) {
  XcdBarrier b; b.bar = bar; b.x = xb_xcc_id(); b.st = st;
  if (__builtin_amdgcn_workitem_id_x() == 0) (void)xb_add(&bar[XB_XCNT(b.x)], 1u);
  return b;
}
DEV void xcd_barrier_complete(unsigned* bar, unsigned x, unsigned& nloc, unsigned& nx) {
  const unsigned G = gridDim.x * gridDim.y * gridDim.z;
  unsigned sum, cnt, mine, sp = 0u;
  for (;;) {
    sum = 0u; cnt = 0u; mine = 0u;
#pragma unroll
    for (unsigned j = 0; j < 16; ++j) { const unsigned c = xb_ld(&bar[XB_XCNT(j)]); sum += c; cnt += (c > 0u) ? 1u : 0u; mine = (j == x) ? c : mine; }
    if (sum == G) break;
    __builtin_amdgcn_s_sleep(1);
    if ((++sp & 255u) == 0u) { if (xb_ld(&bar[XB_TMO])) break; if (sp > XB_SPIN_CAP) { atomicAdd(&bar[XB_TMO], 1u); break; } }
  }
  nloc = mine > 0u ? mine : 1u; nx = cnt > 0u ? cnt : 1u;
}
DEV void xcd_barrier(const XcdBarrier& b) {
  asm volatile("s_waitcnt vmcnt(0)" ::: "memory");
  __syncthreads();
  if (__builtin_amdgcn_workitem_id_x() == 0) {
    unsigned* bar = b.bar;
    __builtin_amdgcn_s_waitcnt(0);
    unsigned nloc = b.st[0], nx = b.st[1];
    if (nloc == 0u) { xcd_barrier_complete(bar, b.x, nloc, nx); b.st[0] = nloc; b.st[1] = nx; }
    const unsigned old = xb_add(&bar[XB_XSUB(b.x)], 1u);
    const unsigned gen = old / nloc;
    if (old + 1u == (gen + 1u) * nloc) {
      __builtin_amdgcn_fence(__ATOMIC_RELEASE, "agent");
      asm volatile("s_waitcnt vmcnt(0)" ::: "memory");
      const unsigned og = xb_add(&bar[XB_TOP], 1u);
      const unsigned tg = og / nx;
      if (og + 1u == (tg + 1u) * nx) xb_add(&bar[XB_TOPGEN], 1u);
      else XB_SPIN(xb_ld(&bar[XB_TOPGEN]) == tg, bar);
      __builtin_amdgcn_fence(__ATOMIC_ACQUIRE, "agent");
      xb_add(&bar[XB_XGEN(b.x)], 1u);
      asm volatile("s_waitcnt vmcnt(0)" ::: "memory");
    } else {
      XB_SPIN(xb_ld(&bar[XB_XGEN(b.x)]) == gen, bar);
      __builtin_amdgcn_fence(__ATOMIC_ACQUIRE, "agent");
      asm volatile("s_waitcnt vmcnt(0)" ::: "memory");
    }
  }
  __syncthreads();
}

constexpr int NST = 13, NPH = 2 + 2 * (1 + 2 * NST);
DEV void run_phase(const Prm& p, int ph, char* smem_base) {
  char* smem = smem_base + (rtid() >> 8) * 63488;
  if (ph == 0) { ph_ada(p); return; }
  if (ph == 1) { ph_ada_reduce(p); return; }
  int q = ph - 2, L = q / (1 + 2 * NST), s = q % (1 + 2 * NST);
#ifdef CONV_REP
  if (s == 0) { for (int r_ = 0; r_ < CONV_REP; r_++) ph_convert(p, L, smem); return; }
#endif
  if (s == 0) { ph_convert(p, L, smem); ph_norm(p, L, 0, 0); return; }
  s -= 1;
  int b = s / NST, st = s % NST;
#ifdef ONLY
  st = ONLY;
#endif
#ifdef REP_MASK
  for (int rep_ = 0; rep_ < (((REP_MASK >> st) & 1) ? REP_N : 1); rep_++)
#endif
  switch (st) {
    case 0: ph_norm(p, L, b, 0); break;
    case 1: ph_inproj(p, smem_base); break;
    case 2: ph_local(p, L, smem); break;
    case 3: ph_states(p, L, smem); break;
    case 4: ph_scan(p, L); break;
    case 5: ph_mix(p, L, smem_base, smem); break;
    case 6: ph_gates(p, L, smem_base); break;
    case 7: ph_merge(p, L, smem); break;
    case 8: ph_resgemm(p, L, b, WS_B(O_H), D, WS_B(O_WTOUT), D, 2, true, smem_base); break;
    case 9: ph_norm(p, L, b, 1); break;
    case 10: ph_ffn1(p, L, smem_base); break;
    case 11: ph_resgemm(p, L, b, WS_B(O_U), FFN, WS_B(O_WTF2), FFN, 5, false, smem_base);
             if (b == 0) ph_norm(p, L, 1, 0);
             break;
    case 12: if (L == 1) ph_final_norm(p, b); break;
  }
}

constexpr int DYN_LDS = 2 * 63488;
__global__ void __launch_bounds__(512) mega(Prm p, int ph0, int ph1) {
  extern __shared__ __attribute__((aligned(16))) char smem[];
  __shared__ uint4 xb_words;
#if COOP
  if (__builtin_amdgcn_workitem_id_x() == 0) xb_words = make_uint4(0u, 0u, 0u, 0u);
  __syncthreads();
  (void)xcd_barrier_post((unsigned*)(p.ws + O_BAR), (volatile LAS unsigned*)&xb_words);
#define GRID_BARRIER() do { if (ph1 > 100000) cg::this_grid().sync(); else { XcdBarrier xb_; xb_.bar = (unsigned*)(p.ws + O_BAR); xb_.x = xb_xcc_id(); xb_.st = (volatile LAS unsigned*)&xb_words; xcd_barrier(xb_); } } while (0)
#else
#define GRID_BARRIER() do {} while (0)
#endif
  for (int ph = ph0; ph < ph1; ph++) {
    if (ph >= 2 && ph < 2 + (1 + 2 * NST) && ((ph - 2) % (1 + 2 * NST)) >= 1 && (((ph - 2) % (1 + 2 * NST)) - 1) % NST == 12) continue;
    { const int q_ = ph - 2; if (q_ >= 0) { const int s_ = q_ % (1 + 2 * NST); if (s_ == 1 || s_ == 1 + NST) continue; } }
    run_phase(p, ph, smem);
    if (ph + 1 < ph1) GRID_BARRIER();
  }
}

extern "C" void kernel_launch(void* const* d_in, const int* in_sizes, int n_in, void* d_out, int out_size, void* d_ws,
                              size_t ws_size, hipStream_t stream) {
  static int grid_blocks = 0;
  if (!grid_blocks) {
    int dev = 0, cus = 0, per_cu = 0;
    (void)hipGetDevice(&dev);
    (void)hipDeviceGetAttribute(&cus, hipDeviceAttributeMultiprocessorCount, dev);
    (void)hipFuncSetAttribute((const void*)mega, hipFuncAttributeMaxDynamicSharedMemorySize, DYN_LDS);
    (void)hipOccupancyMaxActiveBlocksPerMultiprocessor(&per_cu, mega, 512, DYN_LDS);
    if (per_cu > 1) per_cu = 1;
    if (per_cu < 1) per_cu = 1;
    grid_blocks = cus * per_cu;
  }
  Prm p{};
  for (int i = 0; i < N_INPUTS; i++) p.in[i] = (const float*)d_in[i];
  p.out = (float*)d_out;
  p.ws = (char*)d_ws;
#if COOP
  hipMemsetAsync((char*)d_ws + O_BAR, 0, 3456 * 4, stream);
  int ph0 = 0, ph1 = NPH;
  void* args[] = {&p, &ph0, &ph1};
  hipError_t e = hipLaunchCooperativeKernel((void*)mega, dim3(grid_blocks), dim3(512), args, DYN_LDS, stream);
  if (e != hipSuccess) fprintf(stderr, "cooperative launch failed: %s (grid %d)\n", hipGetErrorString(e), grid_blocks);
#else
  for (int ph = 0; ph < NPH; ph++) mega<<<grid_blocks, 512, DYN_LDS, stream>>>(p, ph, ph + 1);
#endif
}
```

```cpp
#include <hip/hip_runtime.h>
#include <hip/hip_cooperative_groups.h>
#include <cstdio>
namespace cg = cooperative_groups;

#ifndef COOP
#define COOP 1
#endif
#define REP_N 4

typedef unsigned short bfr;
typedef __attribute__((ext_vector_type(8))) short bf16x8;
typedef __attribute__((ext_vector_type(4))) float f32x4;
#define DEV __device__ __forceinline__

constexpr int D = 1024, SEQ = 16384, CTX = 256, ROWS = SEQ + CTX, NCH = ROWS / 128;
constexpr int NIN = 8880, NU = 4784, FFN = 2816, NMOD = 6144;
constexpr int C_Z = 1024, C_XBC = 1536, C_DT = 2560, C_RQ = 2576, C_RK = 2832, C_RV = 3088, C_RG = 3600,
              C_CQ = 4112, C_CKV = 4496, C_KR = 4752;
constexpr float EPS = 1e-6f;

enum { I_X, I_C, I_CTX, I_CCTX, I_WADA, I_BADA, I_N1G, I_N2G, I_WIN, I_CONVW, I_CONVB, I_CLNG, I_CLNB, I_SCW, I_SCB,
       I_DTB, I_ALOG, I_SSMD, I_SNG, I_RDEC, I_RGNG, I_RGNB, I_QNG, I_KVNG, I_WUQ, I_WUKV, I_WBR, I_WOUT, I_WF1,
       I_WF2, I_FNG, N_INPUTS };

struct Prm { const float* in[N_INPUTS]; float* out; char* ws; };

constexpr size_t al256(size_t x) { return (x + 255) & ~(size_t)255; }
constexpr size_t O_MOD   = 0;
constexpr size_t O_MODP  = al256(O_MOD + (size_t)2 * 3 * NMOD * 4);
constexpr size_t O_RCS   = al256(O_MODP + (size_t)16 * 2 * 3 * NMOD * 4);
constexpr size_t O_MCS   = al256(O_RCS + 256 * 16 * 8);
constexpr size_t O_CS    = al256(O_MCS + 256 * 8 * 8);
constexpr size_t O_RSQ   = al256(O_CS + (size_t)2 * CTX * D * 4);
constexpr size_t O_RSKV  = al256(O_RSQ + ROWS * 4);
constexpr size_t O_TOT   = al256(O_RSKV + ROWS * 4);
constexpr size_t O_KROPE = al256(O_TOT + 2 * NCH * 8 * 4);
constexpr size_t O_WTIN  = al256(O_KROPE + (size_t)ROWS * 32 * 2);
constexpr size_t O_WTBR  = al256(O_WTIN + (size_t)NIN * D * 2);
constexpr size_t O_WTOUT = al256(O_WTBR + (size_t)4 * D * 512 * 2);
constexpr size_t O_WTF1  = al256(O_WTOUT + (size_t)D * D * 2);
constexpr size_t O_WTF2  = al256(O_WTF1 + (size_t)2 * FFN * D * 2);
constexpr size_t O_WTUQ  = al256(O_WTF2 + (size_t)D * FFN * 2);
constexpr size_t O_WTUKV = al256(O_WTUQ + (size_t)768 * 384 * 2);
constexpr size_t O_H     = al256(O_WTUKV + (size_t)1024 * 256 * 2);
constexpr size_t O_U     = al256(O_H + (size_t)ROWS * D * 2);
constexpr size_t O_BR    = al256(O_U + (size_t)ROWS * NU * 2);
constexpr size_t O_XBC   = al256(O_BR + (size_t)ROWS * 2048 * 2);
constexpr size_t O_SST   = al256(O_XBC + (size_t)ROWS * 1024 * 2);
constexpr size_t O_RST   = al256(O_SST + (size_t)2 * NCH * 8 * 8192 * 4);
constexpr size_t O_Q     = al256(O_RST + (size_t)2 * NCH * 4 * 8192 * 4);
constexpr size_t O_KN    = al256(O_Q + (size_t)ROWS * 768 * 2);
constexpr size_t O_VT    = al256(O_KN + (size_t)ROWS * 512 * 2);
constexpr size_t O_BAR   = al256(O_VT + (size_t)512 * ROWS * 2);
constexpr size_t O_END   = al256(O_BAR + 3456 * 4);
static_assert(O_END <= (size_t)512 * 1024 * 1024, "workspace too large");

#define WS_F(off) ((float*)(p.ws + (off)))
#define WS_B(off) ((bfr*)(p.ws + (off)))

DEV int rtid() { int t = __builtin_amdgcn_workitem_id_x(); asm volatile("" : "+v"(t)); return t; }
DEV int otid() { return rtid() & 255; }
#define VBX ((int)(blockIdx.x * 2 + (rtid() >> 8)))
#define VGX ((int)(gridDim.x * 2))
DEV bfr f2bf(float f) { unsigned u = __float_as_uint(f); u += 0x7fffu + ((u >> 16) & 1u); return (bfr)(u >> 16); }
DEV float bf2f(unsigned h) { return __uint_as_float(h << 16); }
DEV unsigned pack2(float a, float b) { unsigned r; asm("v_cvt_pk_bf16_f32 %0, %1, %2" : "=v"(r) : "v"(a), "v"(b)); return r; }
DEV uint2 pack4(float a, float b, float c, float d) { uint2 r; r.x = pack2(a, b); r.y = pack2(c, d); return r; }
DEV float lo16(unsigned w) { return __uint_as_float(w << 16); }
DEV float hi16(unsigned w) { return __uint_as_float(w & 0xffff0000u); }
DEV void unpack8(const uint4& v, float (&f)[8]) {
  f[0] = lo16(v.x); f[1] = hi16(v.x); f[2] = lo16(v.y); f[3] = hi16(v.y);
  f[4] = lo16(v.z); f[5] = hi16(v.z); f[6] = lo16(v.w); f[7] = hi16(v.w);
}
DEV void unpack4(const uint2& v, float (&f)[4]) { f[0] = lo16(v.x); f[1] = hi16(v.x); f[2] = lo16(v.y); f[3] = hi16(v.y); }
DEV uint4 pack8(const float (&f)[8]) {
  uint4 r; r.x = pack2(f[0], f[1]); r.y = pack2(f[2], f[3]); r.z = pack2(f[4], f[5]); r.w = pack2(f[6], f[7]); return r;
}
DEV unsigned elem16(const uint4& v, int e) {
  unsigned w = (e >> 1) == 0 ? v.x : (e >> 1) == 1 ? v.y : (e >> 1) == 2 ? v.z : v.w;
  return (e & 1) ? (w >> 16) : (w & 0xffffu);
}
DEV float silu_f(float x) { return x / (1.f + __expf(-x)); }
DEV float sigm_f(float x) { return 1.f / (1.f + __expf(-x)); }
DEV float softplus_f(float x) { return x > 20.f ? x : log1pf(__expf(x)); }
DEV float wave_sum(float v) {
#pragma unroll
  for (int o = 32; o >= 1; o >>= 1) v += __shfl_xor(v, o);
  return v;
}

template <int MI, int NI, int KS>
DEV void lds_gemm(const bfr* sX, int ldx, const bfr* sW, int ldw, f32x4 (&acc)[MI][NI]) {
  const int lane = otid() & 63, l15 = lane & 15, quad = lane >> 4;
#pragma unroll
  for (int ks = 0; ks < KS; ks++) {
    bf16x8 xa[MI], wb[NI];
#pragma unroll
    for (int mi = 0; mi < MI; mi++) xa[mi] = *(const bf16x8*)(sX + (mi * 16 + l15) * ldx + ks * 32 + quad * 8);
#pragma unroll
    for (int ni = 0; ni < NI; ni++) wb[ni] = *(const bf16x8*)(sW + (ni * 16 + l15) * ldw + ks * 32 + quad * 8);
#pragma unroll
    for (int mi = 0; mi < MI; mi++)
#pragma unroll
      for (int ni = 0; ni < NI; ni++)
        acc[mi][ni] = __builtin_amdgcn_mfma_f32_16x16x32_bf16(wb[ni], xa[mi], acc[mi][ni], 0, 0, 0);
  }
}

DEV void gemm_mainloop(const bfr* __restrict__ A, int lda, const bfr* __restrict__ Bt, int ldb, int K,
                       f32x4 (&acc)[4][4], char* smem) {
  bfr* sA = (bfr*)smem;
  bfr* sB = sA + 128 * 72;
  const int tid = otid(), wid = tid >> 6, wm = wid >> 1, wn = wid & 1;
  const int lrow = tid >> 3, lkc = (tid & 7) * 8;
  const bfr* pa = A + (size_t)lrow * lda + lkc;
  const bfr* pb = Bt + (size_t)lrow * ldb + lkc;
  const size_t sa = (size_t)32 * lda, sb = (size_t)32 * ldb;
  uint4 ra0 = *(const uint4*)(pa), ra1 = *(const uint4*)(pa + sa), ra2 = *(const uint4*)(pa + 2 * sa), ra3 = *(const uint4*)(pa + 3 * sa);
  uint4 rb0 = *(const uint4*)(pb), rb1 = *(const uint4*)(pb + sb), rb2 = *(const uint4*)(pb + 2 * sb), rb3 = *(const uint4*)(pb + 3 * sb);
  bfr* wa = sA + lrow * 72 + lkc;
  bfr* wb = sB + lrow * 72 + lkc;
  const int nk = K >> 6;
#pragma unroll 1
  for (int kt = 0; kt < nk; kt++) {
    __syncthreads();
    *(uint4*)(wa) = ra0; *(uint4*)(wa + 32 * 72) = ra1; *(uint4*)(wa + 64 * 72) = ra2; *(uint4*)(wa + 96 * 72) = ra3;
    *(uint4*)(wb) = rb0; *(uint4*)(wb + 32 * 72) = rb1; *(uint4*)(wb + 64 * 72) = rb2; *(uint4*)(wb + 96 * 72) = rb3;
    __syncthreads();
    if (kt + 1 < nk) {
      pa += 64; pb += 64;
      ra0 = *(const uint4*)(pa); ra1 = *(const uint4*)(pa + sa); ra2 = *(const uint4*)(pa + 2 * sa); ra3 = *(const uint4*)(pa + 3 * sa);
      rb0 = *(const uint4*)(pb); rb1 = *(const uint4*)(pb + sb); rb2 = *(const uint4*)(pb + 2 * sb); rb3 = *(const uint4*)(pb + 3 * sb);
    }
    lds_gemm<4, 4, 2>(sA + (wm * 64) * 72, 72, sB + (wn * 64) * 72, 72, acc);
  }
}

DEV void gemm2_mainloop(const bfr* __restrict__ A, int lda, const bfr* __restrict__ Bt, int ldb, int K,
                        f32x4 (&acc)[8][4], char* smem) {
  constexpr int LDT = 32;
  bfr* sA0 = (bfr*)smem;
  bfr* sB0 = sA0 + 2 * 256 * LDT;
  const int tid = otid(), lane = tid & 63, wid = tid >> 6, wm = wid >> 1, wn = wid & 1, l15 = lane & 15, quad = lane >> 4;
  const int lrow = tid >> 2, lkc = (tid & 3) * 8;
  const bfr* pa = A + (size_t)lrow * lda + lkc;
  const bfr* pb = Bt + (size_t)lrow * ldb + lkc;
  const size_t sa = (size_t)64 * lda, sb = (size_t)64 * ldb;
  const int wo = lrow * LDT + (((tid & 3) ^ ((0x1320 >> (4 * ((lrow >> 2) & 3))) & 3)) * 8);
  const int rsw = ((quad ^ ((0x1320 >> (4 * ((l15 >> 2) & 3))) & 3)) * 8);
  uint4 ra0, ra1, ra2, ra3, rb0, rb1;
#define SBAR() __builtin_amdgcn_sched_barrier(0)
#define G2_LOADA() do { ra0 = *(const uint4*)(pa); ra1 = *(const uint4*)(pa + sa); ra2 = *(const uint4*)(pa + 2 * sa); ra3 = *(const uint4*)(pa + 3 * sa); pa += 32; } while (0)
#define G2_LOADB() do { rb0 = *(const uint4*)(pb); rb1 = *(const uint4*)(pb + sb); pb += 32; } while (0)
#define G2_STOREA(buf_) do { bfr* a_ = sA0 + (buf_) * 256 * LDT + wo; \
                       *(uint4*)(a_) = ra0; *(uint4*)(a_ + 64 * LDT) = ra1; *(uint4*)(a_ + 128 * LDT) = ra2; *(uint4*)(a_ + 192 * LDT) = ra3; } while (0)
#define G2_STOREB(buf_) do { bfr* b_ = sB0 + (buf_) * 128 * LDT + wo; *(uint4*)(b_) = rb0; *(uint4*)(b_ + 64 * LDT) = rb1; } while (0)
#ifdef PROBE_DMFMA
  f32x4 dacc[4] = {f32x4{0,0,0,0}, f32x4{0,0,0,0}, f32x4{0,0,0,0}, f32x4{0,0,0,0}};
#define MF4(xa_, mi_) do { _Pragma("unroll") for (int ni = 0; ni < 4; ni++) { acc[mi_][ni] = __builtin_amdgcn_mfma_f32_16x16x32_bf16(wb[ni], xa_, acc[mi_][ni], 0, 0, 0); dacc[ni] = __builtin_amdgcn_mfma_f32_16x16x32_bf16(wb[ni], xa_, dacc[ni], 0, 0, 0); } } while (0)
#else
#define MF4(xa_, mi_) do { _Pragma("unroll") for (int ni = 0; ni < 4; ni++) acc[mi_][ni] = __builtin_amdgcn_mfma_f32_16x16x32_bf16(wb[ni], xa_, acc[mi_][ni], 0, 0, 0); } while (0)
#endif
  const int nk = K >> 5;
  __syncthreads();
  G2_LOADA(); G2_LOADB(); G2_STOREA(0); G2_STOREB(0);
  if (nk > 1) { G2_LOADA(); G2_LOADB(); }
  __syncthreads();
#pragma unroll 1
  for (int kt = 0; kt < nk; kt++) {
    const int cur = kt & 1, nxt = cur ^ 1;
    const bool st = kt + 1 < nk, ld = kt + 2 < nk;
    const bfr* sA = sA0 + cur * 256 * LDT + (wm * 128 + l15) * LDT + rsw;
    const bfr* sB = sB0 + cur * 128 * LDT + (wn * 64 + l15) * LDT + rsw;
    bf16x8 wb[4];
#pragma unroll
    for (int ni = 0; ni < 4; ni++) wb[ni] = *(const bf16x8*)(sB + ni * 16 * LDT);
    bf16x8 f0 = *(const bf16x8*)(sA), f1 = *(const bf16x8*)(sA + 16 * LDT), f2;
    SBAR();
    f2 = *(const bf16x8*)(sA + 32 * LDT); MF4(f0, 0); SBAR();
    f0 = *(const bf16x8*)(sA + 48 * LDT); MF4(f1, 1); if (st) G2_STOREA(nxt); SBAR();
    f1 = *(const bf16x8*)(sA + 64 * LDT); MF4(f2, 2); if (st) G2_STOREB(nxt); SBAR();
    f2 = *(const bf16x8*)(sA + 80 * LDT); MF4(f0, 3); if (ld) G2_LOADA(); SBAR();
    f0 = *(const bf16x8*)(sA + 96 * LDT); MF4(f1, 4); if (ld) G2_LOADB(); SBAR();
    f1 = *(const bf16x8*)(sA + 112 * LDT); MF4(f2, 5); SBAR();
    MF4(f0, 6); SBAR();
    MF4(f1, 7);
    __syncthreads();
  }
#undef G2_LOADA
#undef G2_LOADB
#undef G2_STOREA
#undef G2_STOREB
#undef MF4
#ifdef PROBE_DMFMA
  if (dacc[0][0] + dacc[1][1] + dacc[2][2] + dacc[3][3] == 12345.678f) smem[otid()] = 1;
#endif
}
DEV void gemm4_mainloop(const bfr* __restrict__ A, int lda, const bfr* __restrict__ Bt, int ldb, int K,
                        f32x4 (&acc)[4][4], char* smem, const bfr* nA, const bfr* nBt, bool first,
                        const bfr*& g_pa, const bfr*& g_pb, uint4& g_pa0, uint4& g_pa1, uint4& g_pb0, uint4& g_pb1, uint4& g_qa0, uint4& g_qa1, uint4& g_qb0, uint4& g_qb1) {
  constexpr int LDT = 32;
  bfr* sA0 = (bfr*)smem;
  bfr* sB0 = sA0 + 2 * 128 * LDT;
  const int tid = otid(), lane = tid & 63, wid = tid >> 6, wm = wid >> 1, wn = wid & 1, l15 = lane & 15, quad = lane >> 4;
  const int lrow = tid >> 2, lkc = (tid & 3) * 8;
  const size_t offA = (size_t)lrow * lda + lkc, offB = (size_t)lrow * ldb + lkc;
  const size_t sa = (size_t)64 * lda, sb = (size_t)64 * ldb;
  const int wo = lrow * LDT + (((tid & 3) ^ ((0x1320 >> (4 * ((lrow >> 2) & 3))) & 3)) * 8);
  const int rsw = ((quad ^ ((0x1320 >> (4 * ((l15 >> 2) & 3))) & 3)) * 8);
  const bfr* npa = nA + offA; const bfr* npb = nBt + offB;
  int g_rem;
#define G4_LOAD(S) do { g_##S##a0 = *(const uint4*)(g_pa); g_##S##a1 = *(const uint4*)(g_pa + sa); g_##S##b0 = *(const uint4*)(g_pb); g_##S##b1 = *(const uint4*)(g_pb + sb); \
      g_rem -= 1; const bool sw_ = g_rem == 0; g_pa = sw_ ? npa : g_pa + 32; g_pb = sw_ ? npb : g_pb + 32; } while (0)
#define G4_STORE(S, buf_) do { bfr* a_ = sA0 + (buf_) * 128 * LDT + wo; bfr* b_ = sB0 + (buf_) * 128 * LDT + wo; \
      *(uint4*)(a_) = g_##S##a0; *(uint4*)(a_ + 64 * LDT) = g_##S##a1; *(uint4*)(b_) = g_##S##b0; *(uint4*)(b_ + 64 * LDT) = g_##S##b1; } while (0)
#define MF4(xa_, mi_) do { _Pragma("unroll") for (int ni = 0; ni < 4; ni++) acc[mi_][ni] = __builtin_amdgcn_mfma_f32_16x16x32_bf16(wb[ni], xa_, acc[mi_][ni], 0, 0, 0); } while (0)
#define G4_ITER(S, cur_) do { \
    const bfr* sA = sA0 + (cur_) * 128 * LDT + (wm * 64 + l15) * LDT + rsw; \
    const bfr* sB = sB0 + (cur_) * 128 * LDT + (wn * 64 + l15) * LDT + rsw; \
    bf16x8 wb[4]; \
    _Pragma("unroll") for (int ni = 0; ni < 4; ni++) wb[ni] = *(const bf16x8*)(sB + ni * 16 * LDT); \
    bf16x8 f0 = *(const bf16x8*)(sA), f1 = *(const bf16x8*)(sA + 16 * LDT), f2, f3; \
    SBAR(); \
    f2 = *(const bf16x8*)(sA + 32 * LDT); MF4(f0, 0); G4_STORE(S, (cur_) ^ 1); SBAR(); \
    f3 = *(const bf16x8*)(sA + 48 * LDT); MF4(f1, 1); G4_LOAD(S); SBAR(); \
    MF4(f2, 2); SBAR(); \
    MF4(f3, 3); \
    __syncthreads(); } while (0)
  const int nk = K >> 5;
  if (first) {
    g_pa = A + offA; g_pb = Bt + offB; g_rem = nk;
    __syncthreads();
    G4_LOAD(p); G4_LOAD(q);
    G4_STORE(p, 0);
    G4_LOAD(p);
    __syncthreads();
  } else {
    g_rem = nk - 3;
  }
#pragma unroll 1
  for (int kt = 0; kt < nk; kt += 2) {
    G4_ITER(q, 0);
    G4_ITER(p, 1);
  }
#undef G4_LOAD
#undef G4_STORE
#undef G4_ITER
#undef MF4
}
DEV void gemm4_single(const bfr* __restrict__ A, int lda, const bfr* __restrict__ Bt, int ldb, int K, f32x4 (&acc)[4][4], char* smem) {
  const bfr* g_pa = nullptr; const bfr* g_pb = nullptr; uint4 a0{}, a1{}, b0{}, b1{}, c0{}, c1{}, d0{}, d1{};
  gemm4_mainloop(A, lda, Bt, ldb, K, acc, smem, A, Bt, true, g_pa, g_pb, a0, a1, b0, b1, c0, c1, d0, d1);
}

DEV void gemm3_mainloop(const bfr* __restrict__ A, int lda, const bfr* __restrict__ Bt, int ldb, int K,
                        f32x4 (&acc)[8][4], char* smem, const bfr* nA, const bfr* nBt, bool first,
                        const bfr*& g_pa, const bfr*& g_pb, uint4& g_pa0, uint4& g_pa1, uint4& g_pb0, uint4& g_pb1, uint4& g_qa0, uint4& g_qa1, uint4& g_qb0, uint4& g_qb1) {
  int g_rem;
  constexpr int LDT = 32;
  bfr* sA0 = (bfr*)smem;
  bfr* sB0 = sA0 + 2 * 256 * LDT;
  const int tid = rtid(), lane = tid & 63, wid = tid >> 6, wm = wid >> 2, wn = wid & 3, l15 = lane & 15, quad = lane >> 4;
  const int lrow = tid >> 2, lkc = (tid & 3) * 8;
  const size_t offA = (size_t)lrow * lda + lkc, offB = (size_t)lrow * ldb + lkc;
  const size_t sa = (size_t)128 * lda, sb = (size_t)128 * ldb;
  const int wo = lrow * LDT + (((tid & 3) ^ ((0x1320 >> (4 * ((lrow >> 2) & 3))) & 3)) * 8);
  const int rsw = ((quad ^ ((0x1320 >> (4 * ((l15 >> 2) & 3))) & 3)) * 8);
  const bfr* npa = nA + offA; const bfr* npb = nBt + offB;
#define G3_LOAD(S) do { g_##S##a0 = *(const uint4*)(g_pa); g_##S##a1 = *(const uint4*)(g_pa + sa); g_##S##b0 = *(const uint4*)(g_pb); g_##S##b1 = *(const uint4*)(g_pb + sb); \
      g_rem -= 1; const bool sw_ = g_rem == 0;                   \
      g_pa = sw_ ? npa : g_pa + 32; g_pb = sw_ ? npb : g_pb + 32; } while (0)
#define G3_STORE(S, buf_) do { bfr* a_ = sA0 + (buf_) * 256 * LDT + wo; bfr* b_ = sB0 + (buf_) * 256 * LDT + wo; \
      *(uint4*)(a_) = g_##S##a0; *(uint4*)(a_ + 128 * LDT) = g_##S##a1; *(uint4*)(b_) = g_##S##b0; *(uint4*)(b_ + 128 * LDT) = g_##S##b1; } while (0)
#define MF4(xa_, mi_) do { _Pragma("unroll") for (int ni = 0; ni < 4; ni++) acc[mi_][ni] = __builtin_amdgcn_mfma_f32_16x16x32_bf16(wb[ni], xa_, acc[mi_][ni], 0, 0, 0); } while (0)
#define G3_ITER(S, cur_) do { \
    const bfr* sA = sA0 + (cur_) * 256 * LDT + (wm * 128 + l15) * LDT + rsw; \
    const bfr* sB = sB0 + (cur_) * 256 * LDT + (wn * 64 + l15) * LDT + rsw; \
    bf16x8 wb[4]; \
    _Pragma("unroll") for (int ni = 0; ni < 4; ni++) wb[ni] = *(const bf16x8*)(sB + ni * 16 * LDT); \
    bf16x8 f0 = *(const bf16x8*)(sA), f1 = *(const bf16x8*)(sA + 16 * LDT), f2; \
    SBAR(); \
    f2 = *(const bf16x8*)(sA + 32 * LDT); MF4(f0, 0); SBAR(); \
    f0 = *(const bf16x8*)(sA + 48 * LDT); MF4(f1, 1); G3_STORE(S, (cur_) ^ 1); SBAR(); \
    f1 = *(const bf16x8*)(sA + 64 * LDT); MF4(f2, 2); G3_LOAD(S); SBAR(); \
    f2 = *(const bf16x8*)(sA + 80 * LDT); MF4(f0, 3); SBAR(); \
    f0 = *(const bf16x8*)(sA + 96 * LDT); MF4(f1, 4); SBAR(); \
    f1 = *(const bf16x8*)(sA + 112 * LDT); MF4(f2, 5); SBAR(); \
    MF4(f0, 6); SBAR(); \
    MF4(f1, 7); \
    __syncthreads(); } while (0)
  const int nk = K >> 5;
  if (first) {
    g_pa = A + offA; g_pb = Bt + offB; g_rem = nk;
    __syncthreads();
    G3_LOAD(p); G3_LOAD(q);
    G3_STORE(p, 0);
    G3_LOAD(p);
    __syncthreads();
  } else {
    g_rem = nk - 3;
  }
#pragma unroll 1
  for (int kt = 0; kt < nk; kt += 2) {
    G3_ITER(q, 0);
    G3_ITER(p, 1);
  }
#undef G3_LOAD
#undef G3_STORE
#undef G3_ITER
#undef MF4
}
DEV void zero_acc84(f32x4 (&acc)[8][4]) {
#pragma unroll
  for (int i = 0; i < 8; i++)
#pragma unroll
    for (int j = 0; j < 4; j++) acc[i][j] = f32x4{0.f, 0.f, 0.f, 0.f};
}


DEV bool tile_remap(int r, int MT, int NT, int& mt, int& nt, int b, int G, bool clamp) {
  const int per = G >> 3;
  int lin = r * G + (b & 7) * per + (b >> 3);
  if (lin >= MT * NT) { if (!clamp) return false; lin = MT * NT - 1; }
  const int g = lin / (8 * NT), rem = lin - g * 8 * NT;
  const int gsz = min(8, MT - 8 * g);
  nt = rem / gsz; mt = 8 * g + rem - nt * gsz;
  return true;
}
DEV void zero_acc44(f32x4 (&acc)[4][4]) {
#pragma unroll
  for (int i = 0; i < 4; i++)
#pragma unroll
    for (int j = 0; j < 4; j++) acc[i][j] = f32x4{0.f, 0.f, 0.f, 0.f};
}

DEV const float* res_src(const Prm& p, int L, int b, int r) {
  if (r < CTX) return (L == 0 ? p.in[I_CTX] : (const float*)WS_F(O_CS)) + ((size_t)(b * CTX + r)) * D;
  return (L == 0 ? p.in[I_X] : (const float*)p.out) + ((size_t)b * SEQ + (r - CTX)) * D;
}
DEV float* res_dst(const Prm& p, int b, int r) {
  if (r < CTX) return WS_F(O_CS) + ((size_t)(b * CTX + r)) * D;
  return p.out + ((size_t)b * SEQ + (r - CTX)) * D;
}

DEV void ph_ada(const Prm& p) {
  const int tid = otid();
  for (int it = VBX; it < 193; it += VGX) {
    if (it < 192) {
      int L = it / 96, rem = it % 96, ks = rem / 6, cb = rem % 6;
      int j = (cb * 256 + tid) * 4;
      float4 a0 = {0, 0, 0, 0}, a1 = a0, a2 = a0;
      const float* W = p.in[I_WADA] + (size_t)L * D * NMOD;
      for (int k = ks * 64; k < ks * 64 + 64; k++) {
        float4 w = *(const float4*)(W + (size_t)k * NMOD + j);
        float s0 = silu_f(p.in[I_C][k]), s1 = silu_f(p.in[I_C][D + k]), s2 = silu_f(p.in[I_CCTX][k]);
        a0.x += s0 * w.x; a0.y += s0 * w.y; a0.z += s0 * w.z; a0.w += s0 * w.w;
        a1.x += s1 * w.x; a1.y += s1 * w.y; a1.z += s1 * w.z; a1.w += s1 * w.w;
        a2.x += s2 * w.x; a2.y += s2 * w.y; a2.z += s2 * w.z; a2.w += s2 * w.w;
      }
      float* MP = WS_F(O_MODP) + ((size_t)(ks * 2 + L) * 3) * NMOD;
      *(float4*)(MP + j) = a0; *(float4*)(MP + NMOD + j) = a1; *(float4*)(MP + 2 * NMOD + j) = a2;
    } else {
      float2* rcs = (float2*)(p.ws + O_RCS);
      float2* mcs = (float2*)(p.ws + O_MCS);
      for (int idx = tid; idx < 256 * 16; idx += 256) {
        int pos = idx >> 4, i = idx & 15;
        float inv = powf(10000.f, -(float)i / 16.f);
        float ang = (float)pos * inv;
        double t = (double)ang * 0.15915494309189535; t -= floor(t);
        float rr = (float)(t * 6.283185307179586);
        rcs[idx] = make_float2(__cosf(rr), __sinf(rr));
      }
      for (int idx = tid; idx < 256 * 8; idx += 256) {
        int pos = idx >> 3, i = idx & 7;
        float inv = powf(10000.f, -(float)i / 8.f);
        float ang = (float)pos * inv;
        double t = (double)ang * 0.15915494309189535; t -= floor(t);
        float rr = (float)(t * 6.283185307179586);
        mcs[idx] = make_float2(__cosf(rr), __sinf(rr));
      }
    }
  }
}
DEV void ph_ada_reduce(const Prm& p) {
  for (int idx = VBX * 256 + otid(); idx < 2 * 3 * NMOD; idx += VGX * 256) {
    int L = idx / (3 * NMOD), j = idx % NMOD;
    float s = p.in[I_BADA][L * NMOD + j];
    for (int ks = 0; ks < 16; ks++) {
      int r = (idx / NMOD) % 3;
      s += WS_F(O_MODP)[((size_t)(ks * 2 + L) * 3 + r) * NMOD + j];
    }
    WS_F(O_MOD)[idx] = s;
  }
}

DEV void transpose_tile(const float* __restrict__ src, int lds, int N, int k0, int n0, bfr* __restrict__ dst,
                        int ldd, int mode, const float* gain, float* sT) {
  const int tx = otid() & 63, ty = otid() >> 6;
  __syncthreads();
#pragma unroll
  for (int i = 0; i < 16; i++) {
    int k = k0 + ty + 4 * i, n = n0 + tx;
    float v = 0.f;
    if (n < N) { v = src[(size_t)k * lds + n]; if (gain) v *= gain[k]; }
    sT[(ty + 4 * i) * 65 + tx] = v;
  }
  __syncthreads();
#pragma unroll
  for (int i = 0; i < 16; i++) {
    int n = n0 + ty + 4 * i;
    if (n < N) {
      int dr = n;
      if (mode == 1) { int j = n < FFN ? n : n - FFN; dr = (j >> 5) * 64 + (n < FFN ? 0 : 32) + (j & 31); }
      if (mode == 2) { int hd = n >> 7, j = n & 127; dr = j < 64 ? hd * 64 + j : 512 + hd * 64 + (j - 64); }
      dst[(size_t)dr * ldd + k0 + tx] = f2bf(sT[tx * 65 + ty + 4 * i]);
    }
  }
}
DEV void ph_convert(const Prm& p, int L, char* smem) {
  float* sT = (float*)smem;
  constexpr int T0 = 16 * 139, T1 = T0 + 512, T2 = T1 + 256, T3 = T2 + 16 * 88, T4 = T3 + 44 * 16, T5 = T4 + 72,
                T6 = T5 + 64;
  for (int it = VBX; it < T6; it += VGX) {
    if (it < T0) {
      int kt = it % 16, nt = it / 16;
      transpose_tile(p.in[I_WIN] + (size_t)L * D * NIN, NIN, NIN, kt * 64, nt * 64, WS_B(O_WTIN), D, 0, nullptr, sT);
    } else if (it < T1) {
      int q = it - T0, i = q / 128, r = q % 128, kt = r % 8, nt = r / 8;
      transpose_tile(p.in[I_WBR] + ((size_t)L * 4 + i) * 512 * D, D, D, kt * 64, nt * 64,
                     WS_B(O_WTBR) + (size_t)i * D * 512, 512, 0, nullptr, sT);
    } else if (it < T2) {
      int q = it - T1, kt = q % 16, nt = q / 16;
      transpose_tile(p.in[I_WOUT] + (size_t)L * D * D, D, D, kt * 64, nt * 64, WS_B(O_WTOUT), D, 0, nullptr, sT);
    } else if (it < T3) {
      int q = it - T2, kt = q % 16, nt = q / 16;
      transpose_tile(p.in[I_WF1] + (size_t)L * D * 2 * FFN, 2 * FFN, 2 * FFN, kt * 64, nt * 64, WS_B(O_WTF1), D, 1,
                     nullptr, sT);
    } else if (it < T4) {
      int q = it - T3, kt = q % 44, nt = q / 44;
      transpose_tile(p.in[I_WF2] + (size_t)L * FFN * D, D, D, kt * 64, nt * 64, WS_B(O_WTF2), FFN, 0, nullptr, sT);
    } else if (it < T5) {
      int q = it - T4, kt = q % 6, nt = q / 6;
      transpose_tile(p.in[I_WUQ] + (size_t)L * 384 * 768, 768, 768, kt * 64, nt * 64, WS_B(O_WTUQ), 384, 0,
                     p.in[I_QNG] + L * 384, sT);
    } else {
      int q = it - T5, kt = q % 4, nt = q / 4;
      transpose_tile(p.in[I_WUKV] + (size_t)L * 256 * 1024, 1024, 1024, kt * 64, nt * 64, WS_B(O_WTUKV), 256, 2,
                     p.in[I_KVNG] + L * 256, sT);
    }
  }
}

DEV void ph_norm(const Prm& p, int L, int b, int which) {
  const int lane = otid() & 63, wid = otid() >> 6;
  const float* g = p.in[which ? I_N2G : I_N1G] + L * D;
  const int shift = which ? 3 : 0, scale = which ? 4 : 1;
  const int it0 = (which && L == 1) ? CTX / 4 : 0;
  for (int it = VBX + it0; it < ROWS / 4; it += 2 * VGX) {
    const bool hasB = it + VGX < ROWS / 4;
    const int rA = it * 4 + wid, rB = hasB ? (it + VGX) * 4 + wid : rA;
    const float* xA = which ? (const float*)res_dst(p, b, rA) : res_src(p, L, b, rA);
    const float* xB = which ? (const float*)res_dst(p, b, rB) : res_src(p, L, b, rB);
    float4 vA[4], vB[4]; float sA = 0.f, sB = 0.f;
#pragma unroll
    for (int i = 0; i < 4; i++) { vA[i] = *(const float4*)(xA + lane * 4 + 256 * i); vB[i] = *(const float4*)(xB + lane * 4 + 256 * i); }
#pragma unroll
    for (int i = 0; i < 4; i++) {
      sA += vA[i].x * vA[i].x + vA[i].y * vA[i].y + vA[i].z * vA[i].z + vA[i].w * vA[i].w;
      sB += vB[i].x * vB[i].x + vB[i].y * vB[i].y + vB[i].z * vB[i].z + vB[i].w * vB[i].w;
    }
    sA = wave_sum(sA); sB = wave_sum(sB);
    const float rsA = rsqrtf(sA * (1.f / D) + EPS), rsB = rsqrtf(sB * (1.f / D) + EPS);
    const float* mdA = WS_F(O_MOD) + (size_t)(L * 3 + (rA < CTX ? 2 : b)) * NMOD;
    const float* mdB = WS_F(O_MOD) + (size_t)(L * 3 + (rB < CTX ? 2 : b)) * NMOD;
    bfr* hA = WS_B(O_H) + (size_t)rA * D;
    bfr* hB = WS_B(O_H) + (size_t)rB * D;
#pragma unroll
    for (int i = 0; i < 4; i++) {
      int c = lane * 4 + 256 * i;
      float4 gg = *(const float4*)(g + c);
      float4 scA = *(const float4*)(mdA + scale * D + c), shA = *(const float4*)(mdA + shift * D + c);
      float4 scB = *(const float4*)(mdB + scale * D + c), shB = *(const float4*)(mdB + shift * D + c);
      *(uint2*)(hA + c) = pack4(vA[i].x * rsA * gg.x * (1.f + scA.x) + shA.x, vA[i].y * rsA * gg.y * (1.f + scA.y) + shA.y,
                                vA[i].z * rsA * gg.z * (1.f + scA.z) + shA.z, vA[i].w * rsA * gg.w * (1.f + scA.w) + shA.w);
      if (hasB)
        *(uint2*)(hB + c) = pack4(vB[i].x * rsB * gg.x * (1.f + scB.x) + shB.x, vB[i].y * rsB * gg.y * (1.f + scB.y) + shB.y,
                                  vB[i].z * rsB * gg.z * (1.f + scB.z) + shB.z, vB[i].w * rsB * gg.w * (1.f + scB.w) + shB.w);
    }
  }
}
DEV void ph_final_norm(const Prm& p, int b) {
  const int lane = otid() & 63, wid = otid() >> 6;
  const float* g = p.in[I_FNG];
  for (int it = VBX; it < SEQ / 4; it += VGX) {
    float* xr = p.out + ((size_t)b * SEQ + it * 4 + wid) * D;
    float4 v[4]; float ss = 0.f;
#pragma unroll
    for (int i = 0; i < 4; i++) {
      v[i] = *(const float4*)(xr + lane * 4 + 256 * i);
      ss += v[i].x * v[i].x + v[i].y * v[i].y + v[i].z * v[i].z + v[i].w * v[i].w;
    }
    ss = wave_sum(ss);
    float rstd = rsqrtf(ss * (1.f / D) + EPS);
#pragma unroll
    for (int i = 0; i < 4; i++) {
      int c = lane * 4 + 256 * i;
      float4 gg = *(const float4*)(g + c);
      float4 o = {v[i].x * rstd * gg.x, v[i].y * rstd * gg.y, v[i].z * rstd * gg.z, v[i].w * rstd * gg.w};
      *(float4*)(xr + c) = o;
    }
  }
}

#define TILE_IDS                                                                   \
  int tid_ = otid();                           \
  const int tid = tid_, lane = tid & 63, wid = tid >> 6, l15 = lane & 15, quad = lane >> 4, \
            wm = wid >> 1, wn = wid & 1;                                           \
  (void)wm; (void)wn; (void)l15; (void)quad;

#define TILE_IDS3                                                                  \
  const int tid = rtid(), lane = tid & 63, wid = tid >> 6, l15 = lane & 15, quad = lane >> 4, \
            wm = wid >> 2, wn = wid & 3;                                           \
  (void)wm; (void)wn; (void)l15; (void)quad;
DEV void ph_inproj(const Prm& p, char* smem) {
  TILE_IDS3
  constexpr int NT = 19, MT = ROWS / 256;
  const bfr* g_pa = nullptr; const bfr* g_pb = nullptr; uint4 g_pa0{}, g_pa1{}, g_pb0{}, g_pb1{}, g_qa0{}, g_qa1{}, g_qb0{}, g_qb1{}; bool first = true;
  for (int rd = 0; rd * (int)gridDim.x < MT * NT; rd++) {
    int mt, nt; if (!tile_remap(rd, MT, NT, mt, nt, blockIdx.x, gridDim.x, false)) continue;
    int m0 = mt * 256, n0 = nt * 256;
    int mt2, nt2; const bool hasn = tile_remap(rd + 1, MT, NT, mt2, nt2, blockIdx.x, gridDim.x, false);
    if (!hasn) { mt2 = mt; nt2 = nt; }
    f32x4 acc[8][4]; zero_acc84(acc);
    gemm3_mainloop(WS_B(O_H) + (size_t)m0 * D, D, WS_B(O_WTIN) + (size_t)n0 * D, D, D, acc, smem,
                   WS_B(O_H) + (size_t)(mt2 * 256) * D, WS_B(O_WTIN) + (size_t)(nt2 * 256) * D, first, g_pa, g_pb, g_pa0, g_pa1, g_pb0, g_pb1, g_qa0, g_qa1, g_qb0, g_qb1);
    first = !hasn;
#pragma unroll
    for (int mi = 0; mi < 8; mi++)
#pragma unroll
      for (int ni = 0; ni < 4; ni++) {
        int row = m0 + wm * 128 + mi * 16 + l15, col = n0 + wn * 64 + ni * 16 + quad * 4;
        if (col < NU) *(uint2*)(WS_B(O_U) + (size_t)row * NU + col) = pack4(acc[mi][ni][0], acc[mi][ni][1], acc[mi][ni][2], acc[mi][ni][3]);
      }
  }
}
DEV void ph_gates(const Prm& p, int L, char* smem) {
  TILE_IDS3
  constexpr int NT = 16;
  const int mt0 = L == 1 ? 1 : 0, MT = ROWS / 256 - mt0;
  const bfr* g_pa = nullptr; const bfr* g_pb = nullptr; uint4 g_pa0{}, g_pa1{}, g_pb0{}, g_pb1{}, g_qa0{}, g_qa1{}, g_qb0{}, g_qb1{}; bool first = true;
  for (int rd = 0; rd * (int)gridDim.x < MT * NT; rd++) {
    int mt, nt; if (!tile_remap(rd, MT, NT, mt, nt, blockIdx.x, gridDim.x, false)) continue;
    mt += mt0; int m0 = mt * 256, n0 = nt * 256;
    int mt2, nt2; const bool hasn = tile_remap(rd + 1, MT, NT, mt2, nt2, blockIdx.x, gridDim.x, false);
    if (hasn) mt2 += mt0; else { mt2 = mt; nt2 = nt; }
    f32x4 acc[8][4]; zero_acc84(acc);
    gemm3_mainloop(WS_B(O_H) + (size_t)m0 * D, D, WS_B(O_WTIN) + (size_t)(NU + n0) * D, D, D, acc, smem,
                   WS_B(O_H) + (size_t)(mt2 * 256) * D, WS_B(O_WTIN) + (size_t)(NU + nt2 * 256) * D, first, g_pa, g_pb, g_pa0, g_pa1, g_pb0, g_pb1, g_qa0, g_qa1, g_qb0, g_qb1);
    first = !hasn;
#pragma unroll
    for (int mi = 0; mi < 8; mi++)
#pragma unroll
      for (int ni = 0; ni < 4; ni++) {
        int row = m0 + wm * 128 + mi * 16 + l15, col = n0 + wn * 64 + ni * 16 + quad * 4;
        *(uint2*)(WS_B(O_U) + (size_t)row * 4096 + col) =
            pack4(sigm_f(acc[mi][ni][0]), sigm_f(acc[mi][ni][1]), sigm_f(acc[mi][ni][2]), sigm_f(acc[mi][ni][3]));
      }
  }
}
DEV void ph_merge(const Prm& p, int L, char* smem) {
  TILE_IDS
  const int mt0 = L == 1 ? 2 : 0;
  const bfr* g_pa = nullptr; const bfr* g_pb = nullptr; uint4 g_a0{}, g_a1{}, g_b0{}, g_b1{}, g_c0{}, g_c1{}, g_d0{}, g_d1{}; bool first = true;
  const int NT_ = (NCH - mt0) * 8;
  for (int rd = 0; rd * (int)VGX < NT_; rd++) {
    int mt, nt; tile_remap(rd, NCH - mt0, 8, mt, nt, VBX, VGX, true);
    mt += mt0; int m0 = mt * 128, n0 = nt * 128;
    const bool hasn = (rd + 1) * (int)VGX < NT_;
    int mt2 = mt, nt2 = nt; if (hasn) { tile_remap(rd + 1, NCH - mt0, 8, mt2, nt2, VBX, VGX, true); mt2 += mt0; }
    f32x4 macc[4][4]; zero_acc44(macc);
#pragma unroll 1
    for (int i = 0; i < 4; i++) {
      f32x4 acc[4][4]; zero_acc44(acc);
      const bool lastb = i == 3;
      const bfr* nA_ = lastb ? WS_B(O_BR) + (size_t)(mt2 * 128) * 2048 : WS_B(O_BR) + (size_t)m0 * 2048 + (i + 1) * 512;
      const bfr* nB_ = lastb ? WS_B(O_WTBR) + (size_t)(nt2 * 128) * 512 : WS_B(O_WTBR) + ((size_t)(i + 1) * D + n0) * 512;
      gemm4_mainloop(WS_B(O_BR) + (size_t)m0 * 2048 + i * 512, 2048, WS_B(O_WTBR) + ((size_t)i * D + n0) * 512, 512, 512, acc, smem,
                     nA_, nB_, first, g_pa, g_pb, g_a0, g_a1, g_b0, g_b1, g_c0, g_c1, g_d0, g_d1);
      first = lastb && !hasn;
#pragma unroll
      for (int mi = 0; mi < 4; mi++)
#pragma unroll
        for (int ni = 0; ni < 4; ni++) {
          int row = m0 + wm * 64 + mi * 16 + l15, col = n0 + wn * 64 + ni * 16 + quad * 4;
          uint2 gv = *(const uint2*)(WS_B(O_U) + (size_t)row * 4096 + i * D + col);
          float gf[4]; unpack4(gv, gf);
#pragma unroll
          for (int r = 0; r < 4; r++) macc[mi][ni][r] += gf[r] * acc[mi][ni][r];
        }
    }
#pragma unroll
    for (int mi = 0; mi < 4; mi++)
#pragma unroll
      for (int ni = 0; ni < 4; ni++) {
        int row = m0 + wm * 64 + mi * 16 + l15, col = n0 + wn * 64 + ni * 16 + quad * 4;
        *(uint2*)(WS_B(O_H) + (size_t)row * D + col) = pack4(macc[mi][ni][0], macc[mi][ni][1], macc[mi][ni][2], macc[mi][ni][3]);
      }
  }
}
DEV void ph_resgemm(const Prm& p, int L, int b, const bfr* A, int lda, const bfr* Wt, int K, int gate_idx,
                    bool from_src, char* smem) {
  TILE_IDS3
  const int mt0 = L == 1 ? 1 : 0, MT = ROWS / 256 - mt0;
  const bfr* g_pa = nullptr; const bfr* g_pb = nullptr; uint4 g_pa0{}, g_pa1{}, g_pb0{}, g_pb1{}, g_qa0{}, g_qa1{}, g_qb0{}, g_qb1{}; bool first = true;
  for (int rd = 0; rd * (int)gridDim.x < MT * 4; rd++) {
    int mt, nt; if (!tile_remap(rd, MT, 4, mt, nt, blockIdx.x, gridDim.x, false)) continue;
    mt += mt0; int m0 = mt * 256, n0 = nt * 256;
    int mt2, nt2; const bool hasn = tile_remap(rd + 1, MT, 4, mt2, nt2, blockIdx.x, gridDim.x, false);
    if (hasn) mt2 += mt0; else { mt2 = mt; nt2 = nt; }
    f32x4 acc[8][4]; zero_acc84(acc);
    gemm3_mainloop(A + (size_t)m0 * lda, lda, Wt + (size_t)n0 * K, K, K, acc, smem,
                   A + (size_t)(mt2 * 256) * lda, Wt + (size_t)(nt2 * 256) * K, first, g_pa, g_pb, g_pa0, g_pa1, g_pb0, g_pb1, g_qa0, g_qa1, g_qb0, g_qb1);
    first = !hasn;
#pragma unroll
    for (int mi = 0; mi < 8; mi++) {
      int row = m0 + wm * 128 + mi * 16 + l15;
      const float* rs = from_src ? res_src(p, L, b, row) : (const float*)res_dst(p, b, row);
      float* rd = res_dst(p, b, row);
      const float* md = WS_F(O_MOD) + (size_t)(L * 3 + (row < CTX ? 2 : b)) * NMOD + gate_idx * D;
#pragma unroll
      for (int ni = 0; ni < 4; ni++) {
        int col = n0 + wn * 64 + ni * 16 + quad * 4;
        float4 x = *(const float4*)(rs + col), g = *(const float4*)(md + col);
        float4 o = {x.x + g.x * acc[mi][ni][0], x.y + g.y * acc[mi][ni][1], x.z + g.z * acc[mi][ni][2], x.w + g.w * acc[mi][ni][3]};
        *(float4*)(rd + col) = o;
      }
    }
  }
}
DEV void ph_ffn1(const Prm& p, int L, char* smem) {
  TILE_IDS3
  constexpr int NT = 22;
  const int mt0 = L == 1 ? 1 : 0, MT = ROWS / 256 - mt0;
  const bfr* g_pa = nullptr; const bfr* g_pb = nullptr; uint4 g_pa0{}, g_pa1{}, g_pb0{}, g_pb1{}, g_qa0{}, g_qa1{}, g_qb0{}, g_qb1{}; bool first = true;
  for (int rd = 0; rd * (int)gridDim.x < MT * NT; rd++) {
    int mt, nt; if (!tile_remap(rd, MT, NT, mt, nt, blockIdx.x, gridDim.x, false)) continue;
    mt += mt0; int m0 = mt * 256, n0 = nt * 256;
    int mt2, nt2; const bool hasn = tile_remap(rd + 1, MT, NT, mt2, nt2, blockIdx.x, gridDim.x, false);
    if (hasn) mt2 += mt0; else { mt2 = mt; nt2 = nt; }
    f32x4 acc[8][4]; zero_acc84(acc);
    gemm3_mainloop(WS_B(O_H) + (size_t)m0 * D, D, WS_B(O_WTF1) + (size_t)n0 * D, D, D, acc, smem,
                   WS_B(O_H) + (size_t)(mt2 * 256) * D, WS_B(O_WTF1) + (size_t)(nt2 * 256) * D, first, g_pa, g_pb, g_pa0, g_pa1, g_pb0, g_pb1, g_qa0, g_qa1, g_qb0, g_qb1);
    first = !hasn;
    int j0 = ((n0 + wn * 64) >> 6) * 32;
#pragma unroll
    for (int mi = 0; mi < 8; mi++)
#pragma unroll
      for (int ni = 0; ni < 2; ni++) {
        int row = m0 + wm * 128 + mi * 16 + l15, col = j0 + ni * 16 + quad * 4;
        float f[4];
#pragma unroll
        for (int r = 0; r < 4; r++) f[r] = silu_f(acc[mi][ni + 2][r]) * acc[mi][ni][r];
        *(uint2*)(WS_B(O_U) + (size_t)row * FFN + col) = pack4(f[0], f[1], f[2], f[3]);
      }
  }
}

DEV void conv_module_item(const Prm& p, int L, int grp, char* smem) {
  const int tid = otid(), lane = tid & 63, wid = tid >> 6;
  unsigned* sG = (unsigned*)smem;
  float* sR = (float*)(smem + 47104);
  const int t0 = grp * 16, seg0 = t0 < CTX ? 0 : CTX, seg1 = t0 < CTX ? CTX : ROWS;
  const int c = tid * 2;
  const bfr* U_ = WS_B(O_U);
  __syncthreads();
#pragma unroll 8
  for (int rr = 0; rr < 46; rr++) {
    const int r = t0 - 15 + rr, rc = min(max(r, seg0), seg1 - 1);
    const unsigned aa = *(const unsigned*)(U_ + (size_t)rc * NU + c), gg = *(const unsigned*)(U_ + (size_t)rc * NU + 512 + c);
    const unsigned v = pack2(lo16(aa) * sigm_f(lo16(gg)), hi16(aa) * sigm_f(hi16(gg)));
    sG[rr * 256 + tid] = (r == rc) ? v : 0u;
  }
  __syncthreads();
  const float* cw = p.in[I_CONVW] + (size_t)L * 31 * 512 + c;
  float2 cb = *(const float2*)(p.in[I_CONVB] + L * 512 + c);
  float a0[16], a1[16];
#pragma unroll
  for (int o = 0; o < 16; o++) { a0[o] = cb.x; a1[o] = cb.y; }
  float2 wj[31];
#pragma unroll
  for (int j = 0; j < 31; j++) wj[j] = *(const float2*)(cw + j * 512);
#pragma unroll
  for (int j = 0; j < 31; j++) {
    const float2 w = wj[j];
#pragma unroll
    for (int o = 0; o < 16; o++) {
      unsigned vv = sG[(o + j) * 256 + tid];
      a0[o] += w.x * lo16(vv); a1[o] += w.y * hi16(vv);
    }
  }
  float mu[16], rs[16];
#pragma unroll
  for (int o = 0; o < 16; o++) { float s = wave_sum(a0[o] + a1[o]); if (lane == 0) sR[wid * 16 + o] = s; }
  __syncthreads();
#pragma unroll
  for (int o = 0; o < 16; o++) mu[o] = (sR[o] + sR[16 + o] + sR[32 + o] + sR[48 + o]) * (1.f / 512.f);
  __syncthreads();
#pragma unroll
  for (int o = 0; o < 16; o++) {
    float d0 = a0[o] - mu[o], d1 = a1[o] - mu[o];
    float s = wave_sum(d0 * d0 + d1 * d1);
    if (lane == 0) sR[wid * 16 + o] = s;
  }
  __syncthreads();
#pragma unroll
  for (int o = 0; o < 16; o++) rs[o] = rsqrtf((sR[o] + sR[16 + o] + sR[32 + o] + sR[48 + o]) * (1.f / 512.f) + EPS);
  float2 lg = *(const float2*)(p.in[I_CLNG] + L * 512 + c), lb = *(const float2*)(p.in[I_CLNB] + L * 512 + c);
#pragma unroll
  for (int o = 0; o < 16; o++) {
    float y0 = (a0[o] - mu[o]) * rs[o] * lg.x + lb.x, y1 = (a1[o] - mu[o]) * rs[o] * lg.y + lb.y;
    *(unsigned*)(WS_B(O_BR) + (size_t)(t0 + o) * 2048 + c) = pack2(silu_f(y0), silu_f(y1));
  }
}
DEV void xbc_conv_item(const Prm& p, int L, int grp) {
  const int tid = otid();
  const int t0 = grp * 16, seg0 = t0 < CTX ? 0 : CTX, seg1 = t0 < CTX ? CTX : ROWS;
  const int c = tid * 4;
  float4 w[5];
#pragma unroll
  for (int j = 0; j < 5; j++) w[j] = *(const float4*)(p.in[I_SCW] + ((size_t)L * 5 + j) * 1024 + c);
  float4 bb = *(const float4*)(p.in[I_SCB] + L * 1024 + c);
  float4 a[16];
#pragma unroll
  for (int o = 0; o < 16; o++) a[o] = bb;
  const bfr* U_ = WS_B(O_U);
#pragma unroll
  for (int ii = 0; ii < 20; ii++) {
    const int r = t0 - 2 + ii, rc = min(max(r, seg0), seg1 - 1);
    float v[4];
    { uint2 t = *(const uint2*)(U_ + (size_t)rc * NU + C_XBC + c); if (r != rc) { t.x = 0u; t.y = 0u; } unpack4(t, v); }
#pragma unroll
    for (int o = 0; o < 16; o++) {
      if (ii - o >= 0 && ii - o <= 4) {
        a[o].x += w[ii - o].x * v[0]; a[o].y += w[ii - o].y * v[1]; a[o].z += w[ii - o].z * v[2]; a[o].w += w[ii - o].w * v[3];
      }
    }
  }
#pragma unroll
  for (int o = 0; o < 16; o++)
    *(uint2*)(WS_B(O_XBC) + (size_t)(t0 + o) * 1024 + c) = pack4(silu_f(a[o].x), silu_f(a[o].y), silu_f(a[o].z), silu_f(a[o].w));
}
DEV void mla_pre_item(const Prm& p, int it) {
  const int lane = otid() & 63, wid = otid() >> 6;
  const bfr* U_ = WS_B(O_U);
  const float2* mcs = (const float2*)(p.ws + O_MCS);
#pragma unroll 4
  for (int rr = 0; rr < 16; rr++) {
    int r = it * 64 + wid * 16 + rr;
    const bfr* ur = U_ + (size_t)r * NU;
    float sq = 0.f, sk = 0.f;
#pragma unroll
    for (int i = 0; i < 3; i++) { unsigned t = *(const unsigned*)(ur + C_CQ + lane * 2 + 128 * i); float x = lo16(t), y = hi16(t); sq += x * x + y * y; }
    { uint2 t = *(const uint2*)(ur + C_CKV + lane * 4); float f[4]; unpack4(t, f); sk = f[0] * f[0] + f[1] * f[1] + f[2] * f[2] + f[3] * f[3]; }
    sq = wave_sum(sq); sk = wave_sum(sk);
    if (lane == 0) { WS_F(O_RSQ)[r] = rsqrtf(sq * (1.f / 384.f) + EPS); WS_F(O_RSKV)[r] = rsqrtf(sk * (1.f / 256.f) + EPS); }
    if (lane < 16) {
      float x1 = bf2f(ur[C_KR + lane]), x2 = bf2f(ur[C_KR + 16 + lane]);
      float o1 = x1, o2 = x2;
      if (r >= CTX) {
        int t = r - CTX, pos = lane < 8 ? (t >> 6) : (t & 63);
        float2 cs = mcs[pos * 8 + (lane & 7)];
        o1 = x1 * cs.x - x2 * cs.y; o2 = x1 * cs.y + x2 * cs.x;
      }
      WS_B(O_KROPE)[(size_t)r * 32 + lane] = f2bf(o1);
      WS_B(O_KROPE)[(size_t)r * 32 + 16 + lane] = f2bf(o2);
    }
  }
}
DEV void ph_local(const Prm& p, int L, char* smem) {
  constexpr int NG = ROWS / 16;
  for (int it = VBX; it < 2 * NG + 260; it += VGX) {
#ifdef ONLY2
    it = ONLY2 == 0 ? 0 : ONLY2 == 1 ? NG : 2 * NG;
#endif
    if (it < NG) conv_module_item(p, L, it, smem);
    else if (it < 2 * NG) xbc_conv_item(p, L, it - NG);
    else mla_pre_item(p, it - 2 * NG);
  }
}

DEV void uq_tile(const Prm& p, int it, char* smem) {
  TILE_IDS
  int mt = it / 6, nt = it % 6, m0 = mt * 128, n0 = nt * 128;
  f32x4 acc[4][4]; zero_acc44(acc);
  gemm4_single(WS_B(O_U) + (size_t)m0 * NU + C_CQ, NU, WS_B(O_WTUQ) + (size_t)n0 * 384, 384, 384, acc, smem);
#pragma unroll
  for (int mi = 0; mi < 4; mi++) {
    int row = m0 + wm * 64 + mi * 16 + l15;
    float rs = WS_F(O_RSQ)[row];
#pragma unroll
    for (int ni = 0; ni < 4; ni++) {
      int col = n0 + wn * 64 + ni * 16 + quad * 4;
      *(uint2*)(WS_B(O_Q) + (size_t)row * 768 + col) = pack4(rs * acc[mi][ni][0], rs * acc[mi][ni][1], rs * acc[mi][ni][2], rs * acc[mi][ni][3]);
    }
  }
}
DEV void ukn_tile(const Prm& p, int it, char* smem) {
  TILE_IDS
  int mt = it / 4, nt = it % 4, m0 = mt * 128, n0 = nt * 128;
  f32x4 acc[4][4]; zero_acc44(acc);
  gemm4_single(WS_B(O_U) + (size_t)m0 * NU + C_CKV, NU, WS_B(O_WTUKV) + (size_t)n0 * 256, 256, 256, acc, smem);
#pragma unroll
  for (int mi = 0; mi < 4; mi++) {
    int row = m0 + wm * 64 + mi * 16 + l15;
    float rs = WS_F(O_RSKV)[row];
#pragma unroll
    for (int ni = 0; ni < 4; ni++) {
      int col = n0 + wn * 64 + ni * 16 + quad * 4;
      *(uint2*)(WS_B(O_KN) + (size_t)row * 512 + col) = pack4(rs * acc[mi][ni][0], rs * acc[mi][ni][1], rs * acc[mi][ni][2], rs * acc[mi][ni][3]);
    }
  }
}
DEV void uvt_tile(const Prm& p, int it, char* smem) {
  TILE_IDS
  int vt = it / NCH, tt = it % NCH, m0 = vt * 128, n0 = tt * 128;
  f32x4 acc[4][4]; zero_acc44(acc);
  gemm4_single(WS_B(O_WTUKV) + (size_t)(512 + m0) * 256, 256, WS_B(O_U) + (size_t)n0 * NU + C_CKV, NU, 256, acc, smem);
#pragma unroll
  for (int ni = 0; ni < 4; ni++) {
    int tok = n0 + wn * 64 + ni * 16 + quad * 4;
    float4 rs = *(const float4*)(WS_F(O_RSKV) + tok);
#pragma unroll
    for (int mi = 0; mi < 4; mi++) {
      int vrow = m0 + wm * 64 + mi * 16 + l15;
      *(uint2*)(WS_B(O_VT) + (size_t)vrow * ROWS + tok) = pack4(rs.x * acc[mi][ni][0], rs.y * acc[mi][ni][1], rs.z * acc[mi][ni][2], rs.w * acc[mi][ni][3]);
    }
  }
}

DEV void chunk_decay(const Prm& p, int L, float raw, int h, float* sCum, float* sDt, float* sTmp) {
  const int tid = otid(), dir = tid >> 7, i = tid & 127, l = dir ? 127 - i : i;
  float dt = softplus_f(raw + p.in[I_DTB][L * 16 + dir * 8 + h]);
  float v = -dt * expf(p.in[I_ALOG][L * 16 + dir * 8 + h]);
#pragma unroll
  for (int o = 1; o < 64; o <<= 1) { float t = __shfl_up(v, o); if ((tid & 63) >= o) v += t; }
  if ((tid & 63) == 63) sTmp[tid >> 6] = v;
  __syncthreads();
  if (tid & 64) v += sTmp[(tid >> 6) - 1];
  sCum[dir * 128 + l] = v; sDt[dir * 128 + l] = dt;
  __syncthreads();
}

DEV void ssm_state_item(const Prm& p, int L, int it, char* smem) {
  TILE_IDS
  bfr* sBT = (bfr*)smem;
  bfr* sXT = sBT + 128 * 136;
  float* sCum = (float*)(smem + 52224); float* sDt = sCum + 256; float* sTmp = sDt + 256;
  const int c = it >> 2, g = (it >> 1) & 1, hp = it & 1, r0 = c * 128;
  const bfr* X_ = WS_B(O_XBC);
  unsigned rawp;
  { const int dir_ = tid >> 7, i_ = tid & 127, l_ = dir_ ? 127 - i_ : i_;
    rawp = *(const unsigned*)(WS_B(O_U) + (size_t)(r0 + l_) * NU + C_DT + dir_ * 8 + g * 4 + hp * 2); }
  __syncthreads();
#pragma unroll 4
  for (int u = tid; u < 1024; u += 256) {
    int lp = u & 63, nc = u >> 6;
    const bfr* src = X_ + (size_t)(r0 + 2 * lp) * 1024 + 512 + g * 128 + nc * 8;
    uint4 a = *(const uint4*)src, b2 = *(const uint4*)(src + 1024);
#pragma unroll
    for (int e = 0; e < 8; e++) *(unsigned*)(sBT + (nc * 8 + e) * 136 + 2 * lp) = elem16(a, e) | (elem16(b2, e) << 16);
  }
  for (int hh = 0; hh < 2; hh++) {
    const int h = g * 4 + hp * 2 + hh;
    uint4 xs0, xs1, xs2, xs3;
    { const bfr* s0_ = X_ + (size_t)(r0 + 2 * (tid & 63)) * 1024 + h * 64 + (tid >> 6) * 8;
      xs0 = *(const uint4*)s0_; xs1 = *(const uint4*)(s0_ + 1024); xs2 = *(const uint4*)(s0_ + 32); xs3 = *(const uint4*)(s0_ + 1024 + 32); }
    chunk_decay(p, L, hh ? hi16(rawp) : lo16(rawp), h, sCum, sDt, sTmp);
    const float totf = sCum[127], totb = sCum[128];
    if (tid == 0) { WS_F(O_TOT)[(0 * NCH + c) * 8 + h] = __expf(totf); WS_F(O_TOT)[(1 * NCH + c) * 8 + h] = __expf(totb); }
    for (int dir = 0; dir < 2; dir++) {
      const float tot = dir ? totb : totf;
      {
        const int lp = tid & 63, pc = tid >> 6, l0 = 2 * lp;
        float w0 = __expf(tot - sCum[dir * 128 + l0]) * sDt[dir * 128 + l0];
        float w1 = __expf(tot - sCum[dir * 128 + l0 + 1]) * sDt[dir * 128 + l0 + 1];
        float fa[8], fb[8], fc[8], fd[8]; unpack8(xs0, fa); unpack8(xs1, fb); unpack8(xs2, fc); unpack8(xs3, fd);
#pragma unroll
        for (int e = 0; e < 8; e++) {
          *(unsigned*)(sXT + (pc * 8 + e) * 136 + l0) = pack2(fa[e] * w0, fb[e] * w1);
          *(unsigned*)(sXT + ((pc + 4) * 8 + e) * 136 + l0) = pack2(fc[e] * w0, fd[e] * w1);
        }
      }
      __syncthreads();
      f32x4 acc[4][2];
#pragma unroll
      for (int i = 0; i < 4; i++) { acc[i][0] = f32x4{0, 0, 0, 0}; acc[i][1] = f32x4{0, 0, 0, 0}; }
      lds_gemm<4, 2, 4>(sXT, 136, sBT + (wid * 32) * 136, 136, acc);
      float* dst = WS_F(O_SST) + ((size_t)((dir * NCH + c) * 8 + h)) * 8192;
#pragma unroll
      for (int mi = 0; mi < 4; mi++)
#pragma unroll
        for (int ni = 0; ni < 2; ni++) *(f32x4*)(dst + (mi * 16 + l15) * 128 + wid * 32 + ni * 16 + quad * 4) = acc[mi][ni];
      __syncthreads();
    }
  }
}

DEV void ret_rope8(const Prm& p, int r, int nc, const uint4& c1, const uint4& c2, float scale, float (&o1)[8], float (&o2)[8]) {
  float x1[8], x2[8]; unpack8(c1, x1); unpack8(c2, x2);
  if (r >= CTX) {
    const float2* rcs = (const float2*)(p.ws + O_RCS);
    int t = r - CTX, pos = nc < 2 ? (t >> 6) : (t & 63);
    const float2* cs = rcs + pos * 16 + (nc & 1) * 8;
#pragma unroll
    for (int e = 0; e < 8; e++) { float2 v = cs[e]; o1[e] = (x1[e] * v.x - x2[e] * v.y) * scale; o2[e] = (x1[e] * v.y + x2[e] * v.x) * scale; }
  } else {
#pragma unroll
    for (int e = 0; e < 8; e++) { o1[e] = x1[e] * scale; o2[e] = x2[e] * scale; }
  }
}

DEV void ret_state_item(const Prm& p, int L, int it, char* smem) {
  TILE_IDS
  bfr* sVT = (bfr*)smem;
  bfr* sKT = sVT + 128 * 136;
  const int c = it >> 2, h = it & 3, r0 = c * 128;
  const bfr* U_ = WS_B(O_U);
  const float lgf = -expf(p.in[I_RDEC][L * 8 + h]), lgb = -expf(p.in[I_RDEC][L * 8 + 4 + h]);
  __syncthreads();
#pragma unroll 4
  for (int u = tid; u < 1024; u += 256) {
    int lp = u & 63, pc = u >> 6;
    const bfr* src = U_ + (size_t)(r0 + 2 * lp) * NU + C_RV + h * 128 + pc * 8;
    uint4 a = *(const uint4*)src, b2 = *(const uint4*)(src + NU);
#pragma unroll
    for (int e = 0; e < 8; e++) *(unsigned*)(sVT + (pc * 8 + e) * 136 + 2 * lp) = elem16(a, e) | (elem16(b2, e) << 16);
  }
  uint4 a1, a2, b1, b2;
  { const bfr* src = U_ + (size_t)(r0 + 2 * (tid & 63)) * NU + C_RK + h * 64 + (tid >> 6) * 8;
    a1 = *(const uint4*)src; a2 = *(const uint4*)(src + 32); b1 = *(const uint4*)(src + NU); b2 = *(const uint4*)(src + NU + 32); }
  for (int dir = 0; dir < 2; dir++) {
    {
      int lp = tid & 63, nc = tid >> 6, l0 = 2 * lp;
      float w0 = dir ? __expf((float)l0 * lgb) : __expf((float)(127 - l0) * lgf);
      float w1 = dir ? __expf((float)(l0 + 1) * lgb) : __expf((float)(126 - l0) * lgf);
      float p1[8], p2[8], q1[8], q2[8];
      ret_rope8(p, r0 + l0, nc, a1, a2, 0.125f * w0, p1, p2);
      ret_rope8(p, r0 + l0 + 1, nc, b1, b2, 0.125f * w1, q1, q2);
#pragma unroll
      for (int e = 0; e < 8; e++) {
        *(unsigned*)(sKT + (nc * 8 + e) * 136 + l0) = pack2(p1[e], q1[e]);
        *(unsigned*)(sKT + (32 + nc * 8 + e) * 136 + l0) = pack2(p2[e], q2[e]);
      }
    }
    __syncthreads();
    f32x4 acc[2][4];
#pragma unroll
    for (int i = 0; i < 2; i++)
#pragma unroll
      for (int j = 0; j < 4; j++) acc[i][j] = f32x4{0, 0, 0, 0};
    lds_gemm<2, 4, 4>(sVT + (wid * 32) * 136, 136, sKT, 136, acc);
    float* dst = WS_F(O_RST) + ((size_t)((dir * NCH + c) * 4 + h)) * 8192;
#pragma unroll
    for (int mi = 0; mi < 2; mi++)
#pragma unroll
      for (int ni = 0; ni < 4; ni++) *(f32x4*)(dst + (wid * 32 + mi * 16 + l15) * 64 + ni * 16 + quad * 4) = acc[mi][ni];
    __syncthreads();
  }
}
DEV void ph_states(const Prm& p, int L, char* smem) {
  constexpr int N0 = NCH * 6, N1 = N0 + NCH * 8, N2 = N1 + NCH * 4, N3 = N2 + NCH * 4;
  for (int it = VBX; it < N3; it += VGX) {
#ifdef ONLY3
    it = ONLY3 == 0 ? 0 : ONLY3 == 1 ? N0 : ONLY3 == 2 ? N1 : N2;
#endif
    if (it < N0) uq_tile(p, it, smem);
    else if (it < N1) { if (it - N0 < NCH * 4) ukn_tile(p, it - N0, smem); else uvt_tile(p, it - N0 - NCH * 4, smem); }
    else if (it < N2) ssm_state_item(p, L, it - N1, smem);
    else ret_state_item(p, L, it - N2, smem);
  }
}

DEV int chunk_order(int dir, int i) { return dir == 0 ? i : (i < 2 ? 1 - i : 131 - i); }
DEV void ph_scan(const Prm& p, int L) {
  for (int it = VBX; it < 384; it += VGX) {
    if (it < 256) {
      int gid = it * 256 + otid(), dir = gid >> 15, h = (gid >> 12) & 7, e2 = gid & 4095;
      float2 hr = {0, 0};
      for (int i0 = 0; i0 < NCH; i0 += 13) {
        float2 s[13]; float g[13];
#pragma unroll
        for (int j = 0; j < 13; j++) {
          int c = chunk_order(dir, i0 + j);
          s[j] = *(const float2*)(WS_F(O_SST) + ((size_t)((dir * NCH + c) * 8 + h)) * 8192 + e2 * 2);
          g[j] = WS_F(O_TOT)[(dir * NCH + c) * 8 + h];
        }
#pragma unroll
        for (int j = 0; j < 13; j++) {
          int c = chunk_order(dir, i0 + j);
          *(float2*)(WS_F(O_SST) + ((size_t)((dir * NCH + c) * 8 + h)) * 8192 + e2 * 2) = hr;
          hr.x = g[j] * hr.x + s[j].x; hr.y = g[j] * hr.y + s[j].y;
        }
      }
    } else {
      int gid = (it - 256) * 256 + otid(), dir = gid >> 14, h = (gid >> 12) & 3, e2 = gid & 4095;
      const float G = expf(-128.f * expf(p.in[I_RDEC][L * 8 + dir * 4 + h]));
      float2 hr = {0, 0};
      for (int i0 = 0; i0 < NCH; i0 += 13) {
        float2 s[13];
#pragma unroll
        for (int j = 0; j < 13; j++) {
          int c = chunk_order(dir, i0 + j);
          s[j] = *(const float2*)(WS_F(O_RST) + ((size_t)((dir * NCH + c) * 4 + h)) * 8192 + e2 * 2);
        }
#pragma unroll
        for (int j = 0; j < 13; j++) {
          int c = chunk_order(dir, i0 + j);
          *(float2*)(WS_F(O_RST) + ((size_t)((dir * NCH + c) * 4 + h)) * 8192 + e2 * 2) = hr;
          hr.x = G * hr.x + s[j].x; hr.y = G * hr.y + s[j].y;
        }
      }
    }
  }
}

DEV void ssm_out_item(const Prm& p, int L, int it, char* smem) {
  TILE_IDS
  bfr* sC = (bfr*)smem;
  bfr* sB = sC + 64 * 136;
  bfr* sP = sB; bfr* sX = sB + 64 * 136;
  float* sCum = (float*)(smem + 52224); float* sDt = sCum + 256; float* sSS = sDt + 256; float* sTmp = sSS + 64;
  const int c = it >> 2, g = (it >> 1) & 1, lh = it & 1, r0 = c * 128, rq0 = r0 + lh * 64;
  const bfr* X_ = WS_B(O_XBC);
  const bfr* U_ = WS_B(O_U);
  uint2 rawq;
  { const int dir_ = tid >> 7, i_ = tid & 127, l_ = dir_ ? 127 - i_ : i_;
    rawq = *(const uint2*)(U_ + (size_t)(r0 + l_) * NU + C_DT + dir_ * 8 + g * 4); }
  uint4 xr0, xr1, xr2, xr3;
#define SSM_XLOAD(h_) do { \
    const bfr* s0_ = X_ + (size_t)(r0 + 2 * (tid & 63)) * 1024 + (h_) * 64 + (tid >> 6) * 8; \
    xr0 = *(const uint4*)s0_; xr1 = *(const uint4*)(s0_ + 1024); xr2 = *(const uint4*)(s0_ + 32); xr3 = *(const uint4*)(s0_ + 1024 + 32); } while (0)
  SSM_XLOAD(g * 4);
  __syncthreads();
#pragma unroll 4
  for (int u = tid; u < 1024; u += 256) {
    int row = u >> 4, ch = u & 15;
    *(uint4*)(sC + row * 136 + ch * 8) = *(const uint4*)(X_ + (size_t)(rq0 + row) * 1024 + 768 + g * 128 + ch * 8);
  }
#pragma unroll 4
  for (int u = tid; u < 2048; u += 256) {
    int row = u >> 4, ch = u & 15;
    *(uint4*)(sB + row * 136 + ch * 8) = *(const uint4*)(X_ + (size_t)(r0 + row) * 1024 + 512 + g * 128 + ch * 8);
  }
  if (tid < 64) sSS[tid] = 0.f;
  __syncthreads();
  f32x4 cb[2][4];
#pragma unroll
  for (int i = 0; i < 2; i++)
#pragma unroll
    for (int j = 0; j < 4; j++) cb[i][j] = f32x4{0, 0, 0, 0};
  lds_gemm<2, 4, 4>(sC + (wm * 32) * 136, 136, sB + (wn * 64) * 136, 136, cb);
#pragma unroll 1
  for (int hh = 0; hh < 4; hh++) {
    f32x4 y[2][2];
    const int h = g * 4 + hh;
    __syncthreads();
    chunk_decay(p, L, hh == 0 ? lo16(rawq.x) : hh == 1 ? hi16(rawq.x) : hh == 2 ? lo16(rawq.y) : hi16(rawq.y), h, sCum, sDt, sTmp);
#pragma unroll
    for (int mi = 0; mi < 2; mi++) {
      const int rl = wm * 32 + mi * 16 + l15, ll = lh * 64 + rl;
      const float cfl = sCum[ll], cbl = sCum[128 + ll];
#pragma unroll
      for (int ni = 0; ni < 4; ni++) {
        const int s0 = wn * 64 + ni * 16 + quad * 4;
        float pv[4];
#pragma unroll
        for (int r = 0; r < 4; r++) {
          int s = s0 + r;
          float ef = (s <= ll) ? __expf(cfl - sCum[s]) * sDt[s] : 0.f;
          float eb = (s >= ll) ? __expf(cbl - sCum[128 + s]) * sDt[128 + s] : 0.f;
          pv[r] = cb[mi][ni][r] * (ef + eb);
        }
        *(uint2*)(sP + rl * 136 + s0) = pack4(pv[0], pv[1], pv[2], pv[3]);
      }
    }
    {
      const int lp = tid & 63, pc = tid >> 6;
#pragma unroll
      for (int e = 0; e < 8; e++) {
        *(unsigned*)(sX + (pc * 8 + e) * 136 + 2 * lp) = elem16(xr0, e) | (elem16(xr1, e) << 16);
        *(unsigned*)(sX + ((pc + 4) * 8 + e) * 136 + 2 * lp) = elem16(xr2, e) | (elem16(xr3, e) << 16);
      }
      if (hh < 3) SSM_XLOAD(h + 1);
    }
    __syncthreads();
#pragma unroll
    for (int i = 0; i < 2; i++) { y[i][0] = f32x4{0, 0, 0, 0}; y[i][1] = f32x4{0, 0, 0, 0}; }
    float4 hreg[8];
    {
      const float* hsrc = WS_F(O_SST) + ((size_t)((0 * NCH + c) * 8 + h)) * 8192;
#pragma unroll
      for (int k = 0; k < 8; k++) { int u = tid + 256 * k; hreg[k] = *(const float4*)(hsrc + (u >> 5) * 128 + (u & 31) * 4); }
    }
    lds_gemm<2, 2, 4>(sP + (wm * 32) * 136, 136, sX + (wn * 32) * 136, 136, y);
#pragma unroll
    for (int dir = 0; dir < 2; dir++) {
      __syncthreads();
#pragma unroll
      for (int k = 0; k < 8; k++) { int u = tid + 256 * k; *(uint2*)(sX + (u >> 5) * 136 + (u & 31) * 4) = pack4(hreg[k].x, hreg[k].y, hreg[k].z, hreg[k].w); }
      if (dir == 0) {
        const float* hsrc = WS_F(O_SST) + ((size_t)((1 * NCH + c) * 8 + h)) * 8192;
#pragma unroll
        for (int k = 0; k < 8; k++) { int u = tid + 256 * k; hreg[k] = *(const float4*)(hsrc + (u >> 5) * 128 + (u & 31) * 4); }
      }
      __syncthreads();
      f32x4 t[2][2];
#pragma unroll
      for (int i = 0; i < 2; i++) { t[i][0] = f32x4{0, 0, 0, 0}; t[i][1] = f32x4{0, 0, 0, 0}; }
      lds_gemm<2, 2, 4>(sC + (wm * 32) * 136, 136, sX + (wn * 32) * 136, 136, t);
#pragma unroll
      for (int mi = 0; mi < 2; mi++) {
        float e = __expf(sCum[dir * 128 + lh * 64 + wm * 32 + mi * 16 + l15]);
#pragma unroll
        for (int ni = 0; ni < 2; ni++)
#pragma unroll
          for (int r = 0; r < 4; r++) y[mi][ni][r] += e * t[mi][ni][r];
      }
    }
    const float Dh = p.in[I_SSMD][L * 8 + h];
#pragma unroll
    for (int mi = 0; mi < 2; mi++) {
      const int rl = wm * 32 + mi * 16 + l15, row = rq0 + rl;
      float part = 0.f;
#pragma unroll
      for (int ni = 0; ni < 2; ni++) {
        int p0 = wn * 32 + ni * 16 + quad * 4;
        float xf[4], zf[4];
        unpack4(*(const uint2*)(X_ + (size_t)row * 1024 + h * 64 + p0), xf);
        unpack4(*(const uint2*)(U_ + (size_t)row * NU + C_Z + h * 64 + p0), zf);
#pragma unroll
        for (int r = 0; r < 4; r++) {
          float v = (y[mi][ni][r] + Dh * xf[r]) * silu_f(zf[r]);
          y[mi][ni][r] = v; part += v * v;
        }
      }
      part += __shfl_xor(part, 16); part += __shfl_xor(part, 32);
      if (quad == 0) atomicAdd(&sSS[rl], part);
#pragma unroll
      for (int ni = 0; ni < 2; ni++) {
        int ch = hh * 64 + wn * 32 + ni * 16 + quad * 4;
        *(uint2*)(WS_B(O_BR) + (size_t)row * 2048 + 512 + g * 256 + ch) = pack4(y[mi][ni][0], y[mi][ni][1], y[mi][ni][2], y[mi][ni][3]);
      }
    }
  }
  __syncthreads();
  const float* ng = p.in[I_SNG] + L * 512 + g * 256;
#pragma unroll
  for (int mi = 0; mi < 2; mi++) {
    const int rl = wm * 32 + mi * 16 + l15, row = rq0 + rl;
    const float rstd = rsqrtf(sSS[rl] * (1.f / 256.f) + EPS);
#pragma unroll
    for (int hh = 0; hh < 4; hh++)
#pragma unroll
      for (int ni = 0; ni < 2; ni++) {
        int ch = hh * 64 + wn * 32 + ni * 16 + quad * 4;
        float4 gg = *(const float4*)(ng + ch);
        bfr* dst = WS_B(O_BR) + (size_t)row * 2048 + 512 + g * 256 + ch;
        float v[4]; unpack4(*(const uint2*)dst, v);
        *(uint2*)dst = pack4(v[0] * rstd * gg.x, v[1] * rstd * gg.y, v[2] * rstd * gg.z, v[3] * rstd * gg.w);
      }
  }
}

#undef SSM_XLOAD
DEV void ret_out_item(const Prm& p, int L, int it, char* smem) {
  TILE_IDS
  bfr* sQ = (bfr*)smem;
  bfr* sK = sQ + 64 * 72;
  bfr* sP = sK;
  bfr* sV = (bfr*)(smem + 27648);
  bfr* sH = sV;
  float* sSum = (float*)(smem + 62464); float* sSq = sSum + 64;
  const int c = it >> 3, h = (it >> 1) & 3, lh = it & 1, r0 = c * 128, rq0 = r0 + lh * 64;
  const bfr* U_ = WS_B(O_U);
  const float lgf = -expf(p.in[I_RDEC][L * 8 + h]), lgb = -expf(p.in[I_RDEC][L * 8 + 4 + h]);
  __syncthreads();
  {
    int row = tid >> 2, nc = tid & 3, r = rq0 + row;
    const bfr* src = U_ + (size_t)r * NU + C_RQ + h * 64 + nc * 8;
    float o1[8], o2[8];
    ret_rope8(p, r, nc, *(const uint4*)src, *(const uint4*)(src + 32), 1.f, o1, o2);
    *(uint4*)(sQ + row * 72 + nc * 8) = pack8(o1); *(uint4*)(sQ + row * 72 + 32 + nc * 8) = pack8(o2);
  }
  for (int u = tid; u < 512; u += 256) {
    int row = u >> 2, nc = u & 3, r = r0 + row;
    const bfr* src = U_ + (size_t)r * NU + C_RK + h * 64 + nc * 8;
    float o1[8], o2[8];
    ret_rope8(p, r, nc, *(const uint4*)src, *(const uint4*)(src + 32), 0.125f, o1, o2);
    *(uint4*)(sK + row * 72 + nc * 8) = pack8(o1); *(uint4*)(sK + row * 72 + 32 + nc * 8) = pack8(o2);
  }
#pragma unroll 4
  for (int u = tid; u < 1024; u += 256) {
    int lp = u & 63, pc = u >> 6;
    const bfr* src = U_ + (size_t)(r0 + 2 * lp) * NU + C_RV + h * 128 + pc * 8;
    uint4 a = *(const uint4*)src, b2 = *(const uint4*)(src + NU);
#pragma unroll
    for (int e = 0; e < 8; e++) *(unsigned*)(sV + (pc * 8 + e) * 136 + 2 * lp) = elem16(a, e) | (elem16(b2, e) << 16);
  }
  if (tid < 128) sSum[tid] = 0.f;
  __syncthreads();
  f32x4 qk[2][4];
#pragma unroll
  for (int i = 0; i < 2; i++)
#pragma unroll
    for (int j = 0; j < 4; j++) qk[i][j] = f32x4{0, 0, 0, 0};
  lds_gemm<2, 4, 2>(sQ + (wm * 32) * 72, 72, sK + (wn * 64) * 72, 72, qk);
  __syncthreads();
#pragma unroll
  for (int mi = 0; mi < 2; mi++) {
    const int rl = wm * 32 + mi * 16 + l15, ll = lh * 64 + rl;
#pragma unroll
    for (int ni = 0; ni < 4; ni++) {
      const int s0 = wn * 64 + ni * 16 + quad * 4;
      float pv[4];
#pragma unroll
      for (int r = 0; r < 4; r++) {
        int d = ll - (s0 + r);
        float wgt = (d >= 0 ? __expf((float)d * lgf) : 0.f) + (d <= 0 ? __expf((float)(-d) * lgb) : 0.f);
        pv[r] = qk[mi][ni][r] * wgt;
      }
      *(uint2*)(sP + rl * 136 + s0) = pack4(pv[0], pv[1], pv[2], pv[3]);
    }
  }
  __syncthreads();
  f32x4 y[2][4];
#pragma unroll
  for (int i = 0; i < 2; i++)
#pragma unroll
    for (int j = 0; j < 4; j++) y[i][j] = f32x4{0, 0, 0, 0};
  float4 hreg[8];
  {
    const float* hsrc = WS_F(O_RST) + ((size_t)((0 * NCH + c) * 4 + h)) * 8192;
#pragma unroll
    for (int k = 0; k < 8; k++) { int u = tid + 256 * k; hreg[k] = *(const float4*)(hsrc + (u >> 4) * 64 + (u & 15) * 4); }
  }
  lds_gemm<2, 4, 4>(sP + (wm * 32) * 136, 136, sV + (wn * 64) * 136, 136, y);
#pragma unroll
  for (int dir = 0; dir < 2; dir++) {
    __syncthreads();
#pragma unroll
    for (int k = 0; k < 8; k++) { int u = tid + 256 * k; *(uint2*)(sH + (u >> 4) * 72 + (u & 15) * 4) = pack4(hreg[k].x, hreg[k].y, hreg[k].z, hreg[k].w); }
    if (dir == 0) {
      const float* hsrc = WS_F(O_RST) + ((size_t)((1 * NCH + c) * 4 + h)) * 8192;
#pragma unroll
      for (int k = 0; k < 8; k++) { int u = tid + 256 * k; hreg[k] = *(const float4*)(hsrc + (u >> 4) * 64 + (u & 15) * 4); }
    }
    __syncthreads();
    f32x4 t[2][4];
#pragma unroll
    for (int i = 0; i < 2; i++)
#pragma unroll
      for (int j = 0; j < 4; j++) t[i][j] = f32x4{0, 0, 0, 0};
    lds_gemm<2, 4, 2>(sQ + (wm * 32) * 72, 72, sH + (wn * 64) * 72, 72, t);
#pragma unroll
    for (int mi = 0; mi < 2; mi++) {
      const int ll = lh * 64 + wm * 32 + mi * 16 + l15;
      float e = dir == 0 ? __expf((float)(ll + 1) * lgf) : __expf((float)(128 - ll) * lgb);
#pragma unroll
      for (int ni = 0; ni < 4; ni++)
#pragma unroll
        for (int r = 0; r < 4; r++) y[mi][ni][r] += e * t[mi][ni][r];
    }
  }
#pragma unroll
  for (int mi = 0; mi < 2; mi++) {
    const int rl = wm * 32 + mi * 16 + l15;
    float s1 = 0.f, s2 = 0.f;
#pragma unroll
    for (int ni = 0; ni < 4; ni++)
#pragma unroll
      for (int r = 0; r < 4; r++) { float v = y[mi][ni][r]; s1 += v; s2 += v * v; }
    s1 += __shfl_xor(s1, 16); s1 += __shfl_xor(s1, 32);
    s2 += __shfl_xor(s2, 16); s2 += __shfl_xor(s2, 32);
    if (quad == 0) { atomicAdd(&sSum[rl], s1); atomicAdd(&sSq[rl], s2); }
  }
  __syncthreads();
  const float* gg = p.in[I_RGNG] + L * 512 + h * 128;
  const float* gb = p.in[I_RGNB] + L * 512 + h * 128;
#pragma unroll
  for (int mi = 0; mi < 2; mi++) {
    const int rl = wm * 32 + mi * 16 + l15, row = rq0 + rl;
    const float mu = sSum[rl] * (1.f / 128.f);
    const float var = fmaxf(sSq[rl] * (1.f / 128.f) - mu * mu, 0.f);
    const float rstd = rsqrtf(var + EPS);
#pragma unroll
    for (int ni = 0; ni < 4; ni++) {
      int p0 = wn * 64 + ni * 16 + quad * 4;
      float gf[4]; unpack4(*(const uint2*)(U_ + (size_t)row * NU + C_RG + h * 128 + p0), gf);
      float4 g4 = *(const float4*)(gg + p0), b4 = *(const float4*)(gb + p0);
      float o0 = silu_f(gf[0]) * ((y[mi][ni][0] - mu) * rstd * g4.x + b4.x);
      float o1 = silu_f(gf[1]) * ((y[mi][ni][1] - mu) * rstd * g4.y + b4.y);
      float o2 = silu_f(gf[2]) * ((y[mi][ni][2] - mu) * rstd * g4.z + b4.z);
      float o3 = silu_f(gf[3]) * ((y[mi][ni][3] - mu) * rstd * g4.w + b4.w);
      *(uint2*)(WS_B(O_BR) + (size_t)row * 2048 + 1024 + h * 128 + p0) = pack4(o0, o1, o2, o3);
    }
  }
}

typedef __attribute__((ext_vector_type(16))) float f32x16;
DEV unsigned cvtpk(float lo, float hi) { unsigned r; asm("v_cvt_pk_bf16_f32 %0, %1, %2" : "=v"(r) : "v"(lo), "v"(hi)); return r; }
DEV void attn_item(const Prm& p, int q0, int head, int nkeys, char* smem) {
  const int tid = rtid(), lane = tid & 63, wid = tid >> 6, l31 = lane & 31, hi = lane >> 5;
  constexpr int LDK = 104, LDV = 72;
  bfr* sK0 = (bfr*)smem;
  bfr* sV0 = sK0 + 2 * 64 * LDK;
  const bfr* KN = WS_B(O_KN);
  const bfr* KR = WS_B(O_KROPE);
  const bfr* VT = WS_B(O_VT);
  const float qs = 0.10206207261596577f * 1.4426950408889634f;
  const float THR2 = 11.5f;
  bf16x8 qf[6];
  const int row = q0 + wid * 32 + l31;
  {
    const bfr* qp = WS_B(O_Q) + (size_t)row * 768 + head * 96;
#pragma unroll
    for (int ks = 0; ks < 4; ks++) {
      float f[8]; unpack8(*(const uint4*)(qp + ks * 16 + hi * 8), f);
      uint4 t = {cvtpk(f[0] * qs, f[1] * qs), cvtpk(f[2] * qs, f[3] * qs), cvtpk(f[4] * qs, f[5] * qs), cvtpk(f[6] * qs, f[7] * qs)};
      qf[ks] = *(bf16x8*)&t;
    }
    float x1[8], x2[8], o1[8], o2[8];
    unpack8(*(const uint4*)(qp + 64 + hi * 8), x1);
    unpack8(*(const uint4*)(qp + 80 + hi * 8), x2);
    if (row >= CTX) {
      const float2* mcs = (const float2*)(p.ws + O_MCS);
      int t = row - CTX, pos = hi ? (t & 63) : (t >> 6);
#pragma unroll
      for (int e = 0; e < 8; e++) {
        float2 cs = mcs[pos * 8 + e];
        o1[e] = (x1[e] * cs.x - x2[e] * cs.y) * qs; o2[e] = (x1[e] * cs.y + x2[e] * cs.x) * qs;
      }
    } else {
#pragma unroll
      for (int e = 0; e < 8; e++) { o1[e] = x1[e] * qs; o2[e] = x2[e] * qs; }
    }
    uint4 t1 = {cvtpk(o1[0], o1[1]), cvtpk(o1[2], o1[3]), cvtpk(o1[4], o1[5]), cvtpk(o1[6], o1[7])};
    uint4 t2 = {cvtpk(o2[0], o2[1]), cvtpk(o2[2], o2[3]), cvtpk(o2[4], o2[5]), cvtpk(o2[6], o2[7])};
    qf[4] = *(bf16x8*)&t1; qf[5] = *(bf16x8*)&t2;
  }
  f32x16 O0, O1;
#pragma unroll
  for (int r = 0; r < 16; r++) { O0[r] = 0.f; O1[r] = 0.f; }
  float mrun = -1e30f, lrun = 0.f;
  uint4 ek0, ek1, ev0, ok0, ok1, ov0;
  const int nt = nkeys >> 6;
  const bool k2 = tid < 256;
  const int ku0 = tid, ku1 = tid + 512;
  const int kk0 = ku0 / 12, kc0 = ku0 - kk0 * 12, kk1 = ku1 / 12, kc1 = ku1 - kk1 * 12;
  const bfr* ks0 = kc0 < 8 ? KN + (size_t)kk0 * 512 + head * 64 + kc0 * 8 : KR + (size_t)kk0 * 32 + (kc0 - 8) * 8;
  const bfr* ks1 = kc1 < 8 ? KN + (size_t)kk1 * 512 + head * 64 + kc1 * 8 : KR + (size_t)kk1 * 32 + (kc1 - 8) * 8;
  const int kst0 = kc0 < 8 ? 512 * 64 : 32 * 64, kst1 = kc1 < 8 ? 512 * 64 : 32 * 64;
  const int vd0 = tid >> 3, vc0 = tid & 7;
  const bfr* vs0 = VT + (size_t)(head * 64 + vd0) * ROWS + vc0 * 8;
  const int kw0 = kk0 * LDK + kc0 * 8, kw1 = kk1 * LDK + kc1 * 8;
  const int vw0 = vd0 * LDV + (vc0 >> 1) * 16 + (vc0 & 1) * 4;
#define ATT_KLOAD(S, t_) do { const int tc_ = min((int)(t_), nt - 1); S##k0 = *(const uint4*)(ks0 + (size_t)tc_ * kst0); if (k2) S##k1 = *(const uint4*)(ks1 + (size_t)tc_ * kst1); } while (0)
#define ATT_VLOAD(S, t_) do { const int tc_ = min((int)(t_), nt - 1); S##v0 = *(const uint4*)(vs0 + tc_ * 64); } while (0)
#define ATT_KSTORE(S, buf_) do { bfr* sK_ = sK0 + (buf_) * 64 * LDK; *(uint4*)(sK_ + kw0) = S##k0; if (k2) *(uint4*)(sK_ + kw1) = S##k1; } while (0)
#define ATT_VSTORE(S, buf_) do { bfr* sV_ = sV0 + (buf_) * 64 * LDV; \
       *(uint2*)(sV_ + vw0) = make_uint2(S##v0.x, S##v0.y); *(uint2*)(sV_ + vw0 + 8) = make_uint2(S##v0.z, S##v0.w); } while (0)
#define ATT_QK(SA_, SB_, buf_) do { const bfr* sK = sK0 + (buf_) * 64 * LDK + l31 * LDK + hi * 8; \
    _Pragma("unroll") for (int r = 0; r < 16; r++) { SA_[r] = 0.f; SB_[r] = 0.f; } \
    bf16x8 ka0 = *(const bf16x8*)(sK), ka1 = *(const bf16x8*)(sK + 32 * LDK), kb0, kb1; \
    _Pragma("unroll") for (int ks = 0; ks < 6; ks += 2) { \
      kb0 = *(const bf16x8*)(sK + (ks + 1) * 16); kb1 = *(const bf16x8*)(sK + 32 * LDK + (ks + 1) * 16); \
      SA_ = __builtin_amdgcn_mfma_f32_32x32x16_bf16(ka0, qf[ks], SA_, 0, 0, 0); \
      SB_ = __builtin_amdgcn_mfma_f32_32x32x16_bf16(ka1, qf[ks], SB_, 0, 0, 0); SBAR(); \
      if (ks + 2 < 6) { ka0 = *(const bf16x8*)(sK + (ks + 2) * 16); ka1 = *(const bf16x8*)(sK + 32 * LDK + (ks + 2) * 16); } \
      SA_ = __builtin_amdgcn_mfma_f32_32x32x16_bf16(kb0, qf[ks + 1], SA_, 0, 0, 0); \
      SB_ = __builtin_amdgcn_mfma_f32_32x32x16_bf16(kb1, qf[ks + 1], SB_, 0, 0, 0); SBAR(); } } while (0)
#define ATT_SMPV(S0, S1, buf_) do { const bfr* sV = sV0 + (buf_) * 64 * LDV; \
    float pmax; asm("v_max_f32 %0, %1, %2" : "=v"(pmax) : "v"(S0[0]), "v"(S1[0])); \
    _Pragma("unroll") for (int r = 1; r < 16; r++) asm("v_max3_f32 %0, %1, %2, %3" : "=v"(pmax) : "v"(pmax), "v"(S0[r]), "v"(S1[r])); \
    { auto rr_ = __builtin_amdgcn_permlane32_swap(__float_as_uint(pmax), __float_as_uint(pmax), false, false); \
      pmax = fmaxf(__uint_as_float(rr_[0]), __uint_as_float(rr_[1])); } \
    if (!__all(pmax - mrun <= THR2)) { \
      const float mn = fmaxf(mrun, pmax); const float alpha = __builtin_amdgcn_exp2f(mrun - mn); \
      mrun = mn; lrun *= alpha; \
      _Pragma("unroll") for (int r = 0; r < 16; r++) { O0[r] *= alpha; O1[r] *= alpha; } } \
    float rs = 0.f; \
    _Pragma("unroll") for (int r = 0; r < 16; r++) { \
      S0[r] = __builtin_amdgcn_exp2f(S0[r] - mrun); S1[r] = __builtin_amdgcn_exp2f(S1[r] - mrun); rs += S0[r] + S1[r]; } \
    lrun += rs; \
    _Pragma("unroll") for (int kt = 0; kt < 2; kt++) \
    _Pragma("unroll") for (int sx = 0; sx < 2; sx++) { \
        uint4 pw; \
        if (kt == 0) pw = uint4{cvtpk(S0[8 * sx + 0], S0[8 * sx + 1]), cvtpk(S0[8 * sx + 2], S0[8 * sx + 3]), cvtpk(S0[8 * sx + 4], S0[8 * sx + 5]), cvtpk(S0[8 * sx + 6], S0[8 * sx + 7])}; \
        else         pw = uint4{cvtpk(S1[8 * sx + 0], S1[8 * sx + 1]), cvtpk(S1[8 * sx + 2], S1[8 * sx + 3]), cvtpk(S1[8 * sx + 4], S1[8 * sx + 5]), cvtpk(S1[8 * sx + 6], S1[8 * sx + 7])}; \
        bf16x8 pf = *(bf16x8*)&pw; \
        const int ko = kt * 32 + sx * 16 + hi * 8; \
        uint4 va = *(const uint4*)(sV + l31 * LDV + ko), vb = *(const uint4*)(sV + (32 + l31) * LDV + ko); \
        O0 = __builtin_amdgcn_mfma_f32_32x32x16_bf16(*(bf16x8*)&va, pf, O0, 0, 0, 0); \
        O1 = __builtin_amdgcn_mfma_f32_32x32x16_bf16(*(bf16x8*)&vb, pf, O1, 0, 0, 0); } } while (0)
#define ATT_STEP(S, SC0, SC1, SN0, SN1, t_) do { \
    ATT_KSTORE(S, (t_) & 1); \
    ATT_VSTORE(S, ((t_) + 1) & 1); \
    ATT_KLOAD(S, (t_) + 4); \
    ATT_VLOAD(S, (t_) + 3); \
    ATT_QK(SN0, SN1, ((t_) + 1) & 1); \
    ATT_SMPV(SC0, SC1, (t_) & 1); \
    __syncthreads(); } while (0)
  f32x16 SA0, SA1, SB0, SB1;
  __syncthreads();
  ATT_KLOAD(e, 0); ATT_VLOAD(e, 0); ATT_KLOAD(o, 1);
  ATT_KSTORE(e, 0); ATT_VSTORE(e, 0); ATT_KSTORE(o, 1);
  ATT_KLOAD(e, 2); ATT_VLOAD(e, 1); ATT_KLOAD(o, 3); ATT_VLOAD(o, 2);
  __syncthreads();
  ATT_QK(SA0, SA1, 0);
  __syncthreads();
#pragma unroll 1
  for (int t = 0; t < nt; t += 2) {
    ATT_STEP(e, SA0, SA1, SB0, SB1, t);
    ATT_STEP(o, SB0, SB1, SA0, SA1, t + 1);
  }
#undef ATT_KLOAD
#undef ATT_VLOAD
#undef ATT_KSTORE
#undef ATT_VSTORE
#undef ATT_QK
#undef ATT_SMPV
#undef ATT_STEP
  {
    float l = lrun + __shfl_xor(lrun, 32);
    const float inv = 1.f / l;
    bfr* orow = WS_B(O_BR) + (size_t)row * 2048 + 1536 + head * 64 + 4 * hi;
#pragma unroll
    for (int g4 = 0; g4 < 4; g4++) {
      *(uint2*)(orow + 8 * g4) = make_uint2(cvtpk(O0[4 * g4] * inv, O0[4 * g4 + 1] * inv), cvtpk(O0[4 * g4 + 2] * inv, O0[4 * g4 + 3] * inv));
      *(uint2*)(orow + 32 + 8 * g4) = make_uint2(cvtpk(O1[4 * g4] * inv, O1[4 * g4 + 1] * inv), cvtpk(O1[4 * g4 + 2] * inv, O1[4 * g4 + 3] * inv));
    }
  }
}

DEV void ph_mix(const Prm& p, int L, char* smem_base, char* smem) {
  constexpr int NQB = SEQ / 256;
  const int NA = NQB * 8 + (L == 0 ? 8 : 0);
#ifdef ATT_REP
  for (int rp_ = 0; rp_ < ATT_REP; rp_++)
#endif
  for (int it = blockIdx.x; it < NA; it += gridDim.x) {
    if (it < NQB * 8) {
      int head = it / NQB, qb = it % NQB;
      if (gridDim.x == 256) { const int b = blockIdx.x, xcd = b & 7, j = b >> 3, k = it >> 8; head = (xcd >> 1) + 4 * k; qb = (xcd & 1) * 32 + j; }
      attn_item(p, CTX + qb * 256, head, ROWS, smem_base);
    } else attn_item(p, 0, it - NQB * 8, CTX, smem_base);
  }
  constexpr int N2 = NCH * 4, N3 = N2 + NCH * 8;
  for (int it = VBX; it < N3; it += VGX) {
    if (it < N2) ssm_out_item(p, L, it, smem);
    else ret_out_item(p, L, it - N2, smem);
  }
}

#define XB_TMO      128
#define XB_XCNT(j)  (256  + 64 * (j))
#define XB_XSUB(j)  (1280 + 64 * (j))
#define XB_XGEN(j)  (2304 + 64 * (j))
#define XB_TOP      3328
#define XB_TOPGEN   3392
#define XCD_BAR_WORDS 3456
#define XB_SPIN_CAP (1u << 18)
#define LAS __attribute__((address_space(3)))
DEV unsigned xb_ld(unsigned* p)              { return __hip_atomic_load(p, __ATOMIC_RELAXED, __HIP_MEMORY_SCOPE_AGENT); }
DEV unsigned xb_add(unsigned* p, unsigned v) { return __hip_atomic_fetch_add(p, v, __ATOMIC_RELAXED, __HIP_MEMORY_SCOPE_AGENT); }
DEV unsigned xb_xcc_id() { return (unsigned)__builtin_amdgcn_s_getreg((3 << 11) | 20) & 0xFu; }
#define XB_SPIN(cond, bar) do { unsigned _sp = 0; while (cond) { __builtin_amdgcn_s_sleep(1); \
    if ((++_sp & 255u) == 0u) { if (xb_ld(&(bar)[XB_TMO])) break; if (_sp > XB_SPIN_CAP) { atomicAdd(&(bar)[XB_TMO], 1u); break; } } } } while (0)
struct XcdBarrier { unsigned* bar; unsigned x; volatile LAS unsigned* st; };
DEV XcdBarrier xcd_barrier_post(unsigned* bar, volatile LAS unsigned* st) {
  XcdBarrier b; b.bar = bar; b.x = xb_xcc_id(); b.st = st;
  if (__builtin_amdgcn_workitem_id_x() == 0) (void)xb_add(&bar[XB_XCNT(b.x)], 1u);
  return b;
}
DEV void xcd_barrier_complete(unsigned* bar, unsigned x, unsigned& nloc, unsigned& nx) {
  const unsigned G = gridDim.x * gridDim.y * gridDim.z;
  unsigned sum, cnt, mine, sp = 0u;
  for (;;) {
    sum = 0u; cnt = 0u; mine = 0u;
#pragma unroll
    for (unsigned j = 0; j < 16; ++j) { const unsigned c = xb_ld(&bar[XB_XCNT(j)]); sum += c; cnt += (c > 0u) ? 1u : 0u; mine = (j == x) ? c : mine; }
    if (sum == G) break;
    __builtin_amdgcn_s_sleep(1);
    if ((++sp & 255u) == 0u) { if (xb_ld(&bar[XB_TMO])) break; if (sp > XB_SPIN_CAP) { atomicAdd(&bar[XB_TMO], 1u); break; } }
  }
  nloc = mine > 0u ? mine : 1u; nx = cnt > 0u ? cnt : 1u;
}
DEV void xcd_barrier(const XcdBarrier& b) {
  asm volatile("s_waitcnt vmcnt(0)" ::: "memory");
  __syncthreads();
  if (__builtin_amdgcn_workitem_id_x() == 0) {
    unsigned* bar = b.bar;
    __builtin_amdgcn_s_waitcnt(0);
    unsigned nloc = b.st[0], nx = b.st[1];
    if (nloc == 0u) { xcd_barrier_complete(bar, b.x, nloc, nx); b.st[0] = nloc; b.st[1] = nx; }
    const unsigned old = xb_add(&bar[XB_XSUB(b.x)], 1u);
    const unsigned gen = old / nloc;
    if (old + 1u == (gen + 1u) * nloc) {
      __builtin_amdgcn_fence(__ATOMIC_RELEASE, "agent");
      asm volatile("s_waitcnt vmcnt(0)" ::: "memory");
      const unsigned og = xb_add(&bar[XB_TOP], 1u);
      const unsigned tg = og / nx;
      if (og + 1u == (tg + 1u) * nx) xb_add(&bar[XB_TOPGEN], 1u);
      else XB_SPIN(xb_ld(&bar[XB_TOPGEN]) == tg, bar);
      __builtin_amdgcn_fence(__ATOMIC_ACQUIRE, "agent");
      xb_add(&bar[XB_XGEN(b.x)], 1u);
      asm volatile("s_waitcnt vmcnt(0)" ::: "memory");
    } else {
      XB_SPIN(xb_ld(&bar[XB_XGEN(b.x)]) == gen, bar);
      __builtin_amdgcn_fence(__ATOMIC_ACQUIRE, "agent");
      asm volatile("s_waitcnt vmcnt(0)" ::: "memory");
    }
  }
  __syncthreads();
}

constexpr int NST = 13, NPH = 2 + 2 * (1 + 2 * NST);
DEV void run_phase(const Prm& p, int ph, char* smem_base) {
  char* smem = smem_base + (rtid() >> 8) * 63488;
  if (ph == 0) { ph_ada(p); return; }
  if (ph == 1) { ph_ada_reduce(p); return; }
  int q = ph - 2, L = q / (1 + 2 * NST), s = q % (1 + 2 * NST);
#ifdef CONV_REP
  if (s == 0) { for (int r_ = 0; r_ < CONV_REP; r_++) ph_convert(p, L, smem); return; }
#endif
  if (s == 0) { ph_convert(p, L, smem); ph_norm(p, L, 0, 0); return; }
  s -= 1;
  int b = s / NST, st = s % NST;
#ifdef ONLY
  st = ONLY;
#endif
#ifdef REP_MASK
  for (int rep_ = 0; rep_ < (((REP_MASK >> st) & 1) ? REP_N : 1); rep_++)
#endif
  switch (st) {
    case 0: ph_norm(p, L, b, 0); break;
    case 1: ph_inproj(p, smem_base); break;
    case 2: ph_local(p, L, smem); break;
    case 3: ph_states(p, L, smem); break;
    case 4: ph_scan(p, L); break;
    case 5: ph_mix(p, L, smem_base, smem); break;
    case 6: ph_gates(p, L, smem_base); break;
    case 7: ph_merge(p, L, smem); break;
    case 8: ph_resgemm(p, L, b, WS_B(O_H), D, WS_B(O_WTOUT), D, 2, true, smem_base); break;
    case 9: ph_norm(p, L, b, 1); break;
    case 10: ph_ffn1(p, L, smem_base); break;
    case 11: ph_resgemm(p, L, b, WS_B(O_U), FFN, WS_B(O_WTF2), FFN, 5, false, smem_base);
             if (b == 0) ph_norm(p, L, 1, 0);
             break;
    case 12: if (L == 1) ph_final_norm(p, b); break;
  }
}

constexpr int DYN_LDS = 2 * 63488;
__global__ void __launch_bounds__(512) mega(Prm p, int ph0, int ph1) {
  extern __shared__ __attribute__((aligned(16))) char smem[];
  __shared__ uint4 xb_words;
#if COOP
  if (__builtin_amdgcn_workitem_id_x() == 0) xb_words = make_uint4(0u, 0u, 0u, 0u);
  __syncthreads();
  (void)xcd_barrier_post((unsigned*)(p.ws + O_BAR), (volatile LAS unsigned*)&xb_words);
#define GRID_BARRIER() do { if (ph1 > 100000) cg::this_grid().sync(); else { XcdBarrier xb_; xb_.bar = (unsigned*)(p.ws + O_BAR); xb_.x = xb_xcc_id(); xb_.st = (volatile LAS unsigned*)&xb_words; xcd_barrier(xb_); } } while (0)
#else
#define GRID_BARRIER() do {} while (0)
#endif
  for (int ph = ph0; ph < ph1; ph++) {
    if (ph >= 2 && ph < 2 + (1 + 2 * NST) && ((ph - 2) % (1 + 2 * NST)) >= 1 && (((ph - 2) % (1 + 2 * NST)) - 1) % NST == 12) continue;
    { const int q_ = ph - 2; if (q_ >= 0) { const int s_ = q_ % (1 + 2 * NST); if (s_ == 1 || s_ == 1 + NST) continue; } }
    run_phase(p, ph, smem);
    if (ph + 1 < ph1) GRID_BARRIER();
  }
}

extern "C" void kernel_launch(void* const* d_in, const int* in_sizes, int n_in, void* d_out, int out_size, void* d_ws,
                              size_t ws_size, hipStream_t stream) {
  static int grid_blocks = 0;
  if (!grid_blocks) {
    int dev = 0, cus = 0, per_cu = 0;
    (void)hipGetDevice(&dev);
    (void)hipDeviceGetAttribute(&cus, hipDeviceAttributeMultiprocessorCount, dev);
    (void)hipFuncSetAttribute((const void*)mega, hipFuncAttributeMaxDynamicSharedMemorySize, DYN_LDS);
    (void)hipOccupancyMaxActiveBlocksPerMultiprocessor(&per_cu, mega, 512, DYN_LDS);
    if (per_cu > 1) per_cu = 1;
    if (per_cu < 1) per_cu = 1;
    grid_blocks = cus * per_cu;
  }
  Prm p{};
  for (int i = 0; i < N_INPUTS; i++) p.in[i] = (const float*)d_in[i];
  p.out = (float*)d_out;
  p.ws = (char*)d_ws;
#if COOP
  hipMemsetAsync((char*)d_ws + O_BAR, 0, 3456 * 4, stream);
  int ph0 = 0, ph1 = NPH;
  void* args[] = {&p, &ph0, &ph1};
  hipError_t e = hipLaunchCooperativeKernel((void*)mega, dim3(grid_blocks), dim3(512), args, DYN_LDS, stream);
  if (e != hipSuccess) fprintf(stderr, "cooperative launch failed: %s (grid %d)\n", hipGetErrorString(e), grid_blocks);
#else
  for (int ph = 0; ph < NPH; ph++) mega<<<grid_blocks, 512, DYN_LDS, stream>>>(p, ph, ph + 1);
#endif
}
```
